# Optimizing an MI355X kernel written in HIP

```python
import jax, jax.numpy as jnp
from jax import lax
import numpy as np

D_MODEL = 1024
BATCH = 2
SEQ = 8192
DEPTH = 2

FOX_HEADS = 8
FOX_HEAD_DIM = 64
FOX_W = FOX_HEADS * FOX_HEAD_DIM
FORGET_BIAS_MEAN = 3.0
FORGET_W_SCALE = 0.1
RET_HEADS = 8
RET_QK_DIM = 64
RET_V_DIM = 128
RET_QK_W = RET_HEADS * RET_QK_DIM
RET_V_W = RET_HEADS * RET_V_DIM
RET_CHUNK = 128
MLA_HEADS = 8
MLA_Q_RANK = 384
MLA_KV_RANK = 256
MLA_NOPE_DIM = 64
MLA_ROPE_DIM = 32
MLA_V_DIM = 64
MLA_QK_DIM = MLA_NOPE_DIM + MLA_ROPE_DIM
MLA_V_W = MLA_HEADS * MLA_V_DIM
N_BRANCHES = 3
Q_BLOCK = 128
ROPE_THETA = 10000.0
RMS_EPS = 1e-6
D_FF = 3584
N_EXPERTS = 8
TOP_K = 2
N_DENSE = (DEPTH + 1) // 2
N_MOE = DEPTH // 2
IN_SPLITS = (FOX_W, FOX_W, FOX_W, FOX_HEADS,
             RET_QK_W, RET_QK_W, RET_V_W, RET_V_W,
             MLA_Q_RANK, MLA_KV_RANK, MLA_ROPE_DIM,
             N_BRANCHES * D_MODEL)
D_IN = 3 * FOX_W + FOX_HEADS + 2 * RET_QK_W + 2 * RET_V_W + MLA_Q_RANK + MLA_KV_RANK + MLA_ROPE_DIM + N_BRANCHES * D_MODEL

kernel_name = "hybrid_fox_retnet_mla_moe_block"


def rmsnorm(x, w):
    xf = x.astype(jnp.float32)
    y = xf * lax.rsqrt(jnp.mean(xf * xf, axis=-1, keepdims=True) + RMS_EPS)
    return (y * w.astype(jnp.float32)).astype(x.dtype)


def rope(x):
    S, d = x.shape[1], x.shape[-1]
    pos = jnp.arange(S, dtype=jnp.float32)
    inv_freq = ROPE_THETA ** (-jnp.arange(0, d, 2, dtype=jnp.float32) / d)
    ang = pos[:, None] * inv_freq[None, :]
    cos = jnp.cos(ang)[None, :, None, :]
    sin = jnp.sin(ang)[None, :, None, :]
    xf = x.astype(jnp.float32)
    x1, x2 = xf[..., : d // 2], xf[..., d // 2:]
    out = jnp.concatenate([x1 * cos - x2 * sin, x2 * cos + x1 * sin], axis=-1)
    return out.astype(x.dtype)


def blocked_causal_attention(q, k, v, decay_cum=None):
    B, S, H, dk = q.shape
    dv = v.shape[-1]
    nb = S // Q_BLOCK
    scale = dk ** -0.5
    kpos = jnp.arange(S)
    qb = q.reshape(B, nb, Q_BLOCK, H, dk).transpose(1, 0, 2, 3, 4)
    idx = jnp.arange(nb)
    if decay_cum is not None:
        d_keys = decay_cum.transpose(0, 2, 1)
        d_q = decay_cum.reshape(B, nb, Q_BLOCK, H).transpose(1, 0, 2, 3)
        xs = (idx, qb, d_q)
    else:
        xs = (idx, qb)

    def one_block(args):
        i, qi = args[0], args[1]
        s = jnp.einsum('bqhd,bkhd->bhqk', qi, k).astype(jnp.float32) * scale
        if decay_cum is not None:
            dqi = args[2].transpose(0, 2, 1)
            s = s + (dqi[:, :, :, None] - d_keys[:, :, None, :])
        qpos = i * Q_BLOCK + jnp.arange(Q_BLOCK)
        mask = kpos[None, :] <= qpos[:, None]
        s = jnp.where(mask[None, None], s, -jnp.inf)
        p = jax.nn.softmax(s, axis=-1)
        return jnp.einsum('bhqk,bkhd->bqhd', p.astype(v.dtype), v)

    out = lax.map(one_block, xs)
    return out.transpose(1, 0, 2, 3, 4).reshape(B, S, H, dv)


def retention_chunkwise(q, k, v, gammas):
    B, S, H, dk = q.shape
    dv = v.shape[-1]
    C = RET_CHUNK
    nc = S // C
    qf = q.astype(jnp.float32)
    kf = k.astype(jnp.float32) * (dk ** -0.5)
    vf = v.astype(jnp.float32)
    qc = qf.reshape(B, nc, C, H, dk).transpose(1, 0, 3, 2, 4)
    kc = kf.reshape(B, nc, C, H, dk).transpose(1, 0, 3, 2, 4)
    vc = vf.reshape(B, nc, C, H, dv).transpose(1, 0, 3, 2, 4)
    log_g = jnp.log(gammas)
    j = jnp.arange(C, dtype=jnp.float32)
    diff = j[:, None] - j[None, :]
    d_in = jnp.where(diff[None] >= 0,
                     jnp.exp(jnp.maximum(diff, 0.0)[None] * log_g[:, None, None]), 0.0)
    xi = jnp.exp((j[None, :] + 1.0) * log_g[:, None])
    zeta = jnp.exp((C - 1.0 - j[None, :]) * log_g[:, None])
    g_chunk = jnp.exp(C * log_g)

    def step(R, inp):
        qi, ki, vi = inp
        inner = jnp.einsum('bhnd,bhmd->bhnm', qi, ki) * d_in[None]
        o = jnp.einsum('bhnm,bhme->bhne', inner, vi) \
            + jnp.einsum('bhnd,bhde->bhne', qi, R) * xi[None, :, :, None]
        R = g_chunk[None, :, None, None] * R \
            + jnp.einsum('bhmd,bhme->bhde', ki * zeta[None, :, :, None], vi)
        return R, o

    R0 = jnp.zeros((B, H, dk, dv), jnp.float32)
    _, o = lax.scan(step, R0, (qc, kc, vc))
    return o.transpose(1, 0, 3, 2, 4).reshape(B, S, H, dv)


def hybrid_mixer(h, w_in, fox_f_bias, ret_gn_w, mla_q_norm_w, mla_kv_norm_w,
                 mla_w_uq, mla_w_uk, mla_w_uv, w_br_fox, w_br_ret, w_br_mla, w_out):
    B, S, _ = h.shape
    proj = h @ w_in
    split_at = [int(i) for i in np.cumsum(IN_SPLITS)[:-1]]
    (fq, fk, fv, ff, rq, rk, rv, rg, cq, ckv, kr, gl) = jnp.split(proj, split_at, axis=-1)

    logf = jax.nn.log_sigmoid(ff.astype(jnp.float32) + fox_f_bias.astype(jnp.float32))
    cum = jnp.cumsum(logf, axis=1)
    o_fox = blocked_causal_attention(fq.reshape(B, S, FOX_HEADS, FOX_HEAD_DIM),
                                     fk.reshape(B, S, FOX_HEADS, FOX_HEAD_DIM),
                                     fv.reshape(B, S, FOX_HEADS, FOX_HEAD_DIM),
                                     cum).reshape(B, S, FOX_W)

    r_q = rope(rq.reshape(B, S, RET_HEADS, RET_QK_DIM))
    r_k = rope(rk.reshape(B, S, RET_HEADS, RET_QK_DIM))
    r_v = rv.reshape(B, S, RET_HEADS, RET_V_DIM)
    gammas = 1.0 - 2.0 ** (-5.0 - jnp.arange(RET_HEADS, dtype=jnp.float32))
    o = retention_chunkwise(r_q, r_k, r_v, gammas)
    mu = jnp.mean(o, axis=-1, keepdims=True)
    var = jnp.mean(jnp.square(o - mu), axis=-1, keepdims=True)
    o = (o - mu) * lax.rsqrt(var + RMS_EPS) * ret_gn_w.astype(jnp.float32).reshape(RET_HEADS, RET_V_DIM)
    o_ret = jax.nn.silu(rg) * o.reshape(B, S, RET_V_W).astype(h.dtype)

    c_q = rmsnorm(cq, mla_q_norm_w)
    m_q = (c_q @ mla_w_uq).reshape(B, S, MLA_HEADS, MLA_QK_DIM)
    m_q = jnp.concatenate([m_q[..., :MLA_NOPE_DIM], rope(m_q[..., MLA_NOPE_DIM:])], axis=-1)
    c_kv = rmsnorm(ckv, mla_kv_norm_w)
    k_nope = (c_kv @ mla_w_uk).reshape(B, S, MLA_HEADS, MLA_NOPE_DIM)
    m_v = (c_kv @ mla_w_uv).reshape(B, S, MLA_HEADS, MLA_V_DIM)
    k_rope = rope(kr.reshape(B, S, 1, MLA_ROPE_DIM))
    m_k = jnp.concatenate([k_nope, jnp.broadcast_to(k_rope, (B, S, MLA_HEADS, MLA_ROPE_DIM))], axis=-1)
    o_mla = blocked_causal_attention(m_q, m_k, m_v).reshape(B, S, MLA_V_W)

    gates = jax.nn.sigmoid(gl.reshape(B, S, N_BRANCHES, D_MODEL))
    merged = (gates[:, :, 0] * (o_fox @ w_br_fox)
              + gates[:, :, 1] * (o_ret @ w_br_ret)
              + gates[:, :, 2] * (o_mla @ w_br_mla))
    return merged @ w_out


def swiglu(h, w_gate, w_up, w_down):
    return (jax.nn.silu(h @ w_gate) * (h @ w_up)) @ w_down


def moe_swiglu(h, w_router, w_gate, w_up, w_down):
    logits = (h @ w_router).astype(jnp.float32)
    top_v, top_i = lax.top_k(logits, TOP_K)
    top_w = jax.nn.softmax(top_v, axis=-1)
    combine = jnp.sum(top_w[..., None] * jax.nn.one_hot(top_i, N_EXPERTS, dtype=jnp.float32), axis=-2)
    combine = combine.astype(h.dtype)
    out = jnp.zeros_like(h)
    for e in range(N_EXPERTS):
        out = out + combine[..., e:e + 1] * swiglu(h, w_gate[e], w_up[e], w_down[e])
    return out


def setup_inputs(seed: int = 0) -> dict:
    key = jax.random.key(seed)
    ks = jax.random.split(key, 32)
    f32 = jnp.float32

    def nrm(k, shape, scale):
        return jax.random.normal(k, shape, f32) * scale

    def gain(k, shape):
        return 1.0 + 0.05 * jax.random.normal(k, shape, f32)

    col_scale = jnp.ones((D_IN,), f32).at[3 * FOX_W:3 * FOX_W + FOX_HEADS].set(FORGET_W_SCALE)
    return {
        "x": jax.random.normal(ks[0], (BATCH, SEQ, D_MODEL), f32),
        "norm_mix_w": gain(ks[1], (DEPTH, D_MODEL)),
        "w_in": nrm(ks[2], (DEPTH, D_MODEL, D_IN), D_MODEL ** -0.5) * col_scale,
        "fox_f_bias": FORGET_BIAS_MEAN + 0.5 * jax.random.normal(ks[3], (DEPTH, FOX_HEADS), f32),
        "ret_gn_w": gain(ks[4], (DEPTH, RET_V_W)),
        "mla_q_norm_w": gain(ks[5], (DEPTH, MLA_Q_RANK)),
        "mla_kv_norm_w": gain(ks[6], (DEPTH, MLA_KV_RANK)),
        "mla_w_uq": nrm(ks[7], (DEPTH, MLA_Q_RANK, MLA_HEADS * MLA_QK_DIM), MLA_Q_RANK ** -0.5),
        "mla_w_uk": nrm(ks[8], (DEPTH, MLA_KV_RANK, MLA_HEADS * MLA_NOPE_DIM), MLA_KV_RANK ** -0.5),
        "mla_w_uv": nrm(ks[9], (DEPTH, MLA_KV_RANK, MLA_V_W), MLA_KV_RANK ** -0.5),
        "w_br_fox": nrm(ks[10], (DEPTH, FOX_W, D_MODEL), FOX_W ** -0.5),
        "w_br_ret": nrm(ks[11], (DEPTH, RET_V_W, D_MODEL), RET_V_W ** -0.5),
        "w_br_mla": nrm(ks[12], (DEPTH, MLA_V_W, D_MODEL), MLA_V_W ** -0.5),
        "w_out": nrm(ks[13], (DEPTH, D_MODEL, D_MODEL), D_MODEL ** -0.5),
        "norm_ffn_w": gain(ks[14], (DEPTH, D_MODEL)),
        "dense_w_gate": nrm(ks[15], (N_DENSE, D_MODEL, D_FF), D_MODEL ** -0.5),
        "dense_w_up": nrm(ks[16], (N_DENSE, D_MODEL, D_FF), D_MODEL ** -0.5),
        "dense_w_down": nrm(ks[17], (N_DENSE, D_FF, D_MODEL), D_FF ** -0.5),
        "moe_w_router": nrm(ks[18], (N_MOE, D_MODEL, N_EXPERTS), D_MODEL ** -0.5),
        "moe_w_gate": nrm(ks[19], (N_MOE, N_EXPERTS, D_MODEL, D_FF), D_MODEL ** -0.5),
        "moe_w_up": nrm(ks[20], (N_MOE, N_EXPERTS, D_MODEL, D_FF), D_MODEL ** -0.5),
        "moe_w_down": nrm(ks[21], (N_MOE, N_EXPERTS, D_FF, D_MODEL), D_FF ** -0.5),
        "final_norm_w": gain(ks[22], (D_MODEL,)),
    }


def reference(x, norm_mix_w, w_in, fox_f_bias, ret_gn_w, mla_q_norm_w, mla_kv_norm_w,
              mla_w_uq, mla_w_uk, mla_w_uv, w_br_fox, w_br_ret, w_br_mla, w_out,
              norm_ffn_w, dense_w_gate, dense_w_up, dense_w_down,
              moe_w_router, moe_w_gate, moe_w_up, moe_w_down, final_norm_w):
    for l in range(DEPTH):
        h = rmsnorm(x, norm_mix_w[l])
        x = x + hybrid_mixer(h, w_in[l], fox_f_bias[l], ret_gn_w[l], mla_q_norm_w[l],
                             mla_kv_norm_w[l], mla_w_uq[l], mla_w_uk[l], mla_w_uv[l],
                             w_br_fox[l], w_br_ret[l], w_br_mla[l], w_out[l])
        h = rmsnorm(x, norm_ffn_w[l])
        if l % 2 == 0:
            i = l // 2
            x = x + swiglu(h, dense_w_gate[i], dense_w_up[i], dense_w_down[i])
        else:
            i = l // 2
            x = x + moe_swiglu(h, moe_w_router[i], moe_w_gate[i], moe_w_up[i], moe_w_down[i])
    return rmsnorm(x, final_norm_w)
```

```cpp
#include <hip/hip_runtime.h>
#include <hip/hip_bf16.h>
#include <cstdio>
#include <cstdint>

#ifndef FP8_MOE_GU
#define FP8_MOE_GU 1
#endif
#ifndef FP8_MOE_DN
#define FP8_MOE_DN 1
#endif
#ifndef CVT_MOE_IN_P4
#define CVT_MOE_IN_P4 1
#endif
#ifndef CVT_L1_IN_P4
#define CVT_L1_IN_P4 1
#endif
#ifndef FP8_DENSE_GU
#define FP8_DENSE_GU 0
#endif
#define YPARTS (FP8_MOE_DN ? 2 : 4)
#ifndef MK_PER_PHASE
#define MK_PER_PHASE 0
#endif

#define LAS __attribute__((address_space(3)))
typedef unsigned short bf16_t;
typedef short bf16x8 __attribute__((ext_vector_type(8)));
typedef short s16x4 __attribute__((ext_vector_type(4)));
typedef float f32x2 __attribute__((ext_vector_type(2)));
typedef float f32x4 __attribute__((ext_vector_type(4)));
typedef float f32x16 __attribute__((ext_vector_type(16)));
typedef unsigned u32x2 __attribute__((ext_vector_type(2)));
typedef unsigned u32x4 __attribute__((ext_vector_type(4)));
typedef __bf16 bf16x2_t __attribute__((ext_vector_type(2)));

constexpr int BATCH = 2, SEQ = 8192, DM = 1024, M = BATCH * SEQ;
constexpr int DIN = 8360, NP1 = 8448;
constexpr int DFF = 3584, NEXP = 8;
constexpr int MAXT = 136;
constexpr float EPS = 1e-6f;
constexpr float LOG2E = 1.4426950408889634f;
constexpr float C2F = 0.125f * LOG2E;
constexpr float C2M = 0.10206207261596575f * LOG2E;

__device__ __forceinline__ int opaque_tid() { int t = threadIdx.x; asm volatile("" : "+v"(t)); return t; }
template <int MASK> __device__ __forceinline__ float add_xor(float v) {
    if constexpr (MASK == 32) { auto rr = __builtin_amdgcn_permlane32_swap(__float_as_uint(v), __float_as_uint(v), false, false); return __uint_as_float(rr[0]) + __uint_as_float(rr[1]); }
    else return v + __int_as_float(__builtin_amdgcn_ds_swizzle(__float_as_int(v), (MASK << 10) | 0x1F));
}
__device__ __forceinline__ unsigned pk2(float lo, float hi) { f32x2 v = {lo, hi}; bf16x2_t b = __builtin_convertvector(v, bf16x2_t); return __builtin_bit_cast(unsigned, b); }
__device__ __forceinline__ unsigned pk4_fp8(float a, float b, float c, float d) { a = __builtin_amdgcn_fmed3f(a, -448.f, 448.f); b = __builtin_amdgcn_fmed3f(b, -448.f, 448.f); c = __builtin_amdgcn_fmed3f(c, -448.f, 448.f); d = __builtin_amdgcn_fmed3f(d, -448.f, 448.f); int v = __builtin_amdgcn_cvt_pk_fp8_f32(a, b, 0, false); v = __builtin_amdgcn_cvt_pk_fp8_f32(c, d, v, true); return (unsigned)v; }
__device__ __forceinline__ float bf2f(unsigned short u) { return __uint_as_float((unsigned)u << 16); }
__device__ __forceinline__ unsigned short f2bf(float f) { return (unsigned short)(pk2(f, 0.f) & 0xffffu); }
__device__ __forceinline__ float fexp2(float x) { return __builtin_amdgcn_exp2f(x); }
__device__ __forceinline__ float sigmoidf_(float x) { return __builtin_amdgcn_rcpf(1.f + fexp2(-x * LOG2E)); }
__device__ __forceinline__ float lg2gamma(int h) { const float e = fexp2((float)(-5 - h)); return -(e * (1.f + e * (0.5f + e * (0.33333333f + e * (0.25f + e * (0.2f + e * 0.16666667f)))))) * LOG2E; }

namespace pg8 {
constexpr int BM = 256, BK = 64, HALF = 128, HTB = HALF * BK * 2, STAGE_BYTES = 8 * HTB, NXCD = 8, WGM = 8;
__host__ __device__ __forceinline__ int lds_byte(int r, int c) { const int st = (r >> 4) * 2 + (c >> 5), rr = r & 15, cc = c & 31, ob = rr * 64 + cc * 2; return st * 1024 + (ob ^ (((ob >> 9) & 1) << 5)); }
__host__ __device__ __forceinline__ void stage_rc(int b, int& R, int& C) { const int st = b / 1024, sb = b % 1024, swz = sb ^ (((sb >> 9) & 1) << 5); R = (st >> 1) * 16 + swz / 64; C = (st & 1) * 32 + (swz % 64) / 2; }
__host__ __device__ __forceinline__ int perm32(int rho) { const int n = rho >> 4, i = rho & 15; return 8 * (i >> 2) + 4 * n + (i & 3); }

struct Unit { int pm, pn; const char* A; const char* B; int k; };

__device__ __forceinline__ bool grid_order(int i, int G, int c, int nM, int nN, int& pm, int& pn) {
    const int nwg = nM * nN; const long L = (long)i * G + c; if (L >= nwg) return false;
    int wgid = (int)L; { const int q = nwg / NXCD, r = nwg % NXCD, xcd = wgid % NXCD, off = wgid / NXCD; wgid = (xcd < r ? xcd * (q + 1) : r * (q + 1) + (xcd - r) * q) + off; }
    const int nig = WGM * nN, gid = wgid / nig, fm = gid * WGM, gsz = (nM - fm) < WGM ? (nM - fm) : WGM;
    pm = fm + ((wgid % nig) % gsz); pn = (wgid % nig) / gsz; return true;
}
struct GridOrder {
    int nM, nN, G, c; const char* A; const char* Bt; size_t tstep; int pn_off = 0, pn_skip = 1 << 30, pn_add = 1;
    __device__ __forceinline__ void init(int nM_, int nN_, int G_, int c_, const void* A_, const void* Bt_, int K) { nM = nM_; nN = nN_; G = G_; c = c_; A = (const char*)A_; Bt = (const char*)Bt_; tstep = (size_t)BM * K * 2; }
    __device__ __forceinline__ bool next(int i, Unit& u) const { if (!grid_order(i, G, c, nM, nN, u.pm, u.pn)) return false; u.pn += pn_off; if (u.pn >= pn_skip) u.pn += pn_add;
        u.A = A + (size_t)u.pm * tstep; u.B = Bt + (size_t)u.pn * tstep; return true; }
};
__host__ __device__ __forceinline__ size_t moe_gu_base(int e) { return e < 5 ? ((size_t)12 << 20) + (size_t)e * (7u << 20) : ((size_t)60 << 20) + (size_t)(e - 5) * (7u << 20); }
__host__ __device__ __forceinline__ size_t moe_dn_base(int e) { return e == 0 ? ((size_t)47 << 20) : e < 6 ? ((size_t)353 << 20) + (size_t)(e - 1) * (7u << 19) : e == 6 ? ((size_t)525 << 20) : ((size_t)461 << 20); }
struct MoeOrder {
    int t0, nM, nN, G, c, arow0; const char* A; const char* Bt; size_t tstep, estride; const LAS unsigned char* te; int kpart_bytes = 0, dn = 0;
    __device__ __forceinline__ bool next(int i, Unit& u) const { int pm, pn; if (!grid_order(i, G, c, nM, nN, pm, pn)) return false; u.pm = t0 + pm; u.pn = pn; u.k = i;
        const int kp = kpart_bytes ? (pn >> 2) : 0, pnn = kpart_bytes ? (pn & 3) : pn;
        u.A = A + (size_t)(u.pm - arow0) * tstep + (size_t)kp * kpart_bytes; u.B = Bt + (dn ? moe_dn_base(te[u.pm]) : moe_gu_base(te[u.pm])) + (size_t)pnn * tstep + (size_t)kp * kpart_bytes; return true; }
};

typedef int i32x4_t __attribute__((ext_vector_type(4)));
typedef int i32x8_t __attribute__((ext_vector_type(8)));
__device__ __forceinline__ i32x8_t cat8(const bf16x8 lo, const bf16x8 hi) { return __builtin_shufflevector(__builtin_bit_cast(i32x4_t, lo), __builtin_bit_cast(i32x4_t, hi), 0, 1, 2, 3, 4, 5, 6, 7); }
template <class Epi, class Sched, bool ALIGN_EPI, bool FP8 = false>
__device__ __forceinline__ void gemm_phase(LAS unsigned char* lds, const int K, const Sched& S, const Epi& E, const int KLEN = 0) {
    const int tid = opaque_tid(), wid = __builtin_amdgcn_readfirstlane(tid >> 6), lane = tid & 63, wr = wid >> 2, wc = wid & 3, fr = lane & 15, fq = lane >> 4;
    const int nt = (KLEN ? KLEN : K) / BK;
    LAS float* rtab = (LAS float*)(lds + 131072 + 1024);
    unsigned voffA[2], voffB[2];
#pragma unroll
    for (int i = 0; i < 2; ++i) { int R, C; stage_rc(tid * 16 + i * 8192, R, C); const int Rb = (R & ~31) + perm32(R & 31);
        voffA[i] = (unsigned)(R * K + C) * 2u; voffB[i] = (unsigned)(Rb * K + C) * 2u; }
    const size_t kstep = (size_t)(BK * 2);
    const size_t hstep = (size_t)HALF * K * 2;
    const unsigned ldsw = (unsigned)wid * 1024u;
    const int aoff = lds_byte(wr * 64 + fr, fq * 8), boff = lds_byte(wc * 32 + fr, fq * 8);
#define PG8_SA(b, h) (((b) * 2 + (h)) * HTB)
#define PG8_SB(b, h) ((4 + (b) * 2 + (h)) * HTB)
#define PG8_STAGE(bufoff, gbase, voff) do { _Pragma("unroll") for (int _i = 0; _i < 2; ++_i) \
        __builtin_amdgcn_global_load_lds((const unsigned*)((const char*)(gbase) + (voff)[_i]), (LAS unsigned*)(lds + (bufoff) + ldsw + _i * 8192), 16, 0, 0); } while (0)
#define PG8_LDA(dst, b, h) do { _Pragma("unroll") for (int m = 0; m < 4; ++m) { if constexpr (FP8) dst##8[m] = cat8(*(const LAS bf16x8*)(lds + PG8_SA(b, h) + aoff + m * 2048), *(const LAS bf16x8*)(lds + PG8_SA(b, h) + aoff + m * 2048 + 1024)); \
        else { _Pragma("unroll") for (int k = 0; k < 2; ++k) dst[m][k] = *(const LAS bf16x8*)(lds + PG8_SA(b, h) + aoff + m * 2048 + k * 1024); } } } while (0)
#define PG8_LDB(dst, b, h) do { _Pragma("unroll") for (int n = 0; n < 2; ++n) { if constexpr (FP8) dst##8[n] = cat8(*(const LAS bf16x8*)(lds + PG8_SB(b, h) + boff + n * 2048), *(const LAS bf16x8*)(lds + PG8_SB(b, h) + boff + n * 2048 + 1024)); \
        else { _Pragma("unroll") for (int k = 0; k < 2; ++k) dst[n][k] = *(const LAS bf16x8*)(lds + PG8_SB(b, h) + boff + n * 2048 + k * 1024); } } } while (0)
#define PG8_MMA(ai, bj, At, Bt) do { __builtin_amdgcn_s_setprio(1); _Pragma("unroll") for (int m = 0; m < 4; ++m) _Pragma("unroll") for (int n = 0; n < 2; ++n) { \
        if constexpr (FP8) asm volatile("s_nop 1\n\tv_mfma_scale_f32_16x16x128_f8f6f4 %0, %1, %2, %0, %3, %3 op_sel_hi:[0,0,0]" : "+v"(acc[ai][bj][m][n]) : "v"(Bt##8[n]), "v"(At##8[m]), "v"(sc1_)); \
        else { _Pragma("unroll") for (int k = 0; k < 2; ++k) acc[ai][bj][m][n] = __builtin_amdgcn_mfma_f32_16x16x32_bf16(Bt[n][k], At[m][k], acc[ai][bj][m][n], 0, 0, 0); } } __builtin_amdgcn_s_setprio(0); } while (0)
#define PG8_WAIT_V(n) asm volatile("s_waitcnt vmcnt(" #n ")" ::: "memory")
#define PG8_WAIT_L(n) asm volatile("s_waitcnt lgkmcnt(" #n ")" ::: "memory")
#define PG8_BAR __builtin_amdgcn_s_barrier()
#define PG8_SCHED __builtin_amdgcn_sched_barrier(0)
    Unit cur, nxt; int ui = 0;
    if (!S.next(0, cur)) return;
    f32x4 acc[2][2][4][2];
    if constexpr (Epi::HAS_INIT) E.init(acc, cur, wr, wc, fr, fq);
    else {
#pragma unroll
    for (int a = 0; a < 2; ++a)
#pragma unroll
        for (int b = 0; b < 2; ++b)
#pragma unroll
            for (int m = 0; m < 4; ++m)
#pragma unroll
                for (int n = 0; n < 2; ++n) acc[a][b][m][n] = (f32x4){0.f, 0.f, 0.f, 0.f};
    }
    int sc1_ = 0x7F7F7F7F; asm volatile("" : "+v"(sc1_));
    bf16x8 At[4][2], B0[2][2], B1[2][2]; i32x8_t At8[4], B08[2], B18[2]; (void)At; (void)B0; (void)B1; (void)At8; (void)B08; (void)B18;
    const char* cA = cur.A; const char* cB = cur.B;
    PG8_STAGE(PG8_SB(0, 0), cB, voffB); PG8_STAGE(PG8_SB(0, 1), cB + hstep, voffB); PG8_STAGE(PG8_SA(0, 0), cA, voffA); PG8_STAGE(PG8_SA(0, 1), cA + hstep, voffA);
    if (wr == 1) PG8_BAR;
    PG8_WAIT_V(2); PG8_BAR;
    PG8_STAGE(PG8_SB(1, 0), cB + kstep, voffB); PG8_STAGE(PG8_SA(1, 0), cA + kstep, voffA); PG8_STAGE(PG8_SB(1, 1), cB + hstep + kstep, voffB);
    PG8_WAIT_V(6); PG8_BAR;
    for (;;) {
        const bool has_next = S.next(ui + 1, nxt);
        const char* nA = has_next ? nxt.A : cA; const char* nB = has_next ? nxt.B : cB;
        int t = 0;
#pragma nounroll
        for (int sg = 0; sg < (Epi::HAS_MID ? 3 : 1); ++sg) {
        int tend = nt; if constexpr (Epi::HAS_MID) tend = sg == 0 ? Epi::MID0 : (sg == 1 ? Epi::MID1 : nt);
#pragma nounroll
        for (; t < tend; t += 2) {
            const bool last = (t == nt - 2);
            const char* a1 = cA + (size_t)(t + 1) * kstep;
            const char* a2 = last ? nA : cA + (size_t)(t + 2) * kstep; const char* b2 = last ? nB : cB + (size_t)(t + 2) * kstep;
            const char* a3 = a2 + kstep; const char* b3 = b2 + kstep;
            PG8_LDB(B0, 0, 0); PG8_LDB(B1, 0, 1); PG8_SCHED; PG8_LDA(At, 0, 0); PG8_STAGE(PG8_SA(1, 1), a1 + hstep, voffA);
            PG8_WAIT_V(8); PG8_WAIT_L(0); PG8_BAR; PG8_MMA(0, 0, At, B0); PG8_MMA(0, 1, At, B1); PG8_BAR; PG8_SCHED;
            PG8_LDA(At, 0, 1); PG8_STAGE(PG8_SB(0, 0), b2, voffB); PG8_STAGE(PG8_SB(0, 1), b2 + hstep, voffB); PG8_STAGE(PG8_SA(0, 0), a2, voffA);
            PG8_WAIT_V(8); PG8_WAIT_L(0); PG8_BAR; PG8_MMA(1, 0, At, B0); PG8_MMA(1, 1, At, B1); PG8_BAR; PG8_SCHED;
            PG8_LDB(B0, 1, 0); PG8_LDB(B1, 1, 1); PG8_SCHED; PG8_LDA(At, 1, 0); PG8_STAGE(PG8_SA(0, 1), a2 + hstep, voffA);
            PG8_WAIT_V(8); PG8_WAIT_L(0); PG8_BAR; PG8_MMA(0, 0, At, B0); PG8_MMA(0, 1, At, B1); PG8_BAR; PG8_SCHED;
            PG8_LDA(At, 1, 1); PG8_STAGE(PG8_SB(1, 0), b3, voffB); PG8_STAGE(PG8_SB(1, 1), b3 + hstep, voffB); PG8_STAGE(PG8_SA(1, 0), a3, voffA);
            PG8_WAIT_V(8); PG8_WAIT_L(0); PG8_BAR; PG8_MMA(1, 0, At, B0); PG8_MMA(1, 1, At, B1); PG8_BAR; PG8_SCHED;
        }
        if constexpr (Epi::HAS_MID) { if (sg < 2) E.mid(acc, cur, wr, wc, fr, fq, t); }
        }
        if constexpr (FP8) { asm volatile("s_nop 15\n\ts_nop 7" ::: "memory"); PG8_SCHED; }
        if constexpr (ALIGN_EPI) { if (wr == 0) PG8_BAR; }
        if constexpr (Epi::NEEDS_RS) { static_assert(ALIGN_EPI, "r-table needs aligned halves"); if (!E.prefilled()) { E.rs_table(cur, rtab); PG8_WAIT_L(0); PG8_BAR; asm volatile("" ::: "memory"); } }
        E(acc, cur, wr, wc, fr, fq, rtab);
        if (!has_next) break;
        if constexpr (Epi::HAS_INIT) E.init(acc, nxt, wr, wc, fr, fq);
        else {
#pragma unroll
        for (int a = 0; a < 2; ++a)
#pragma unroll
            for (int b = 0; b < 2; ++b)
#pragma unroll
                for (int m = 0; m < 4; ++m)
#pragma unroll
                    for (int n = 0; n < 2; ++n) acc[a][b][m][n] = (f32x4){0.f, 0.f, 0.f, 0.f};
        }
        cur = nxt; cA = nA; cB = nB; ++ui;
        if constexpr (ALIGN_EPI) { if (wr == 1) PG8_BAR; }
    }
    PG8_WAIT_V(0);
    if constexpr (!ALIGN_EPI) { if (wr == 0) PG8_BAR; }
    PG8_BAR;
#undef PG8_SA
#undef PG8_SB
#undef PG8_STAGE
#undef PG8_LDA
#undef PG8_LDB
#undef PG8_MMA
#undef PG8_WAIT_V
#undef PG8_WAIT_L
#undef PG8_BAR
#undef PG8_SCHED
}

template <int NP> __device__ __forceinline__ void rs_fill(const float* part, int row_first, float inv_n, LAS float* rtab) {
    const int tid = opaque_tid(), rl = tid >> 1, half = tid & 1; const float* p = part + (size_t)(row_first + rl) * NP + half * (NP / 2); float s;
    if constexpr (NP == 16) { const f32x4 a = *(const f32x4*)p, b = *(const f32x4*)(p + 4); s = ((a.x + a.y) + (a.z + a.w)) + ((b.x + b.y) + (b.z + b.w)); }
    else if constexpr (NP == 12) { const f32x2 a = *(const f32x2*)p, b = *(const f32x2*)(p + 2), c = *(const f32x2*)(p + 4); s = (a.x + a.y) + (b.x + b.y) + (c.x + c.y); }
    else { const f32x4 a = *(const f32x4*)p; s = (a.x + a.y) + (a.z + a.w); }
    s = add_xor<1>(s);
    if (half == 0) rtab[rl] = __builtin_amdgcn_rsqf(s * inv_n + EPS);
}
#define ST16(p, v) (*(u32x4*)(p) = (v))
__device__ __forceinline__ u32x4 pack8(const f32x4 a, const f32x4 b) { u32x4 w; w.x = pk2(a.x, a.y); w.y = pk2(a.z, a.w); w.z = pk2(b.x, b.y); w.w = pk2(b.z, b.w); return w; }
__device__ __forceinline__ float sum8sq(const f32x4 a, const f32x4 b) { return ((a.x * a.x + a.y * a.y) + (a.z * a.z + a.w * a.w)) + ((b.x * b.x + b.y * b.y) + (b.z * b.z + b.w * b.w)); }
__device__ __forceinline__ void rope4(f32x4& x1, f32x4& x2, const f32x4 t0, const f32x4 t1) {
    const f32x4 c = {t0.x, t0.z, t1.x, t1.z}, s = {t0.y, t0.w, t1.y, t1.w};
    const f32x4 y1 = x1 * c - x2 * s, y2 = x2 * c + x1 * s; x1 = y1; x2 = y2;
}

#define RS_(ai, m) rt[(ai) * HALF + (m) * 16]
struct EpiP1 {
    bf16_t *FQ, *FK, *FV, *RQ, *KG, *RV, *RG, *GATES, *CQ, *CKV, *KR; float *LOGF, *SSQC, *SSQK;
    const float* SSQ16; const f32x2* T64; const f32x2* T32; const float* fbias; unsigned* KMSQ;
    int pre = 0;
    static constexpr bool NEEDS_RS = true, HAS_MID = false, HAS_INIT = false;
    __device__ __forceinline__ bool prefilled() const { return pre != 0; }
    __device__ __forceinline__ void rs_table(const Unit& u, LAS float* rtab) const { rs_fill<16>(SSQ16, u.pm * BM, 1.f / 1024.f, rtab); }
    __device__ __forceinline__ void operator()(const f32x4 (&acc)[2][2][4][2], const Unit& u, int wr, int wc, int fr, int fq, const LAS float* rtab) const {
        const int pn = u.pn, row0 = u.pm * BM + wr * 64 + fr, ct0 = wc * 32 + fq * 8; const LAS float* rt = rtab + (pre ? 256 + (u.pm & 7) * 256 : 0) + wr * 64 + fr;
        if (pn < 6 || (pn >= 10 && pn < 14)) {
            bf16_t* dst; int ld, cb; float sc = 1.f;
            if (pn < 2) { dst = FQ; ld = 512; cb = pn * 256; sc = C2F; } else if (pn < 4) { dst = FK; ld = 512; cb = (pn - 2) * 256; } else if (pn < 6) { dst = FV; ld = 512; cb = (pn - 4) * 256; } else { dst = RV; ld = 1024; cb = (pn - 10) * 256; }
            float mx[2] = {0.f, 0.f};
#pragma unroll
            for (int ai = 0; ai < 2; ++ai)
#pragma unroll
                for (int m = 0; m < 4; ++m) { const int row = row0 + ai * HALF + m * 16; const float s = RS_(ai, m) * sc; bf16_t* rp = dst + (size_t)row * ld + cb + ct0;
#pragma unroll
                    for (int bj = 0; bj < 2; ++bj) { const f32x4 a = acc[ai][bj][m][0] * s, b = acc[ai][bj][m][1] * s; ST16(rp + bj * HALF, pack8(a, b));
                        if (pn == 2 || pn == 3) { float q = sum8sq(a, b); q = add_xor<16>(q); q = add_xor<32>(q); mx[bj] = fmaxf(mx[bj], q); } } }
            if (pn == 2 || pn == 3) {
#pragma unroll
                for (int bj = 0; bj < 2; ++bj) { float q = mx[bj];
                    q = fmaxf(q, __int_as_float(__builtin_amdgcn_ds_swizzle(__float_as_int(q), (1 << 10) | 0x1F))); q = fmaxf(q, __int_as_float(__builtin_amdgcn_ds_swizzle(__float_as_int(q), (2 << 10) | 0x1F)));
                    q = fmaxf(q, __int_as_float(__builtin_amdgcn_ds_swizzle(__float_as_int(q), (4 << 10) | 0x1F))); q = fmaxf(q, __int_as_float(__builtin_amdgcn_ds_swizzle(__float_as_int(q), (8 << 10) | 0x1F)));
                    const int colb = (pn - 2) * 256 + bj * HALF + wc * 32;
                    if (fr == 0 && fq == 0) atomicMax(KMSQ + (((u.pm * BM) >> 13) * 8 + (colb >> 6)) * 2 + ((colb >> 5) & 1), __float_as_uint(q)); } }
        } else if (pn >= 14 && pn < 30) {
            const bool gl = pn >= 18; const int cb = (pn - 14) * 256;
            bf16_t* gfb = GATES + ((size_t)(((pn - 18) >> 2) * 64 + u.pm) * 4 + ((pn - 18) & 3)) * (8 * 16 * 64 * 8) + (size_t)((wr * 4 + wc) * 16) * 512 + (fq * 16 + fr) * 8;
#pragma unroll
            for (int ai = 0; ai < 2; ++ai)
#pragma unroll
                for (int m = 0; m < 4; ++m) { const int row = row0 + ai * HALF + m * 16; const float s = RS_(ai, m); bf16_t* rp = gl ? gfb + (ai * 8 + m * 2) * 512 - 0 : RG + (size_t)row * 1024 + cb + ct0; const int bstep = gl ? 512 : HALF;
#pragma unroll
                    for (int bj = 0; bj < 2; ++bj) { f32x4 v[2];
#pragma unroll
                        for (int n = 0; n < 2; ++n) { const f32x4 x = acc[ai][bj][m][n] * s; f32x4 sg; sg.x = sigmoidf_(x.x); sg.y = sigmoidf_(x.y); sg.z = sigmoidf_(x.z); sg.w = sigmoidf_(x.w); v[n] = gl ? sg : x * sg; }
                        ST16(rp + bj * bstep, pack8(v[0], v[1])); } }
        } else if (pn >= 6 && pn < 10) {
            const bool isk = pn >= 8; bf16_t* dst = isk ? KG : RQ; const int cb = (pn - (isk ? 8 : 6)) * 256; const int i0 = 16 * (wc & 1) + 4 * fq;
#pragma unroll
            for (int ai = 0; ai < 2; ++ai) {
                f32x4 tq0[4], tq1[4];
#pragma unroll
                for (int m = 0; m < 4; ++m) { const int pos = (row0 + ai * HALF + m * 16) & (SEQ - 1); const f32x4* tp = (const f32x4*)(T64 + (size_t)pos * 32 + i0); tq0[m] = tp[0]; tq1[m] = tp[1]; }
                asm volatile("" ::: "memory");
#pragma unroll
                for (int m = 0; m < 4; ++m) { const int row = row0 + ai * HALF + m * 16, pos = row & (SEQ - 1); const float s = RS_(ai, m); bf16_t* rp = dst + (size_t)row * 512 + cb + ct0;
                    const f32x4 t0 = tq0[m], t1 = tq1[m];
#pragma unroll
                    for (int bj = 0; bj < 2; ++bj) { f32x4 x1 = acc[ai][bj][m][0] * s, x2 = acc[ai][bj][m][1] * s; rope4(x1, x2, t0, t1);
                        if (isk) { const int head = (cb + bj * HALF + wc * 32) >> 6; const float ks = 0.125f * fexp2(-(float)(pos & 127) * lg2gamma(head)); x1 = x1 * ks; x2 = x2 * ks; }
                        ST16(rp + bj * HALF, pack8(x1, x2)); } }
                asm volatile("" ::: "memory"); }
        } else {
#pragma unroll
            for (int bj = 0; bj < 2; ++bj) {
                int kind, col, grp;
                if (pn == 30) { kind = 0; col = bj * HALF + ct0; grp = 4 * bj + wc; }
                else if (pn == 31) { if (bj == 0) { kind = 0; col = 256 + ct0; grp = 8 + wc; } else { kind = 1; col = ct0; grp = wc; } }
                else { if (bj == 0) { kind = 1; col = HALF + ct0; grp = 4 + wc; } else { kind = 2; col = 0; grp = 0; } }
                if (kind < 2) {
                    bf16_t* dst = kind == 0 ? CQ : CKV; const int ld = kind == 0 ? 384 : 256; float* sq = kind == 0 ? SSQC : SSQK; const int np = kind == 0 ? 12 : 8;
#pragma unroll
                    for (int ai = 0; ai < 2; ++ai)
#pragma unroll
                        for (int m = 0; m < 4; ++m) { const int row = row0 + ai * HALF + m * 16; const float s = RS_(ai, m); const f32x4 a = acc[ai][bj][m][0] * s, b = acc[ai][bj][m][1] * s;
                            ST16(dst + (size_t)row * ld + col, pack8(a, b));
                            float q = sum8sq(a, b); q = add_xor<16>(q); q = add_xor<32>(q);
                            if (fq == 0) sq[(size_t)row * np + grp] = q; }
                } else if (wc == 0) {
#pragma unroll
                    for (int ai = 0; ai < 2; ++ai) {
                        f32x4 tq0[4], tq1[4];
#pragma unroll
                        for (int m = 0; m < 4; ++m) { const int pos = (row0 + ai * HALF + m * 16) & (SEQ - 1); const f32x4* tp = (const f32x4*)(T32 + (size_t)pos * 16 + 4 * fq); tq0[m] = tp[0]; tq1[m] = tp[1]; }
                        asm volatile("" ::: "memory");
#pragma unroll
                        for (int m = 0; m < 4; ++m) { const int row = row0 + ai * HALF + m * 16; const float s = RS_(ai, m);
                            f32x4 x1 = acc[ai][bj][m][0] * s, x2 = acc[ai][bj][m][1] * s; rope4(x1, x2, tq0[m], tq1[m]);
                            ST16(KR + (size_t)row * 32 + 8 * fq, pack8(x1, x2)); }
                        asm volatile("" ::: "memory"); }
                } else if (wc == 1 && fq == 0) {
                    const f32x4 b0 = *(const f32x4*)(fbias), b1 = *(const f32x4*)(fbias + 4);
#pragma unroll
                    for (int ai = 0; ai < 2; ++ai)
#pragma unroll
                        for (int m = 0; m < 4; ++m) { const int row = row0 + ai * HALF + m * 16; const float s = RS_(ai, m);
                            const f32x4 a = acc[ai][bj][m][0] * s + b0, b = acc[ai][bj][m][1] * s + b1; f32x4 la, lb;
                            la.x = fminf(a.x, 0.f) - __logf(1.f + __expf(-fabsf(a.x))); la.y = fminf(a.y, 0.f) - __logf(1.f + __expf(-fabsf(a.y))); la.z = fminf(a.z, 0.f) - __logf(1.f + __expf(-fabsf(a.z))); la.w = fminf(a.w, 0.f) - __logf(1.f + __expf(-fabsf(a.w)));
                            lb.x = fminf(b.x, 0.f) - __logf(1.f + __expf(-fabsf(b.x))); lb.y = fminf(b.y, 0.f) - __logf(1.f + __expf(-fabsf(b.y))); lb.z = fminf(b.z, 0.f) - __logf(1.f + __expf(-fabsf(b.z))); lb.w = fminf(b.w, 0.f) - __logf(1.f + __expf(-fabsf(b.w)));
                            *(f32x4*)(LOGF + (size_t)row * 8) = la; *(f32x4*)(LOGF + (size_t)row * 8 + 4) = lb; }
                }
            }
        }
    }
};

__device__ __forceinline__ unsigned pk4_gate(const f32x4 g) {
    const unsigned a = (unsigned)fmaxf(g.x * 255.f + 0.5f, 1.f), b = (unsigned)fmaxf(g.y * 255.f + 0.5f, 1.f), c = (unsigned)fmaxf(g.z * 255.f + 0.5f, 1.f), d = (unsigned)fmaxf(g.w * 255.f + 0.5f, 1.f);
    return a | (b << 8) | (c << 16) | (d << 24); }
struct EpiGL8 {
    unsigned char* GATES;
    static constexpr bool NEEDS_RS = true, HAS_MID = false, HAS_INIT = false;
    __device__ __forceinline__ bool prefilled() const { return true; }
    __device__ __forceinline__ void rs_table(const Unit&, LAS float*) const {}
    __device__ __forceinline__ void operator()(const f32x4 (&acc)[2][2][4][2], const Unit& u, int wr, int wc, int fr, int fq, const LAS float* rtab) const {
        const LAS float* rt = rtab + 256 + (u.pm & 7) * 256 + wr * 64 + fr;
        unsigned char* gfb = GATES + ((size_t)((u.pn >> 2) * 64 + u.pm) * 4 + (u.pn & 3)) * (8 * 16 * 64 * 8) + (size_t)((wr * 4 + wc) * 16) * 512 + (fq * 16 + fr) * 8;
#pragma unroll
        for (int ai = 0; ai < 2; ++ai)
#pragma unroll
            for (int m = 0; m < 4; ++m) { const float s = RS_(ai, m) * (-LOG2E / 32.f);
#pragma unroll
                for (int bj = 0; bj < 2; ++bj) { f32x4 v[2];
#pragma unroll
                    for (int n = 0; n < 2; ++n) { const f32x4 t = acc[ai][bj][m][n] * s; v[n].x = __builtin_amdgcn_rcpf(1.f + fexp2(t.x)); v[n].y = __builtin_amdgcn_rcpf(1.f + fexp2(t.y)); v[n].z = __builtin_amdgcn_rcpf(1.f + fexp2(t.z)); v[n].w = __builtin_amdgcn_rcpf(1.f + fexp2(t.w)); }
                    *(u32x2*)(gfb + (ai * 8 + m * 2 + bj) * 512) = (u32x2){pk4_gate(v[0]), pk4_gate(v[1])}; } }
    }
};
struct EpiMQ {
    bf16_t* MQ; const float* SSQC; const f32x2* T32;
    static constexpr bool NEEDS_RS = true, HAS_MID = false, HAS_INIT = false;
    __device__ __forceinline__ bool prefilled() const { return false; }
    __device__ __forceinline__ void rs_table(const Unit& u, LAS float* rtab) const { rs_fill<12>(SSQC, u.pm * BM, 1.f / 384.f, rtab); }
    __device__ __forceinline__ void operator()(const f32x4 (&acc)[2][2][4][2], const Unit& u, int wr, int wc, int fr, int fq, const LAS float* rtab) const {
        const int row0 = u.pm * BM + wr * 64 + fr, ct0 = wc * 32 + fq * 8; const LAS float* rt = rtab + wr * 64 + fr;
#pragma unroll
        for (int ai = 0; ai < 2; ++ai) {
            f32x4 tq0[4], tq1[4];
#pragma unroll
            for (int m = 0; m < 4; ++m) { const int pos = (row0 + ai * HALF + m * 16) & (SEQ - 1); const f32x4* tp = (const f32x4*)(T32 + (size_t)pos * 16 + 4 * fq); tq0[m] = tp[0]; tq1[m] = tp[1]; }
            asm volatile("" ::: "memory");
#pragma unroll
            for (int m = 0; m < 4; ++m) { const int row = row0 + ai * HALF + m * 16; const float s = RS_(ai, m); bf16_t* rp = MQ + (size_t)row * 768 + u.pn * 256 + ct0;
                const f32x4 t0 = tq0[m], t1 = tq1[m];
#pragma unroll
                for (int bj = 0; bj < 2; ++bj) { const int G = 8 * u.pn + 4 * bj + wc; f32x4 x1 = acc[ai][bj][m][0] * s, x2 = acc[ai][bj][m][1] * s;
                    if (G % 3 == 2) rope4(x1, x2, t0, t1);
                    ST16(rp + bj * HALF, pack8(x1 * C2M, x2 * C2M)); } }
            asm volatile("" ::: "memory"); }
    }
};
struct EpiKV {
    bf16_t *KN, *MV; const float* SSQK;
    static constexpr bool NEEDS_RS = true, HAS_MID = false, HAS_INIT = false;
    __device__ __forceinline__ bool prefilled() const { return false; }
    __device__ __forceinline__ void rs_table(const Unit& u, LAS float* rtab) const { rs_fill<8>(SSQK, u.pm * BM, 1.f / 256.f, rtab); }
    __device__ __forceinline__ void operator()(const f32x4 (&acc)[2][2][4][2], const Unit& u, int wr, int wc, int fr, int fq, const LAS float* rtab) const {
        const int row0 = u.pm * BM + wr * 64 + fr, ct0 = wc * 32 + fq * 8; const LAS float* rt = rtab + wr * 64 + fr;
        bf16_t* dst = u.pn < 2 ? KN : MV; const int cb = (u.pn & 1) * 256;
#pragma unroll
        for (int ai = 0; ai < 2; ++ai)
#pragma unroll
            for (int m = 0; m < 4; ++m) { const int row = row0 + ai * HALF + m * 16; const float s = RS_(ai, m); bf16_t* rp = dst + (size_t)row * 512 + cb + ct0;
#pragma unroll
                for (int bj = 0; bj < 2; ++bj) ST16(rp + bj * HALF, pack8(acc[ai][bj][m][0] * s, acc[ai][bj][m][1] * s)); }
    }
};
struct EpiMerge {
    const unsigned char* GATES; bf16_t* MERGED;
    static constexpr bool NEEDS_RS = false, HAS_MID = true, HAS_INIT = false; static constexpr int MID0 = 8, MID1 = 24;
    static __device__ __forceinline__ void unpack_gate(const u32x2 g, f32x4& g0, f32x4& g1) {
        g0 = (f32x4){(float)(g.x & 255u), (float)((g.x >> 8) & 255u), (float)((g.x >> 16) & 255u), (float)(g.x >> 24)};
        g1 = (f32x4){(float)(g.y & 255u), (float)((g.y >> 8) & 255u), (float)((g.y >> 16) & 255u), (float)(g.y >> 24)}; }
    __device__ __forceinline__ void mid(f32x4 (&acc)[2][2][4][2], const Unit& u, int wr, int wc, int fr, int fq, int t) const {
        int row0 = ((wr * 4 + wc) * 16) * 512 + (fq * 16 + fr) * 8; asm volatile("" : "+v"(row0));
        const int br = t == MID0 ? 0 : 1;
        const unsigned char* gfb = GATES + ((size_t)(br * 64 + u.pm) * 4 + u.pn) * (8 * 16 * 64 * 8) + (size_t)row0;
#pragma unroll
        for (int ai = 0; ai < 2; ++ai) {
            u32x2 pq[8], nq[8];
#pragma unroll
            for (int sl = 0; sl < 8; ++sl) { const unsigned char* gp = gfb + (ai * 8 + sl) * 512; pq[sl] = *(const u32x2*)gp; nq[sl] = *(const u32x2*)(gp + (size_t)64 * 4 * (8 * 16 * 64 * 8)); }
            asm volatile("" ::: "memory");
#pragma unroll
            for (int m = 0; m < 4; ++m) {
#pragma unroll
                for (int bj = 0; bj < 2; ++bj) {
                    f32x4 p0, p1, n0, n1; unpack_gate(pq[m * 2 + bj], p0, p1); unpack_gate(nq[m * 2 + bj], n0, n1);
                    n0.x = __builtin_amdgcn_rcpf(n0.x); n0.y = __builtin_amdgcn_rcpf(n0.y); n0.z = __builtin_amdgcn_rcpf(n0.z); n0.w = __builtin_amdgcn_rcpf(n0.w);
                    n1.x = __builtin_amdgcn_rcpf(n1.x); n1.y = __builtin_amdgcn_rcpf(n1.y); n1.z = __builtin_amdgcn_rcpf(n1.z); n1.w = __builtin_amdgcn_rcpf(n1.w);
                    acc[ai][bj][m][0] = acc[ai][bj][m][0] * (p0 * n0); acc[ai][bj][m][1] = acc[ai][bj][m][1] * (p1 * n1); }
                }
            asm volatile("" ::: "memory"); }
    }
    __device__ __forceinline__ void operator()(const f32x4 (&acc)[2][2][4][2], const Unit& u, int wr, int wc, int fr, int fq, const LAS float* rtab) const {
        const int row0 = u.pm * BM + wr * 64 + fr, c0 = u.pn * BM + wc * 32 + fq * 8;
        const unsigned char* gfb = GATES + ((size_t)(2 * 64 + u.pm) * 4 + u.pn) * (8 * 16 * 64 * 8) + (size_t)((wr * 4 + wc) * 16) * 512 + (fq * 16 + fr) * 8;
        u32x2 gq[16];
#pragma unroll
        for (int sl = 0; sl < 16; ++sl) gq[sl] = *(const u32x2*)(gfb + sl * 512);
        asm volatile("" ::: "memory");
#pragma unroll
        for (int ai = 0; ai < 2; ++ai)
#pragma unroll
            for (int m = 0; m < 4; ++m) { const int row = row0 + ai * HALF + m * 16;
#pragma unroll
                for (int bj = 0; bj < 2; ++bj) { const int col = c0 + bj * HALF; f32x4 g0, g1; unpack_gate(gq[ai * 8 + m * 2 + bj], g0, g1);
                    *(u32x4*)(MERGED + (size_t)row * 1024 + col) = pack8(acc[ai][bj][m][0] * (g0 * (1.f / 255.f)), acc[ai][bj][m][1] * (g1 * (1.f / 255.f))); }
                }
    }
};
struct EpiResid {
    const float* xin; float* xo; bf16_t* XB; float* SSQ16; unsigned char* XB8 = nullptr;
    const bf16_t* xin16 = nullptr;
    static constexpr bool NEEDS_RS = false, HAS_MID = false, HAS_INIT = true;
    __device__ __forceinline__ void init(f32x4 (&acc)[2][2][4][2], const Unit& u, int wr, int wc, int fr, int fq) const {
        const int row0 = u.pm * BM + wr * 64 + fr, c0 = u.pn * BM + wc * 32 + fq * 8;
#pragma unroll
        for (int ai = 0; ai < 2; ++ai)
#pragma unroll
            for (int m = 0; m < 4; ++m)
#pragma unroll
                for (int bj = 0; bj < 2; ++bj) { const size_t off = (size_t)(row0 + ai * HALF + m * 16) * 1024 + c0 + bj * HALF;
                    if (xin16) { const u32x4 w = *(const u32x4*)(xin16 + off);
                        acc[ai][bj][m][0] = (f32x4){__uint_as_float(w.x << 16), __uint_as_float(w.x & 0xffff0000u), __uint_as_float(w.y << 16), __uint_as_float(w.y & 0xffff0000u)};
                        acc[ai][bj][m][1] = (f32x4){__uint_as_float(w.z << 16), __uint_as_float(w.z & 0xffff0000u), __uint_as_float(w.w << 16), __uint_as_float(w.w & 0xffff0000u)}; }
                    else { const float* p = xin + off; acc[ai][bj][m][0] = *(const f32x4*)p; acc[ai][bj][m][1] = *(const f32x4*)(p + 4); } }
    }
    __device__ __forceinline__ void operator()(const f32x4 (&acc)[2][2][4][2], const Unit& u, int wr, int wc, int fr, int fq, const LAS float* rtab) const {
        const int row0 = u.pm * BM + wr * 64 + fr, c0 = u.pn * BM + wc * 32 + fq * 8;
#pragma unroll
        for (int ai = 0; ai < 2; ++ai)
#pragma unroll
            for (int m = 0; m < 4; ++m) { const int row = row0 + ai * HALF + m * 16; float q = 0.f;
#pragma unroll
                for (int bj = 0; bj < 2; ++bj) { const size_t off = (size_t)row * 1024 + c0 + bj * HALF; const f32x4 a = acc[ai][bj][m][0], b = acc[ai][bj][m][1];
                    if (xo) { *(f32x4*)(xo + off) = a; *(f32x4*)(xo + off + 4) = b; } if (XB) *(u32x4*)(XB + off) = pack8(a, b); q += sum8sq(a, b);
                    if (XB8) *(u32x2*)(XB8 + off) = (u32x2){pk4_fp8(a.x, a.y, a.z, a.w), pk4_fp8(b.x, b.y, b.z, b.w)}; }
                q = add_xor<16>(q); q = add_xor<32>(q);
                if (fq == 0) SSQ16[(size_t)row * 16 + 4 * u.pn + wc] = q; }
    }
};
constexpr float ACT8_SC = 8.f;
template <bool MOE, bool OUT8 = false> struct EpiSwiglu {
    bf16_t* ACT; const float* RS; int arow0;
    int pre = 0; float wsc = 1.f;
    static constexpr bool NEEDS_RS = true, HAS_MID = false, HAS_INIT = false;
    __device__ __forceinline__ bool prefilled() const { return pre != 0; }
    __device__ __forceinline__ void rs_table(const Unit& u, LAS float* rtab) const {
        if constexpr (MOE) { const int tid = opaque_tid(); if ((tid & 1) == 0) rtab[tid >> 1] = RS[u.pm * BM + (tid >> 1)]; } else rs_fill<16>(RS, u.pm * BM, 1.f / 1024.f, rtab); }
    __device__ __forceinline__ void operator()(const f32x4 (&acc)[2][2][4][2], const Unit& u, int wr, int wc, int fr, int fq, const LAS float* rtab) const {
        const int row0 = u.pm * BM + wr * 64 + fr, c0 = u.pn * HALF + wc * 32 + fq * 8;
        const LAS float* rt = rtab + (pre ? 256 + ((pre == 2 ? u.k : u.pm) & 7) * 256 : 0) + wr * 64 + fr;
#pragma unroll
        for (int ai = 0; ai < 2; ++ai)
#pragma unroll
            for (int m = 0; m < 4; ++m) { const int row = row0 + ai * HALF + m * 16 - (MOE ? arow0 * BM : 0); const float s = RS_(ai, m) * wsc; f32x4 v[2];
#pragma unroll
                for (int n = 0; n < 2; ++n) { const f32x4 g = acc[ai][0][m][n] * s, up = acc[ai][1][m][n] * s; f32x4 sg; sg.x = sigmoidf_(g.x); sg.y = sigmoidf_(g.y); sg.z = sigmoidf_(g.z); sg.w = sigmoidf_(g.w); v[n] = g * sg * up; }
                if constexpr (OUT8) { v[0] *= ACT8_SC; v[1] *= ACT8_SC; *(u32x2*)((unsigned char*)ACT + (size_t)row * DFF + c0) = (u32x2){pk4_fp8(v[0].x, v[0].y, v[0].z, v[0].w), pk4_fp8(v[1].x, v[1].y, v[1].z, v[1].w)}; }
                else ST16(ACT + (size_t)row * DFF + c0, pack8(v[0], v[1])); }
    }
};
constexpr float Y8_SC = 16.f;
struct EpiY {
    bf16_t* Y; float osc = 1.f;
    static constexpr bool NEEDS_RS = false, HAS_MID = false, HAS_INIT = false;
    __device__ __forceinline__ void operator()(const f32x4 (&acc)[2][2][4][2], const Unit& u, int wr, int wc, int fr, int fq, const LAS float* rtab) const {
        const int row0 = u.pm * BM + wr * 64 + fr, c0 = u.pn * BM + wc * 32 + fq * 8;
#pragma unroll
        for (int ai = 0; ai < 2; ++ai)
#pragma unroll
            for (int m = 0; m < 4; ++m) { unsigned char* rp = (unsigned char*)Y + (size_t)(row0 + ai * HALF + m * 16) * 1024 + c0; const float sc = osc * Y8_SC;
#pragma unroll
                for (int bj = 0; bj < 2; ++bj) { const f32x4 a = acc[ai][bj][m][0] * sc, b = acc[ai][bj][m][1] * sc; *(u32x2*)(rp + bj * HALF) = (u32x2){pk4_fp8(a.x, a.y, a.z, a.w), pk4_fp8(b.x, b.y, b.z, b.w)}; } }
    }
};
struct EpiYPart {
    bf16_t* YP; int row_base; float osc = 1.f;
    static constexpr bool NEEDS_RS = false, HAS_MID = false, HAS_INIT = false;
    __device__ __forceinline__ void operator()(const f32x4 (&acc)[2][2][4][2], const Unit& u, int wr, int wc, int fr, int fq, const LAS float* rtab) const {
        const int row0 = u.pm * BM + wr * 64 + fr - row_base, c0 = (u.pn & 3) * BM + wc * 32 + fq * 8; bf16_t* base = YP + (size_t)(u.pn >> 2) * 2048 * 1024;
#pragma unroll
        for (int ai = 0; ai < 2; ++ai)
#pragma unroll
            for (int m = 0; m < 4; ++m) { bf16_t* rp = base + (size_t)(row0 + ai * HALF + m * 16) * 1024 + c0;
#pragma unroll
                for (int bj = 0; bj < 2; ++bj) *(u32x4*)(rp + bj * HALF) = pack8(acc[ai][bj][m][0] * osc, acc[ai][bj][m][1] * osc); }
    }
};
}

namespace att {
__device__ __forceinline__ int crow(int r, int hi) { return (r & 3) + 8 * (r >> 2) + 4 * hi; }
__device__ __forceinline__ void glds16(const void* gsrc, unsigned lds_dst) { unsigned keep;
    asm volatile("s_mov_b32 %0, m0\n\ts_mov_b32 m0, %2\n\ts_nop 0\n\tglobal_load_lds_dwordx4 %1, off\n\ts_mov_b32 m0, %0" : "=&s"(keep) : "v"(gsrc), "s"(lds_dst) : "memory"); }
#define ATT_RFL(x) ((unsigned)__builtin_amdgcn_readfirstlane((int)(x)))
#define ATT_WAIT_BAR(N) asm volatile("s_waitcnt vmcnt(" #N ") lgkmcnt(0)\n\ts_barrier" ::: "memory")
#define ATT_SBAR() __builtin_amdgcn_sched_barrier(0)
#define ATT_MFMA(a, b, c) __builtin_amdgcn_mfma_f32_32x32x16_bf16(a, b, c, 0, 0, 0)
typedef LAS const char* lds_cptr;
typedef short v4i16_t __attribute__((ext_vector_type(4)));
__device__ __forceinline__ bf16x8 ldsv(lds_cptr p) { return *(const LAS bf16x8*)p; }
#define ATT_TRI(lo_, hi_, base, off0, off1) do { asm volatile("ds_read_b64_tr_b16 %0, %1 offset:%c2" : "=&v"(lo_) : "v"(base), "i"(off0) : "memory"); \
    asm volatile("ds_read_b64_tr_b16 %0, %1 offset:%c2" : "=&v"(hi_) : "v"(base), "i"(off1) : "memory"); } while (0)
#define ATT_TRW() do { asm volatile("s_waitcnt lgkmcnt(0)" ::: "memory"); ATT_SBAR(); } while (0)
#define ATT_FR(lo_, hi_) ((bf16x8){lo_[0], lo_[1], lo_[2], lo_[3], hi_[0], hi_[1], hi_[2], hi_[3]})

__device__ __forceinline__ float rowmax32(const f32x16& p0, const f32x16& p1) {
    float a = fmaxf(fmaxf(p0[0], p0[1]), p1[0]), b = fmaxf(fmaxf(p0[2], p0[3]), p1[1]); a = fmaxf(fmaxf(a, p1[2]), p1[3]);
#pragma unroll
    for (int r = 4; r < 16; r += 4) { a = fmaxf(fmaxf(a, p0[r]), p0[r + 1]); b = fmaxf(fmaxf(b, p0[r + 2]), p0[r + 3]); a = fmaxf(fmaxf(a, p1[r]), p1[r + 1]); b = fmaxf(fmaxf(b, p1[r + 2]), p1[r + 3]); }
    const float m = fmaxf(a, b); auto rr = __builtin_amdgcn_permlane32_swap(__float_as_uint(m), __float_as_uint(m), false, false);
    return fmaxf(__uint_as_float(rr[0]), __uint_as_float(rr[1]));
}

template <int NS, bool BIAS, int NCH>
__device__ __forceinline__ void attn_unit2(int qb, const bf16_t* Qh, int qp, const bf16_t* KAh, int kap, const bf16_t* KBh, int kbp, const bf16_t* Vh, int vp, bf16_t* Oh, int op, const float* cumf, float kmax, LAS char* shm) {
    constexpr int NQ = BIAS ? NS - 1 : NS, NM = 2 * NS;
    constexpr int KSL = NCH * 1024, LDS_K = 0, LDS_V = 4 * KSL, LDS_WS = LDS_V + 3 * 8192, LDS_QX = LDS_WS + 8 * 256, LDS_OST = LDS_QX + 64;
    static_assert(LDS_OST + 8 * 4096 <= 131072 && (NM == 10 || NM == 12), "attention LDS / k-steps");
    const int tid = opaque_tid(), lane = tid & 63, r32 = lane & 31, hi = lane >> 5; const int wid = __builtin_amdgcn_readfirstlane(tid >> 6);
    const int q0 = qb * 256, NT = (q0 + 256) / 64;
    const bf16_t* Qw = Qh + (long)(q0 + wid * 32) * qp;
    const unsigned lds0 = (unsigned)(uintptr_t)shm;
    LAS float* wsf = (LAS float*)(shm + LDS_WS) + wid * 64;
    const bool hasB = wid < NCH - 8;
    const bf16_t* ksrcA = KAh + (long)lane * kap + wid * 8;
    const bf16_t* ksrcB = KBh + (long)lane * kbp + (BIAS ? 0 : wid * 8);
    const bf16_t* vsrc = Vh + (long)(16 * (wid & 3) + (lane >> 2)) * vp + (wid >> 2) * 32 + (lane & 3) * 8;
    const unsigned kdstA = lds0 + LDS_K + wid * 1024, kdstB = lds0 + LDS_K + (8 + wid) * 1024, vdst = lds0 + LDS_V + wid * 1024;
#define A2_TILE(s) ((s) < 4 ? NT - 4 + (s) : NT - 1 - (s))
#define A2_DMA_K(t, sb) do { glds16(ksrcA + (long)A2_TILE(t) * 64 * kap, ATT_RFL(kdstA + (sb))); if (hasB) glds16(ksrcB + (long)A2_TILE(t) * 64 * kbp, ATT_RFL(kdstB + (sb))); } while (0)
#define A2_DMA_V(t, sb) glds16(vsrc + (long)A2_TILE(t) * 64 * vp, ATT_RFL(vdst + (sb)))
#define A2_WB(a, b) do { if (hasB) { ATT_WAIT_BAR(b); } else { ATT_WAIT_BAR(a); } } while (0)
#define A2_KS(t) (((t) & 3) * KSL)
    const lds_cptr vp0 = (lds_cptr)shm + LDS_V + ((lane >> 4) & 1) * 32 + (lane & 3) * 8 + (4 * hi + ((lane & 15) >> 2)) * 64;
    const lds_cptr kp0 = (lds_cptr)shm + LDS_K + hi * 1024 + r32 * 16, kpb = (lds_cptr)shm + LDS_K + 8192 + r32 * 16;
    A2_DMA_K(0, 0); A2_DMA_V(0, 0); A2_DMA_K(1, KSL);
    bf16x8 qr[NS];
#pragma unroll
    for (int d0 = 0; d0 < NQ; ++d0) qr[d0] = *(const bf16x8*)(Qw + (long)r32 * qp + d0 * 16 + hi * 8);
    if constexpr (BIAS) { const short o1 = hi ? (short)0 : (short)0x3F80; qr[NS - 1] = (bf16x8){o1, o1, o1, 0, 0, 0, 0, 0}; }
    float mhat = 0.f, l_reg = 0.f; f32x16 o[2];
#pragma unroll
    for (int r = 0; r < 16; ++r) { o[0][r] = 0.f; o[1][r] = 0.f; }
    f32x16 negm;
#pragma unroll
    for (int r = 0; r < 16; ++r) negm[r] = 0.f;
    asm volatile("" : "+v"(negm));
    const int qrel = wid * 32 + r32; bool resc = false;
    f32x16 pA0, pA1, pB0, pB1; bf16x8 kf[4]; s16x4 vlo[8], vhi[8]; u32x4 pw0, pw1, pw2, pw3;
    int vs_prev = 0, vs_cur = 0, vs_next = 8192;
#define A2_ROT() do { vs_prev = vs_cur; vs_cur = vs_next; vs_next = (vs_next == 16384) ? 0 : vs_next + 8192; } while (0)
#define A2_KADDR(kq, kqb, j) ((BIAS && ((j) >> 1) == NS - 1) ? ((kqb) + ((j) & 1) * 512) : ((kq) + ((j) >> 1) * 2048 + ((j) & 1) * 512))
#define A2_CMASK(P0, P1, t) do { const int jb_ = (t) - (NT - 4); if (jb_ >= 0) { const int kb_ = 64 * jb_ + 4 * hi; \
        _Pragma("unroll") for (int r = 0; r < 16; ++r) { const int kv_ = kb_ + (r & 3) + 8 * (r >> 2); if (kv_ > qrel) P0[r] = -INFINITY; if (kv_ + 32 > qrel) P1[r] = -INFINITY; } } } while (0)
#define A2_RESC() do { if (resc) { asm volatile("s_waitcnt lgkmcnt(0)" ::: "memory"); \
        _Pragma("unroll") for (int d_ = 0; d_ < 2; ++d_) _Pragma("unroll") for (int r = 0; r < 16; ++r) o[d_][r] *= wsf[crow(r, hi)]; } } while (0)
    A2_DMA_K(2, 2 * KSL);
    if constexpr (BIAS) {
        float qs = 0.f;
#pragma unroll
        for (int d0 = 0; d0 < NQ; ++d0)
#pragma unroll
            for (int j = 0; j < 8; ++j) { const float v = bf2f((unsigned short)qr[d0][j]); qs += v * v; }
        { auto rr = __builtin_amdgcn_permlane32_swap(__float_as_uint(qs), __float_as_uint(qs), false, false); qs = __uint_as_float(rr[0]) + __uint_as_float(rr[1]); }
        qs = fmaxf(qs, __int_as_float(__builtin_amdgcn_ds_swizzle(__float_as_int(qs), (1 << 10) | 0x1F))); qs = fmaxf(qs, __int_as_float(__builtin_amdgcn_ds_swizzle(__float_as_int(qs), (2 << 10) | 0x1F)));
        qs = fmaxf(qs, __int_as_float(__builtin_amdgcn_ds_swizzle(__float_as_int(qs), (4 << 10) | 0x1F))); qs = fmaxf(qs, __int_as_float(__builtin_amdgcn_ds_swizzle(__float_as_int(qs), (8 << 10) | 0x1F)));
        qs = fmaxf(qs, __int_as_float(__builtin_amdgcn_ds_swizzle(__float_as_int(qs), (16 << 10) | 0x1F)));
        if (lane == 0) ((LAS float*)(shm + LDS_QX))[wid] = qs;
    }
    A2_WB(3, 5);
    int NSTEP = NT;
    if constexpr (BIAS) { if (NT > 4) {
        const LAS float* qx = (const LAS float*)(shm + LDS_QX); float qm = fmaxf(fmaxf(fmaxf(qx[0], qx[1]), fmaxf(qx[2], qx[3])), fmaxf(fmaxf(qx[4], qx[5]), fmaxf(qx[6], qx[7])));
        const float lim = cumf[q0] - 32.f - 2.f * __builtin_sqrtf(qm) * kmax * 1.0001f;
        const int T0 = lane, T1 = lane + 64; const bool c0 = (T0 < NT - 4) && (cumf[64 * T0 + 63] <= lim), c1 = (T1 < NT - 4) && (cumf[64 * T1 + 63] <= lim);
        const int nskip = (__popcll(__ballot(c0)) + __popcll(__ballot(c1))) & ~1; NSTEP = __builtin_amdgcn_readfirstlane(NT - nskip); } }
    { const lds_cptr kq_ = kp0, kqb_ = kpb;
#pragma unroll
      for (int j = 0; j < NM; ++j) { const bf16x8 f = ldsv(A2_KADDR(kq_, kqb_, j)); if (j & 1) pA1 = ATT_MFMA(f, qr[j >> 1], j < 2 ? negm : pA1); else pA0 = ATT_MFMA(f, qr[j >> 1], j < 2 ? negm : pA0); } }
    A2_CMASK(pA0, pA1, A2_TILE(0));
    { const float rm = rowmax32(pA0, pA1); mhat += rm;
#pragma unroll
      for (int r = 0; r < 16; ++r) { pA0[r] -= rm; pA1[r] -= rm; }
#pragma unroll
      for (int r = 0; r < 16; ++r) negm[r] = -mhat;
      asm volatile("" : "+v"(negm));
#pragma unroll
      for (int r = 0; r < 16; ++r) { pA0[r] = fexp2(pA0[r]); pA1[r] = fexp2(pA1[r]); } }
    ATT_WAIT_BAR(0);
    A2_DMA_K(3, 3 * KSL); A2_DMA_V(1, 8192);
    A2_ROT();
    { const lds_cptr kq_ = kp0 + A2_KS(1), kqb_ = kpb + A2_KS(1); kf[0] = ldsv(A2_KADDR(kq_, kqb_, 0)); kf[1] = ldsv(A2_KADDR(kq_, kqb_, 1)); kf[2] = ldsv(A2_KADDR(kq_, kqb_, 2)); }
#define A2_PKW(P, B) pk2(P[B], P[B + 1])
#define A2_PAF(k) __builtin_bit_cast(bf16x8, pw##k)
#define A2_VFR(i) ((bf16x8){vlo[i][0], vlo[i][1], vlo[i][2], vlo[i][3], vhi[i][0], vhi[i][1], vhi[i][2], vhi[i][3]})
#define A2_PIN(x) asm volatile("" : "+v"(x))
#define A2_VTR(p) __builtin_bit_cast(s16x4, __builtin_amdgcn_ds_read_tr16_b64_v4i16((LAS v4i16_t*)(p)))
#define A2_VRD(i) do { vlo[i] = A2_VTR(vp_ + (((i) >> 2) * 4096 + ((i) & 3) * 1024)); vhi[i] = A2_VTR(vp_ + (((i) >> 2) * 4096 + ((i) & 3) * 1024 + 512)); } while (0)
#define A2_KJ(j) do { if ((j) < NM) kf[(j) % 4] = ldsv(A2_KADDR(kq_, kqb_, (j))); } while (0)
#define A2_GAPA(MF, a0, a1, a2, a3, W0, W1, PW) do { MF; sacc += a0; sacc += a1; sacc += a2; sacc += a3; A2_PIN(sacc); W0; W1; A2_PIN(PW); ATT_SBAR(); } while (0)
#define A2_GAPB(MF, X, B) do { MF; X[B] = fexp2(X[B]); X[B + 1] = fexp2(X[B + 1]); X[B + 2] = fexp2(X[B + 2]); X[B + 3] = fexp2(X[B + 3]); A2_PIN(X); ATT_SBAR(); } while (0)
#define A2_MX3(a, b, c) __builtin_fmaxf(__builtin_fmaxf((a), (b)), (c))
#define A2_STEP(C0, C1, P0, P1, t, GK, GV, GL) do { ATT_SBAR(); \
    const lds_cptr vp_ = vp0 + vs_prev; const lds_cptr kq_ = kp0 + A2_KS(t), kqb_ = kpb + A2_KS(t); \
    A2_VRD(0); A2_KJ(3); ATT_SBAR(); float sacc = (P0[0] + P0[1]); \
    A2_GAPA(C0 = ATT_MFMA(kf[0], qr[0], negm), P0[2], P0[3], P0[4], P0[5],     pw0[0] = A2_PKW(P0, 0), pw0[1] = A2_PKW(P0, 2), pw0); \
    A2_VRD(4); A2_KJ(4); ATT_SBAR(); A2_GAPA(C1 = ATT_MFMA(kf[1], qr[0], negm), P0[6], P0[7], P0[8], P0[9],     pw0[2] = A2_PKW(P0, 4), pw0[3] = A2_PKW(P0, 6), pw0); \
    A2_VRD(1); A2_KJ(5); ATT_SBAR(); A2_GAPA(C0 = ATT_MFMA(kf[2], qr[1], C0),   P0[10], P0[11], P0[12], P0[13], pw1[0] = A2_PKW(P0, 8), pw1[1] = A2_PKW(P0, 10), pw1); \
    A2_VRD(5); A2_KJ(6); ATT_SBAR(); A2_GAPA(C1 = ATT_MFMA(kf[3], qr[1], C1),   P0[14], P0[15], P1[0], P1[1],   pw1[2] = A2_PKW(P0, 12), pw1[3] = A2_PKW(P0, 14), pw1); \
    A2_VRD(2); A2_KJ(7); ATT_SBAR(); A2_GAPA(C0 = ATT_MFMA(kf[0], qr[2], C0),   P1[2], P1[3], P1[4], P1[5],     pw2[0] = A2_PKW(P1, 0), pw2[1] = A2_PKW(P1, 2), pw2); \
    A2_VRD(6); A2_KJ(8); ATT_SBAR(); A2_GAPA(C1 = ATT_MFMA(kf[1], qr[2], C1),   P1[6], P1[7], P1[8], P1[9],     pw2[2] = A2_PKW(P1, 4), pw2[3] = A2_PKW(P1, 6), pw2); \
    A2_VRD(3); A2_KJ(9); ATT_SBAR(); A2_GAPA(C0 = ATT_MFMA(kf[2], qr[3], C0),   P1[10], P1[11], P1[12], P1[13], pw3[0] = A2_PKW(P1, 8), pw3[1] = A2_PKW(P1, 10), pw3); \
    A2_VRD(7); A2_KJ(10); ATT_SBAR(); A2_GAPA(C1 = ATT_MFMA(kf[3], qr[3], C1),  P1[14], P1[15], 0.f, 0.f,       pw3[2] = A2_PKW(P1, 12), pw3[3] = A2_PKW(P1, 14), pw3); \
    A2_KJ(11); ATT_SBAR(); C0 = ATT_MFMA(kf[0], qr[4], C0); ATT_SBAR(); \
    C1 = ATT_MFMA(kf[1], qr[4], C1); ATT_SBAR(); \
    if constexpr (NM > 10) { C0 = ATT_MFMA(kf[2], qr[NS - 1], C0); ATT_SBAR(); C1 = ATT_MFMA(kf[3], qr[NS - 1], C1); ATT_SBAR(); } \
    l_reg += sacc; \
    if (GK) { A2_DMA_K((t) + 3, A2_KS((t) + 3)); } if (GV) { A2_DMA_V((t) + 1, vs_next); } \
    A2_CMASK(C0, C1, A2_TILE(t)); \
    { float a = A2_MX3(C0[0], C0[1], C1[0]), b = A2_MX3(C0[2], C0[3], C1[1]); a = A2_MX3(a, C1[2], C1[3]); \
      _Pragma("unroll") for (int r = 4; r < 16; r += 4) { a = A2_MX3(a, C0[r], C0[r + 1]); b = A2_MX3(b, C0[r + 2], C0[r + 3]); a = A2_MX3(a, C1[r], C1[r + 1]); b = A2_MX3(b, C1[r + 2], C1[r + 3]); } \
      float rm = __builtin_fmaxf(a, b); { auto rr = __builtin_amdgcn_permlane32_swap(__float_as_uint(rm), __float_as_uint(rm), false, false); rm = __builtin_fmaxf(__uint_as_float(rr[0]), __uint_as_float(rr[1])); } \
      resc = false; \
      if (__builtin_expect(__any(rm > 8.f), 0)) { const float dl = __builtin_fmaxf(rm, 0.f); mhat += dl; \
        _Pragma("unroll") for (int r = 0; r < 16; ++r) { C0[r] -= dl; C1[r] -= dl; } \
        _Pragma("unroll") for (int r = 0; r < 16; ++r) negm[r] = -mhat; asm volatile("" : "+v"(negm)); \
        const float f = fexp2(-dl); l_reg *= f; if (hi == 0) wsf[r32] = f; resc = true; } } \
    ATT_SBAR(); \
    A2_GAPB(o[0] = ATT_MFMA(A2_PAF(0), A2_VFR(0), o[0]), C0, 0); \
    A2_GAPB(o[1] = ATT_MFMA(A2_PAF(0), A2_VFR(4), o[1]), C0, 4); \
    A2_GAPB(o[0] = ATT_MFMA(A2_PAF(1), A2_VFR(1), o[0]), C0, 8); \
    if (GL) { const lds_cptr kn_ = kp0 + A2_KS((t) + 1), knb_ = kpb + A2_KS((t) + 1); kf[0] = ldsv(A2_KADDR(kn_, knb_, 0)); kf[1] = ldsv(A2_KADDR(kn_, knb_, 1)); kf[2] = ldsv(A2_KADDR(kn_, knb_, 2)); ATT_SBAR(); } \
    A2_GAPB(o[1] = ATT_MFMA(A2_PAF(1), A2_VFR(5), o[1]), C0, 12); \
    A2_GAPB(o[0] = ATT_MFMA(A2_PAF(2), A2_VFR(2), o[0]), C1, 0); \
    A2_GAPB(o[1] = ATT_MFMA(A2_PAF(2), A2_VFR(6), o[1]), C1, 4); \
    A2_GAPB(o[0] = ATT_MFMA(A2_PAF(3), A2_VFR(3), o[0]), C1, 8); \
    A2_GAPB(o[1] = ATT_MFMA(A2_PAF(3), A2_VFR(7), o[1]), C1, 12); \
    } while (0)
    int t = 1;
    for (; t + 5 < NSTEP; t += 2) {
        A2_STEP(pB0, pB1, pA0, pA1, t, true, true, true);     A2_WB(2, 3); A2_RESC(); A2_ROT();
        A2_STEP(pA0, pA1, pB0, pB1, t + 1, true, true, true); A2_WB(2, 3); A2_RESC(); A2_ROT();
    }
#define A2_ENDW(tt) do { if ((tt) + 3 < NSTEP) { A2_WB(2, 3); } else if ((tt) + 2 < NSTEP) { ATT_WAIT_BAR(1); } else { ATT_WAIT_BAR(0); } } while (0)
    for (; t + 1 < NSTEP; t += 2) {
        A2_STEP(pB0, pB1, pA0, pA1, t, (t + 3 < NSTEP), (t + 1 < NSTEP), (t + 1 < NSTEP));         A2_ENDW(t);     A2_RESC(); A2_ROT();
        A2_STEP(pA0, pA1, pB0, pB1, t + 1, (t + 4 < NSTEP), (t + 2 < NSTEP), (t + 2 < NSTEP));     A2_ENDW(t + 1); A2_RESC(); A2_ROT();
    }
    A2_STEP(pB0, pB1, pA0, pA1, NSTEP - 1, false, false, false); A2_RESC();
    { float sacc = pB0[0] + pB0[1];
#pragma unroll
      for (int r = 2; r < 16; ++r) sacc += pB0[r];
#pragma unroll
      for (int r = 0; r < 16; ++r) sacc += pB1[r];
      l_reg += sacc;
      pw0 = (u32x4){A2_PKW(pB0, 0), A2_PKW(pB0, 2), A2_PKW(pB0, 4), A2_PKW(pB0, 6)}; pw1 = (u32x4){A2_PKW(pB0, 8), A2_PKW(pB0, 10), A2_PKW(pB0, 12), A2_PKW(pB0, 14)};
      pw2 = (u32x4){A2_PKW(pB1, 0), A2_PKW(pB1, 2), A2_PKW(pB1, 4), A2_PKW(pB1, 6)}; pw3 = (u32x4){A2_PKW(pB1, 8), A2_PKW(pB1, 10), A2_PKW(pB1, 12), A2_PKW(pB1, 14)};
      const lds_cptr vp_ = vp0 + vs_cur;
#pragma unroll
      for (int i = 0; i < 8; ++i) A2_VRD(i);
      o[0] = ATT_MFMA(A2_PAF(0), A2_VFR(0), o[0]); o[1] = ATT_MFMA(A2_PAF(0), A2_VFR(4), o[1]); o[0] = ATT_MFMA(A2_PAF(1), A2_VFR(1), o[0]); o[1] = ATT_MFMA(A2_PAF(1), A2_VFR(5), o[1]);
      o[0] = ATT_MFMA(A2_PAF(2), A2_VFR(2), o[0]); o[1] = ATT_MFMA(A2_PAF(2), A2_VFR(6), o[1]); o[0] = ATT_MFMA(A2_PAF(3), A2_VFR(3), o[0]); o[1] = ATT_MFMA(A2_PAF(3), A2_VFR(7), o[1]); }
    { auto rr = __builtin_amdgcn_permlane32_swap(__float_as_uint(l_reg), __float_as_uint(l_reg), false, false); l_reg = __uint_as_float(rr[0]) + __uint_as_float(rr[1]); }
    if (hi == 0) wsf[32 + r32] = l_reg;
    asm volatile("s_waitcnt lgkmcnt(0)" ::: "memory");
    float rli[16];
#pragma unroll
    for (int r = 0; r < 16; ++r) rli[r] = __builtin_amdgcn_rcpf(wsf[32 + crow(r, hi)]);
    bf16_t* Ow = Oh + (long)(q0 + wid * 32) * op;
    { LAS bf16_t* stg = (LAS bf16_t*)(shm + LDS_OST) + wid * 2048;
#pragma unroll
        for (int r = 0; r < 16; ++r) { const int orow = crow(r, hi);
#pragma unroll
            for (int d0 = 0; d0 < 2; ++d0) stg[orow * 64 + d0 * 32 + r32] = f2bf(o[d0][r] * rli[r]); }
        asm volatile("s_waitcnt lgkmcnt(0)" ::: "memory");
#pragma unroll
        for (int i = 0; i < 4; ++i) { const int row = i * 8 + (lane >> 3), ch = lane & 7; const u32x4 v = *(const LAS u32x4*)(stg + row * 64 + ch * 8); *(u32x4*)(Ow + (long)row * op + ch * 8) = v; } }
    asm volatile("s_waitcnt lgkmcnt(0)\n\ts_barrier" ::: "memory");
#undef A2_TILE
#undef A2_DMA_K
#undef A2_DMA_V
#undef A2_WB
#undef A2_KS
#undef A2_ROT
#undef A2_KADDR
#undef A2_CMASK
#undef A2_RESC
#undef A2_PKW
#undef A2_PAF
#undef A2_VFR
#undef A2_PIN
#undef A2_VTR
#undef A2_VRD
#undef A2_KJ
#undef A2_GAPA
#undef A2_GAPB
#undef A2_MX3
#undef A2_STEP
#undef A2_ENDW
}

__device__ __forceinline__ void tstate_run(int u0, int stride, int n, const bf16_t* KG, const bf16_t* RV, float* T, LAS char* shm) {
    const int tid = opaque_tid(), lane = tid & 63, r32 = lane & 31, hi = lane >> 5; const int wid = __builtin_amdgcn_readfirstlane(tid >> 6);
    const unsigned lds0 = (unsigned)(uintptr_t)shm;
    const int dblk = wid >> 2, db = wid & 3;
#define TS_DMA(u, buf) do { const int bh_ = (u) >> 6, c_ = (u) & 63; const long row0_ = (long)(bh_ >> 3) * SEQ + (long)c_ * 128; const int h_ = bh_ & 7; \
    _Pragma("unroll") for (int i = 0; i < 2; ++i) { const int kp = wid * 2 + i, c8 = kp >> 1, rh = kp & 1; glds16(KG + (row0_ + 64 * rh + lane) * 512 + h_ * 64 + 8 * c8, ATT_RFL(lds0 + (buf) * 49152 + c8 * 2048 + rh * 1024)); } \
    _Pragma("unroll") for (int i = 0; i < 4; ++i) { const int vp = wid * 4 + i, db_ = vp >> 3, j = vp & 7; glds16(RV + (row0_ + 16 * j + (lane >> 2)) * 1024 + h_ * 128 + 32 * db_ + (lane & 3) * 8, ATT_RFL(lds0 + (buf) * 49152 + 16384 + db_ * 8192 + j * 1024)); } } while (0)
    if (n <= 0) return;
    TS_DMA(u0, 0);
    for (int k = 0; k < n; ++k) {
        const int u = u0 + k * stride, buf = k & 1;
        if (k + 1 < n) { TS_DMA(u + stride, buf ^ 1); ATT_WAIT_BAR(6); } else ATT_WAIT_BAR(0);
        const int ab = (int)lds0 + buf * 49152 + (4 * dblk + 2 * ((lane >> 4) & 1) + ((lane & 3) >> 1)) * 2048 + (8 * hi + ((lane & 15) >> 2)) * 16 + (lane & 1) * 8;
        const int vb = (int)lds0 + buf * 49152 + 16384 + db * 8192 + (8 * hi + ((lane & 15) >> 2)) * 64 + ((lane >> 4) & 1) * 32 + (lane & 3) * 8;
        f32x16 acc;
#pragma unroll
        for (int r = 0; r < 16; ++r) acc[r] = 0.f;
#pragma unroll
        for (int ks = 0; ks < 8; ks += 2) { s16x4 al0, ah0, bl0, bh0, al1, ah1, bl1, bh1;
            ATT_TRI(al0, ah0, ab, ks * 256, ks * 256 + 64); ATT_TRI(bl0, bh0, vb, ks * 1024, ks * 1024 + 256); ATT_TRI(al1, ah1, ab, ks * 256 + 256, ks * 256 + 320); ATT_TRI(bl1, bh1, vb, ks * 1024 + 1024, ks * 1024 + 1280);
            ATT_TRW(); acc = ATT_MFMA(ATT_FR(al0, ah0), ATT_FR(bl0, bh0), acc); acc = ATT_MFMA(ATT_FR(al1, ah1), ATT_FR(bl1, bh1), acc); }
        float* Tp = T + ((size_t)u * 64 + 32 * dblk) * 128 + 32 * db + r32;
#pragma unroll
        for (int r = 0; r < 16; ++r) Tp[(size_t)crow(r, hi) * 128] = acc[r];
        asm volatile("s_waitcnt lgkmcnt(0)\n\ts_barrier" ::: "memory");
    }
#undef TS_DMA
}

__device__ __forceinline__ void ret_unit(int bh, int cp, const bf16_t* RQ, const bf16_t* KG, const bf16_t* RV, const bf16_t* RP, const bf16_t* RG, const float* gnw, bf16_t* OR, LAS char* shm) {
    const int tid = opaque_tid(), lane = tid & 63, r32 = lane & 31, hi = lane >> 5; const int wid = __builtin_amdgcn_readfirstlane(tid >> 6);
    const int hw = wid >> 2, wq = wid & 3, b = bh >> 3, h = bh & 7, c = 2 * cp + hw; const long row0 = (long)b * SEQ + (long)c * 128;
    const unsigned lds0 = (unsigned)(uintptr_t)shm + hw * 65536u;
    bf16x8 qr[4];
#pragma unroll
    for (int d0 = 0; d0 < 4; ++d0) qr[d0] = *(const bf16x8*)(RQ + (row0 + 32 * wq + r32) * 512 + h * 64 + 16 * d0 + 8 * hi);
#pragma unroll
    for (int i = 0; i < 4; ++i) { const int kp = wq * 4 + i, c8 = kp >> 1, rh = kp & 1; glds16(KG + (row0 + 64 * rh + lane) * 512 + h * 64 + 8 * c8, ATT_RFL(lds0 + c8 * 2048 + rh * 1024)); }
#pragma unroll
    for (int i = 0; i < 8; ++i) { const int vp = wq * 8 + i, db = vp >> 3, j = vp & 7; glds16(RV + (row0 + 16 * j + (lane >> 2)) * 1024 + h * 128 + 32 * db + (lane & 3) * 8, ATT_RFL(lds0 + 16384 + db * 8192 + j * 1024)); }
#pragma unroll
    for (int i = 0; i < 4; ++i) { const int rp = wq * 4 + i, db = rp >> 2, j = rp & 3; glds16(RP + ((size_t)(bh * 64 + c) * 64 + 16 * j + (lane >> 2)) * 128 + 32 * db + (lane & 3) * 8, ATT_RFL(lds0 + 49152 + db * 4096 + j * 1024)); }
    ATT_WAIT_BAR(0);
    f32x16 o[4];
#pragma unroll
    for (int d = 0; d < 4; ++d)
#pragma unroll
        for (int r = 0; r < 16; ++r) o[d][r] = 0.f;
    const lds_cptr kbase = (lds_cptr)shm + hw * 65536 + hi * 2048 + r32 * 16;
    const int vb0 = (int)lds0 + 16384 + ((lane >> 4) & 1) * 32 + (lane & 3) * 8 + (4 * hi + ((lane & 15) >> 2)) * 64;
    for (int kt = 0; kt <= wq; ++kt) {
        f32x16 p;
#pragma unroll
        for (int r = 0; r < 16; ++r) p[r] = 0.f;
#pragma unroll
        for (int d0 = 0; d0 < 4; ++d0) p = ATT_MFMA(ldsv(kbase + d0 * 4096 + kt * 512), qr[d0], p);
        if (kt == wq) {
#pragma unroll
            for (int r = 0; r < 16; ++r) if (crow(r, hi) > r32) p[r] = 0.f; }
        const u32x4 pw0 = {pk2(p[0], p[1]), pk2(p[2], p[3]), pk2(p[4], p[5]), pk2(p[6], p[7])}, pw1 = {pk2(p[8], p[9]), pk2(p[10], p[11]), pk2(p[12], p[13]), pk2(p[14], p[15])};
        const int vb = vb0 + kt * 2048;
        { s16x4 l0[4], h0[4], l1[4], h1[4];
#pragma unroll
          for (int db = 0; db < 4; ++db) { ATT_TRI(l0[db], h0[db], vb, db * 8192, db * 8192 + 512); ATT_TRI(l1[db], h1[db], vb, db * 8192 + 1024, db * 8192 + 1536); }
          ATT_TRW();
#pragma unroll
          for (int db = 0; db < 4; ++db) { o[db] = ATT_MFMA(__builtin_bit_cast(bf16x8, pw0), ATT_FR(l0[db], h0[db]), o[db]); o[db] = ATT_MFMA(__builtin_bit_cast(bf16x8, pw1), ATT_FR(l1[db], h1[db]), o[db]); } }
    }
    { const int rb = (int)lds0 + 49152 + ((lane >> 4) & 1) * 32 + (lane & 3) * 8 + (8 * hi + ((lane & 15) >> 2)) * 64;
#pragma unroll
        for (int dp = 0; dp < 4; dp += 2) { s16x4 l0[2], h0[2], l1[2], h1[2], l2[2], h2[2], l3[2], h3[2];
#pragma unroll
            for (int e = 0; e < 2; ++e) { const int db = dp + e; ATT_TRI(l0[e], h0[e], rb, db * 4096, db * 4096 + 256); ATT_TRI(l1[e], h1[e], rb, db * 4096 + 1024, db * 4096 + 1280); ATT_TRI(l2[e], h2[e], rb, db * 4096 + 2048, db * 4096 + 2304); ATT_TRI(l3[e], h3[e], rb, db * 4096 + 3072, db * 4096 + 3328); }
            ATT_TRW();
#pragma unroll
            for (int e = 0; e < 2; ++e) { const int db = dp + e; o[db] = ATT_MFMA(qr[0], ATT_FR(l0[e], h0[e]), o[db]); o[db] = ATT_MFMA(qr[1], ATT_FR(l1[e], h1[e]), o[db]); o[db] = ATT_MFMA(qr[2], ATT_FR(l2[e], h2[e]), o[db]); o[db] = ATT_MFMA(qr[3], ATT_FR(l3[e], h3[e]), o[db]); } } }
    asm volatile("s_waitcnt lgkmcnt(0)\n\ts_barrier" ::: "memory");
    const float lg = lg2gamma(h);
    float gw[4];
#pragma unroll
    for (int db = 0; db < 4; ++db) gw[db] = gnw[h * 128 + 32 * db + r32];
    float s1[16], s2[16];
#pragma unroll
    for (int r = 0; r < 16; ++r) { const int n = 32 * wq + crow(r, hi); const float g = fexp2((float)n * lg);
        o[0][r] *= g; o[1][r] *= g; o[2][r] *= g; o[3][r] *= g; s1[r] = (o[0][r] + o[1][r]) + (o[2][r] + o[3][r]); }
#pragma unroll
    for (int r = 0; r < 16; ++r) s1[r] = add_xor<1>(s1[r]);
#pragma unroll
    for (int r = 0; r < 16; ++r) s1[r] = add_xor<2>(s1[r]);
#pragma unroll
    for (int r = 0; r < 16; ++r) s1[r] = add_xor<4>(s1[r]);
#pragma unroll
    for (int r = 0; r < 16; ++r) s1[r] = add_xor<8>(s1[r]);
#pragma unroll
    for (int r = 0; r < 16; ++r) s1[r] = add_xor<16>(s1[r]);
#pragma unroll
    for (int r = 0; r < 16; ++r) { const float mu = s1[r] * (1.f / 128.f); o[0][r] -= mu; o[1][r] -= mu; o[2][r] -= mu; o[3][r] -= mu; s2[r] = (o[0][r] * o[0][r] + o[1][r] * o[1][r]) + (o[2][r] * o[2][r] + o[3][r] * o[3][r]); }
#pragma unroll
    for (int r = 0; r < 16; ++r) s2[r] = add_xor<1>(s2[r]);
#pragma unroll
    for (int r = 0; r < 16; ++r) s2[r] = add_xor<2>(s2[r]);
#pragma unroll
    for (int r = 0; r < 16; ++r) s2[r] = add_xor<4>(s2[r]);
#pragma unroll
    for (int r = 0; r < 16; ++r) s2[r] = add_xor<8>(s2[r]);
#pragma unroll
    for (int r = 0; r < 16; ++r) s2[r] = add_xor<16>(s2[r]);
    { LAS bf16_t* stg = (LAS bf16_t*)shm + wid * 4096;
#pragma unroll
      for (int r = 0; r < 16; ++r) { const float rstd = __builtin_amdgcn_rsqf(s2[r] * (1.f / 128.f) + EPS); const int orow = crow(r, hi);
#pragma unroll
          for (int db = 0; db < 4; ++db) stg[orow * 128 + db * 32 + r32] = f2bf(o[db][r] * rstd * gw[db]); }
      u32x4 gq[8];
#pragma unroll
      for (int i = 0; i < 8; ++i) { const int row = i * 4 + (lane >> 4), ch = lane & 15; gq[i] = *(const u32x4*)(RG + (size_t)(row0 + 32 * wq + row) * 1024 + h * 128 + ch * 8); }
      asm volatile("s_waitcnt lgkmcnt(0)" ::: "memory");
#pragma unroll
      for (int i = 0; i < 8; ++i) { const int row = i * 4 + (lane >> 4), ch = lane & 15; const u32x4 v = *(const LAS u32x4*)(stg + row * 128 + ch * 8);
          const size_t grow = (size_t)(row0 + 32 * wq + row); const u32x4 g = gq[i];
          u32x4 w;
          w.x = pk2(__uint_as_float(v.x << 16) * __uint_as_float(g.x << 16), __uint_as_float(v.x & 0xffff0000u) * __uint_as_float(g.x & 0xffff0000u));
          w.y = pk2(__uint_as_float(v.y << 16) * __uint_as_float(g.y << 16), __uint_as_float(v.y & 0xffff0000u) * __uint_as_float(g.y & 0xffff0000u));
          w.z = pk2(__uint_as_float(v.z << 16) * __uint_as_float(g.z << 16), __uint_as_float(v.z & 0xffff0000u) * __uint_as_float(g.z & 0xffff0000u));
          w.w = pk2(__uint_as_float(v.w << 16) * __uint_as_float(g.w << 16), __uint_as_float(v.w & 0xffff0000u) * __uint_as_float(g.w & 0xffff0000u));
          *(u32x4*)(OR + grow * 2048 + 512 + h * 128 + ch * 8) = w; } }
    asm volatile("s_waitcnt lgkmcnt(0)\n\ts_barrier" ::: "memory");
}
}

constexpr size_t MiB = 1u << 20;
constexpr size_t WS_CTL = 0, CTL_ZERO_BYTES = 64 * 1024;
constexpr size_t WS_SSQ16 = 1 * MiB;
constexpr size_t WS_TAB64 = 2 * MiB, WS_TAB32 = 4 * MiB;
constexpr size_t WS_SSQC = 5 * MiB, WS_SSQK = 6 * MiB, WS_LOGF = 6 * MiB + 512 * 1024;
constexpr size_t WS_SEL = 7 * MiB, WS_SLOT = 7 * MiB + 256 * 1024, WS_CNT = 7 * MiB + 384 * 1024, WS_RSL = 7 * MiB + 512 * 1024;
constexpr size_t WS_CUMB = 8 * MiB, WS_KR = 10 * MiB, WS_CUMF = 11 * MiB  ;
constexpr int CW_KMSQ = 8448;
constexpr int CW_QCTR = 8192;
constexpr size_t WS_WIN = 12 * MiB, WIN_STRIDE = (size_t)NP1 * 1024 * 2;
constexpr size_t WS_WUQ = 45 * MiB, WS_WUKV = 47 * MiB, WS_WBCAT = 48 * MiB  , WS_WOUT = 56 * MiB, WS_WGU = 60 * MiB, WS_WDN = 74 * MiB;
constexpr size_t WS_XB = 81 * MiB;
constexpr size_t WS_FQ = 113 * MiB, WS_FK = 129 * MiB, WS_FV = 145 * MiB, WS_RQ = 161 * MiB, WS_KG = 177 * MiB, WS_RV = 193 * MiB, WS_RG = 225 * MiB, WS_GATES = 257 * MiB;
constexpr size_t WS_ACT = 225 * MiB;
constexpr size_t WS_CQ = 353 * MiB, WS_CKV = 365 * MiB;
constexpr size_t WS_MQ = 373 * MiB, WS_KN = 397 * MiB, WS_MV = 413 * MiB, WS_T = 429 * MiB, WS_OCAT = 429 * MiB, WS_X1B = 461 * MiB, WS_RP = 493 * MiB;
constexpr size_t WS_ACTM = 81 * MiB  , WS_YP = 150 * MiB  , WS_HS = 180 * MiB, WS_Y = 248 * MiB;
constexpr size_t WS_XB8 = 509 * MiB  , WS_WGL8 = 525 * MiB  , WS_END = 531 * MiB;

constexpr int RING_BYTES = 131072, MISC_OFF = RING_BYTES, LDS_BYTES = 147456;

#define RLX_AGENT __ATOMIC_RELAXED, __HIP_MEMORY_SCOPE_AGENT
#define XB_TMO      128
#define XB_XCNT(j)  (256  + 64 * (j))
#define XB_XSUB(j)  (1280 + 64 * (j))
#define XB_XGEN(j)  (2304 + 64 * (j))
#define XB_TOP      3328
#define XB_TOPGEN   3392
#define XCD_BAR_WORDS 3456
#define XB_SPIN_CAP (1u << 18)
__device__ __forceinline__ unsigned xb_ld(unsigned* p)              { return __hip_atomic_load(p, __ATOMIC_RELAXED, __HIP_MEMORY_SCOPE_AGENT); }
__device__ __forceinline__ unsigned xb_add(unsigned* p, unsigned v) { return __hip_atomic_fetch_add(p, v, __ATOMIC_RELAXED, __HIP_MEMORY_SCOPE_AGENT); }
__device__ __forceinline__ unsigned xb_xcc_id() { return (unsigned)__builtin_amdgcn_s_getreg((3 << 11) | 20) & 0xFu; }
#define XB_SPIN(cond, bar) do { unsigned _sp = 0; while (cond) { __builtin_amdgcn_s_sleep(1); \
    if ((++_sp & 255u) == 0u) { if (xb_ld(&(bar)[XB_TMO])) break; if (_sp > XB_SPIN_CAP) { atomicAdd(&(bar)[XB_TMO], 1u); break; } } } } while (0)
struct XcdBarrier { unsigned* bar; unsigned x; volatile LAS unsigned* st; };
__device__ __forceinline__ XcdBarrier xcd_barrier_post(unsigned* bar, volatile LAS unsigned* st) {
    XcdBarrier b; b.bar = bar; b.x = xb_xcc_id(); b.st = st;
    if (threadIdx.x == 0) (void)xb_add(&bar[XB_XCNT(b.x)], 1u);
    return b;
}
__device__ __forceinline__ void xcd_barrier_complete(unsigned* bar, unsigned x, unsigned& nloc, unsigned& nx) {
    const unsigned G = gridDim.x * gridDim.y * gridDim.z;
    unsigned sum, cnt, mine, sp = 0u;
    for (;;) {
        sum = 0u; cnt = 0u; mine = 0u;
#pragma unroll
        for (unsigned j = 0; j < 16; ++j) { const unsigned c = xb_ld(&bar[XB_XCNT(j)]); sum += c; cnt += (c > 0u) ? 1u : 0u; mine = (j == x) ? c : mine; }
        if (sum == G) break;
        __builtin_amdgcn_s_sleep(1);
        if ((++sp & 255u) == 0u) { if (xb_ld(&bar[XB_TMO])) break; if (sp > XB_SPIN_CAP) { atomicAdd(&bar[XB_TMO], 1u); break; } }
    }
    nloc = mine > 0u ? mine : 1u; nx = cnt > 0u ? cnt : 1u;
}
__device__ __forceinline__ void xcd_barrier(const XcdBarrier& b) {
    asm volatile("s_waitcnt vmcnt(0)" ::: "memory");
    __syncthreads();
    if (threadIdx.x == 0) {
        unsigned* bar = b.bar;
        __builtin_amdgcn_s_waitcnt(0);
        unsigned nloc = b.st[0], nx = b.st[1];
        if (nloc == 0u) { xcd_barrier_complete(bar, b.x, nloc, nx); b.st[0] = nloc; b.st[1] = nx; }
        const unsigned old = xb_add(&bar[XB_XSUB(b.x)], 1u);
        const unsigned gen = old / nloc;
        if (old + 1u == (gen + 1u) * nloc) {
            __builtin_amdgcn_fence(__ATOMIC_RELEASE, "agent");
            asm volatile("s_waitcnt vmcnt(0)" ::: "memory");
            const unsigned og = xb_add(&bar[XB_TOP], 1u);
            const unsigned tg = og / nx;
            if (og + 1u == (tg + 1u) * nx) xb_add(&bar[XB_TOPGEN], 1u);
            else XB_SPIN(xb_ld(&bar[XB_TOPGEN]) == tg, bar);
            __builtin_amdgcn_fence(__ATOMIC_ACQUIRE, "agent");
            xb_add(&bar[XB_XGEN(b.x)], 1u);
            asm volatile("s_waitcnt vmcnt(0)" ::: "memory");
        } else {
            XB_SPIN(xb_ld(&bar[XB_XGEN(b.x)]) == gen, bar);
            __builtin_amdgcn_fence(__ATOMIC_ACQUIRE, "agent");
            asm volatile("s_waitcnt vmcnt(0)" ::: "memory");
        }
    }
    __syncthreads();
}

#define LDS_WAIT() asm volatile("s_waitcnt lgkmcnt(0)" ::: "memory")
__device__ __forceinline__ float wave_sum(float v) { v = add_xor<1>(v); v = add_xor<2>(v); v = add_xor<4>(v); v = add_xor<8>(v); v = add_xor<16>(v); return add_xor<32>(v); }
__device__ __forceinline__ int rp64(int j) { const int head = j >> 6, d = j & 63, i = d & 31, x2 = d >> 5; return 64 * head + 8 * (i >> 2) + 4 * x2 + (i & 3); }
__device__ __forceinline__ int rp32(int d) { const int i = d & 15, x2 = d >> 4; return 8 * (i >> 2) + 4 * x2 + (i & 3); }
template <int KIND> __device__ __forceinline__ int map_col(int j) {
    if (KIND == 0) return j;
    if (KIND == 1) {
        if (j < 1536) return j;
        if (j < 1544) return 8352 + (j - 1536);
        if (j < 2056) return 1536 + rp64(j - 1544);
        if (j < 2568) return 2048 + rp64(j - 2056);
        if (j < 3592) return 2560 + (j - 2568);
        if (j < 4616) return 3584 + (j - 3592);
        if (j < 5000) return 7680 + (j - 4616);
        if (j < 5256) return 8064 + (j - 5000);
        if (j < 5288) return 8320 + rp32(j - 5256);
        return 4608 + (j - 5288);
    }
    if (KIND == 2) { const int head = j / 96, d = j - 96 * head; return d < 64 ? 96 * head + d : 96 * head + 64 + rp32(d - 64); }
    if (KIND == 3) return 256 * (j >> 7) + (j & 127);
    return 256 * (j >> 7) + 128 + (j & 127);
}
template <int KIND> __device__ __forceinline__ void tr_item(const float* W, int ldw, int ncols, int K, const float* ksc, bf16_t* WT, int ldk, int koff, int row_off, LAS unsigned* scr, int item, int lane) {
    const int nblk = (ncols + 63) >> 6, kb = item / nblk, nb = item - kb * nblk, k0 = 64 * kb, n0 = 64 * nb, col = n0 + lane; const bool ok = col < ncols;
    const float* src = W + (size_t)k0 * ldw + (ok ? col : 0);
    float v[64];
#pragma unroll
    for (int i = 0; i < 64; ++i) v[i] = src[(size_t)i * ldw];
    if (ksc) {
#pragma unroll
        for (int i = 0; i < 64; ++i) v[i] *= ksc[k0 + i]; }
#pragma unroll
    for (int i = 0; i < 32; ++i) scr[lane * 34 + i] = pk2(v[2 * i], v[2 * i + 1]);
    LDS_WAIT(); asm volatile("" ::: "memory");
    const int c = lane & 7;
#pragma unroll
    for (int j = 0; j < 8; ++j) { const int n = (lane >> 3) + 8 * j; const u32x2 a = *(const LAS u32x2*)(scr + n * 34 + c * 4), b = *(const LAS u32x2*)(scr + n * 34 + c * 4 + 2);
        if (n0 + n < ncols) *(u32x4*)(WT + (size_t)(row_off + map_col<KIND>(n0 + n)) * ldk + koff + k0 + 8 * c) = (u32x4){a.x, a.y, b.x, b.y}; }
    LDS_WAIT(); asm volatile("" ::: "memory");
}
template <int KIND> __device__ __forceinline__ void tr8_item(const float* W, int ldw, int ncols, int K, const float* ksc, unsigned char* WT8, LAS unsigned* scr, int item, int lane) {
    const int nblk = (ncols + 63) >> 6, kb = item / nblk, nb = item - kb * nblk, k0 = 64 * kb, n0 = 64 * nb, col = n0 + lane; const bool ok = col < ncols;
    const float* src = W + (size_t)k0 * ldw + (ok ? col : 0);
    float v[64];
#pragma unroll
    for (int i = 0; i < 64; ++i) v[i] = src[(size_t)i * ldw];
#pragma unroll
    for (int i = 0; i < 64; ++i) v[i] *= ksc ? ksc[k0 + i] * 32.f : 32.f;
#pragma unroll
    for (int i = 0; i < 16; ++i) scr[lane * 18 + i] = pk4_fp8(v[4 * i], v[4 * i + 1], v[4 * i + 2], v[4 * i + 3]);
    LDS_WAIT(); asm volatile("" ::: "memory");
    const int c = lane & 3;
#pragma unroll
    for (int j = 0; j < 4; ++j) { const int n = (lane >> 2) + 16 * j; const u32x2 a = *(const LAS u32x2*)(scr + n * 18 + c * 4), b = *(const LAS u32x2*)(scr + n * 18 + c * 4 + 2);
        if (n0 + n < ncols) *(u32x4*)(WT8 + (size_t)map_col<KIND>(n0 + n) * K + k0 + 16 * c) = (u32x4){a.x, a.y, b.x, b.y}; }
    LDS_WAIT(); asm volatile("" ::: "memory");
}
struct MoeCvtItem { const char* src; const float* ksc; unsigned char* dst; int ldw, K, k0, n0, job; };
__device__ __forceinline__ MoeCvtItem moe_cvt_item(const float* wg, const float* wu, const float* wd, const float* gain, unsigned char* ws, int g, int lane) {
    MoeCvtItem it; const int e = g / 2688, r = g - e * 2688, job = r / 896, i = r - job * 896; it.job = job;
    if (job < 2) { const int kb = i / 56, nb = i - kb * 56; it.k0 = 64 * kb; it.n0 = 64 * nb; it.ldw = DFF; it.K = 1024; it.ksc = gain; it.dst = ws + pg8::moe_gu_base(e);
        it.src = (const char*)((job == 0 ? wg : wu) + (size_t)e * 1024 * DFF + (size_t)it.k0 * DFF + it.n0); }
    else { const int kb = i >> 4, nb = i & 15; it.k0 = 64 * kb; it.n0 = 64 * nb; it.ldw = 1024; it.K = DFF; it.ksc = nullptr; it.dst = ws + pg8::moe_dn_base(e);
        it.src = (const char*)(wd + (size_t)e * DFF * 1024 + (size_t)it.k0 * 1024 + it.n0); }
    return it;
}
__device__ __forceinline__ void moe_cvt_load(float (&v)[64], const MoeCvtItem& it, int lane) {
    const unsigned step = (unsigned)it.ldw * 4u; const __amdgpu_buffer_rsrc_t rs = __builtin_amdgcn_make_buffer_rsrc((void*)it.src, (short)0, (int)(64u * step), 0x00020000); const int vo = lane * 4;
#pragma unroll
    for (int i = 0; i < 64; ++i) v[i] = __uint_as_float(__builtin_amdgcn_raw_buffer_load_b32(rs, vo, (int)(i * step), 2  ));
}
__device__ __forceinline__ void moe_cvt_finish(float (&v)[64], const MoeCvtItem& it, LAS unsigned* scr, int lane) {
    if (it.ksc) {
#pragma unroll
        for (int i = 0; i < 64; ++i) v[i] *= it.ksc[it.k0 + i] * 32.f;
    } else {
#pragma unroll
        for (int i = 0; i < 64; ++i) v[i] *= 32.f;
    }
#pragma unroll
    for (int i = 0; i < 16; ++i) scr[lane * 18 + i] = pk4_fp8(v[4 * i], v[4 * i + 1], v[4 * i + 2], v[4 * i + 3]);
    LDS_WAIT(); asm volatile("" ::: "memory");
    const int c = lane & 3;
#pragma unroll
    for (int j = 0; j < 4; ++j) { const int n = it.n0 + (lane >> 2) + 16 * j; const u32x2 a = *(const LAS u32x2*)(scr + ((lane >> 2) + 16 * j) * 18 + c * 4), b = *(const LAS u32x2*)(scr + ((lane >> 2) + 16 * j) * 18 + c * 4 + 2);
        const int row = it.job == 2 ? n : 256 * (n >> 7) + 128 * it.job + (n & 127);
        *(u32x4*)(it.dst + (size_t)row * it.K + it.k0 + 16 * c) = (u32x4){a.x, a.y, b.x, b.y}; }
    LDS_WAIT(); asm volatile("" ::: "memory");
}
__device__ __forceinline__ void moe_cvt_run(const float* wg, const float* wu, const float* wd, const float* gain, unsigned char* ws, LAS unsigned* scr, int w, int nw, int nitems, int lane) {
    float va[64], vb[64]; int g = w; MoeCvtItem ia, ib;
    if (g < nitems) { ia = moe_cvt_item(wg, wu, wd, gain, ws, g, lane); moe_cvt_load(va, ia, lane); }
    while (g < nitems) {
        const bool hb = g + nw < nitems;
        if (hb) { ib = moe_cvt_item(wg, wu, wd, gain, ws, g + nw, lane); moe_cvt_load(vb, ib, lane); }
        moe_cvt_finish(va, ia, scr, lane);
        g += nw; if (!hb) break;
        const bool ha = g + nw < nitems;
        if (ha) { ia = moe_cvt_item(wg, wu, wd, gain, ws, g + nw, lane); moe_cvt_load(va, ia, lane); }
        moe_cvt_finish(vb, ib, scr, lane);
        g += nw; if (!ha) break;
    }
}
#define TR8_JOB(KIND, W, ldw, ncols, K, ksc, WT8) do { const int nit_ = ((K) / 64) * (((ncols) + 63) / 64); int st_ = gw - rot; if (st_ < 0) st_ += NGW; \
    for (int it_ = st_; it_ < nit_; it_ += NGW) tr8_item<KIND>(W, ldw, ncols, K, ksc, WT8, (LAS unsigned*)scr, it_, lane); rot = (rot + nit_) % NGW; } while (0)
#define TR_JOB(KIND, W, ldw, ncols, K, ksc, WT, row_off) TR_JOB2(KIND, W, ldw, ncols, K, ksc, WT, K, 0, row_off)
#define TR_JOB2(KIND, W, ldw, ncols, K, ksc, WT, ldk, koff, row_off) do { const int nit_ = ((K) / 64) * (((ncols) + 63) / 64); int st_ = gw - rot; if (st_ < 0) st_ += NGW; \
    for (int it_ = st_; it_ < nit_; it_ += NGW) tr_item<KIND>(W, ldw, ncols, K, ksc, WT, ldk, koff, row_off, (LAS unsigned*)scr, it_, lane); rot = (rot + nit_) % NGW; } while (0)
#define CVT_LAYER(l_) do { bf16_t* WIN_ = (bf16_t*)(ws + WS_WIN + (l_) * WIN_STRIDE); \
        TR_JOB(1, args.in[2] + (size_t)(l_) * 1024 * DIN, DIN, 5288, 1024, args.in[1] + (l_) * 1024, WIN_, 0);     \
        for (int i = gw * 64 + lane; i < (NP1 - DIN) * 1024 / 8; i += NGW * 64) *(u32x4*)(WIN_ + (size_t)DIN * 1024 + (size_t)i * 8) = (u32x4){0u, 0u, 0u, 0u};     \
        TR8_JOB(0, args.in[2] + (size_t)(l_) * 1024 * DIN + 5288, DIN, 3072, 1024, args.in[1] + (l_) * 1024, ws + WS_WGL8 + (size_t)(l_) * 3 * MiB); \
        TR_JOB(2, args.in[7] + (size_t)(l_) * 384 * 768, 768, 768, 384, args.in[5] + (l_) * 384, (bf16_t*)(ws + WS_WUQ + (l_) * MiB), 0); \
        TR_JOB(0, args.in[8] + (size_t)(l_) * 256 * 512, 512, 512, 256, args.in[6] + (l_) * 256, (bf16_t*)(ws + WS_WUKV + (l_) * (MiB / 2)), 0); \
        TR_JOB(0, args.in[9] + (size_t)(l_) * 256 * 512, 512, 512, 256, args.in[6] + (l_) * 256, (bf16_t*)(ws + WS_WUKV + (l_) * (MiB / 2)), 512); \
        TR_JOB2(0, args.in[10] + (size_t)(l_) * 512 * 1024, 1024, 1024, 512, (const float*)nullptr, (bf16_t*)(ws + WS_WBCAT + (l_) * 4 * MiB), 2048, 0, 0); \
        TR_JOB2(0, args.in[11] + (size_t)(l_) * 1024 * 1024, 1024, 1024, 1024, (const float*)nullptr, (bf16_t*)(ws + WS_WBCAT + (l_) * 4 * MiB), 2048, 512, 0); \
        TR_JOB2(0, args.in[12] + (size_t)(l_) * 512 * 1024, 1024, 1024, 512, (const float*)nullptr, (bf16_t*)(ws + WS_WBCAT + (l_) * 4 * MiB), 2048, 1536, 0); \
        TR_JOB(0, args.in[13] + (size_t)(l_) * 1024 * 1024, 1024, 1024, 1024, (const float*)nullptr, (bf16_t*)(ws + WS_WOUT + (l_) * 2 * MiB), 0); } while (0)
#define CVT_DENSE() do { \
        TR_JOB(3, args.in[15], DFF, DFF, 1024, args.in[14], (bf16_t*)(ws + WS_WGU), 0); \
        TR_JOB(4, args.in[16], DFF, DFF, 1024, args.in[14], (bf16_t*)(ws + WS_WGU), 0); \
        TR_JOB(0, args.in[17], 1024, 1024, DFF, (const float*)nullptr, (bf16_t*)(ws + WS_WDN), 0); } while (0)
#define CVT_MOE(e0_, e1_, gu_) do { for (int e = (e0_); e < (e1_); ++e) { \
        if (gu_) { TR8_JOB(3, args.in[19] + (size_t)e * 1024 * DFF, DFF, DFF, 1024, args.in[14] + 1024, ws + pg8::moe_gu_base(e)); \
                   TR8_JOB(4, args.in[20] + (size_t)e * 1024 * DFF, DFF, DFF, 1024, args.in[14] + 1024, ws + pg8::moe_gu_base(e)); } \
        TR8_JOB(0, args.in[21] + (size_t)e * DFF * 1024, 1024, 1024, DFF, (const float*)nullptr, ws + pg8::moe_dn_base(e)); } } while (0)
#define CVT_IS_BLOCK() (((bx >> 3) & 3) == 0)
#define CVT_RANK() ((bx >> 5) * 8 + (bx & 7))

struct Args { const float* in[23]; float* out; unsigned char* ws; int ph_lo, ph_hi; };
constexpr int NPH = 32;
__host__ __device__ constexpr int PH(int l, int j) { return 1 + 16 * l + j; }

__device__ __forceinline__ void moe_table(const int* CNT, volatile LAS unsigned* MISC, int tid, int lane, int wave, int tb) {
    { int s = 0, bl = 0;
#pragma unroll
        for (int j = 0; j < 4; ++j) { const int bb = lane + 64 * j; const int c = CNT[bb * 8 + wave]; s += c; bl += (bb < tb) ? c : 0; }
        s = (int)wave_sum((float)s); bl = (int)wave_sum((float)bl);
        if (lane == 0) { MISC[16 + wave] = (unsigned)s; MISC[24 + wave] = (unsigned)bl; } }
    __syncthreads();
    if (tid == 0) { volatile LAS unsigned char* te = (volatile LAS unsigned char*)(MISC + 64); int t = 0;
        for (int e = 0; e < 8; ++e) { const int nt_ = ((int)MISC[16 + e] + 255) >> 8; for (int i = 0; i < nt_ && t < MAXT; ++i) te[t++] = (unsigned char)e; }
        MISC[32] = (unsigned)t; }
    __syncthreads();
}

#define IN(k) (lo <= (k) && (k) < hi)
#define SEAM() do { if (!MK_PER_PHASE) xcd_barrier(bar); } while (0)

#define RS_PREFILL() do { const int t_ = opaque_tid(); LAS float* rt8_ = (LAS float*)(lds + 131072 + 1024) + 256; \
    for (int i_ = t_; i_ < 2048; i_ += 512) { const float* p_ = SSQ16 + ((size_t)(bx & 7) * 2048 + i_) * 16; const f32x4 a_ = *(const f32x4*)p_, b_ = *(const f32x4*)(p_ + 4), c_ = *(const f32x4*)(p_ + 8), d_ = *(const f32x4*)(p_ + 12); \
        rt8_[i_] = __builtin_amdgcn_rsqf((((a_.x + a_.y) + (a_.z + a_.w)) + ((b_.x + b_.y) + (b_.z + b_.w)) + ((c_.x + c_.y) + (c_.z + c_.w)) + ((d_.x + d_.y) + (d_.z + d_.w))) * (1.f / 1024.f) + EPS); } \
    __syncthreads(); } while (0)
#define PHASE_IDS() const int tid = opaque_tid(), lane = tid & 63, wave = __builtin_amdgcn_readfirstlane(tid >> 6), gw = bx * 8 + wave; LAS float* scr = (LAS float*)(lds + wave * 16384); (void)lane; (void)gw; (void)scr
template <int l> __device__ __forceinline__ void layer_body(const Args& args, LAS unsigned char* lds, volatile LAS unsigned* MISC, const XcdBarrier& bar, const int lo, const int hi) {
    const int G = gridDim.x, bx = blockIdx.x, vcu = (bx & 7) * (G >> 3) + (bx >> 3), NGW = G * 8; (void)NGW; (void)vcu;
    unsigned char* ws = args.ws;
    float* XRES = args.out;
    float* SSQ16 = (float*)(ws + WS_SSQ16); const f32x2* T64 = (const f32x2*)(ws + WS_TAB64); const f32x2* T32 = (const f32x2*)(ws + WS_TAB32);
    float* SSQC = (float*)(ws + WS_SSQC); float* SSQK = (float*)(ws + WS_SSQK); float* LOGF = (float*)(ws + WS_LOGF);
    bf16_t* CUMB = (bf16_t*)(ws + WS_CUMB); bf16_t* KR = (bf16_t*)(ws + WS_KR); float* CUMF = (float*)(ws + WS_CUMF);
    bf16_t* XB = (bf16_t*)(ws + WS_XB); bf16_t* MERGED = (bf16_t*)(ws + WS_FQ);
    bf16_t *FQ = (bf16_t*)(ws + WS_FQ), *FK = (bf16_t*)(ws + WS_FK), *FV = (bf16_t*)(ws + WS_FV), *RQ = (bf16_t*)(ws + WS_RQ), *KG = (bf16_t*)(ws + WS_KG), *RV = (bf16_t*)(ws + WS_RV);
    bf16_t *RG = (bf16_t*)(ws + WS_RG), *GATES = (bf16_t*)(ws + WS_GATES), *CQ = (bf16_t*)(ws + WS_CQ), *CKV = (bf16_t*)(ws + WS_CKV);
    bf16_t *MQ = (bf16_t*)(ws + WS_MQ), *KN = (bf16_t*)(ws + WS_KN), *MV = (bf16_t*)(ws + WS_MV), *OCAT = (bf16_t*)(ws + WS_OCAT), *RP = (bf16_t*)(ws + WS_RP), *X1B = (bf16_t*)(ws + WS_X1B);
    float* Tst = (float*)(ws + WS_T); bf16_t* ACT = (bf16_t*)(ws + WS_ACT);

        const int pb = PH(l, 0);
        const bf16_t* WIN = (const bf16_t*)(ws + WS_WIN + l * WIN_STRIDE);
        const float* xin = l == 0 ? args.in[0] : (const float*)XRES;
        if (IN(pb + 0)) {
            pg8::GridOrder S; S.init(64, 20, G, bx, XB, WIN, 1024); S.pn_skip = 17; S.pn_add = 13;
            pg8::EpiP1 E{FQ, FK, FV, RQ, KG, RV, RG, GATES, CQ, CKV, KR, LOGF, SSQC, SSQK, SSQ16, T64, T32, args.in[3] + l * 8, (unsigned*)(ws + WS_CTL) + CW_KMSQ + 64 * l};
            RS_PREFILL(); E.pre = 1;
            pg8::gemm_phase<pg8::EpiP1, pg8::GridOrder, true>(lds, 1024, S, E);
            { pg8::GridOrder S8; S8.init(64, 12, G, bx, ws + WS_XB8, ws + WS_WGL8 + (size_t)l * 3 * MiB, 512); pg8::EpiGL8 E8{(unsigned char*)GATES};
              pg8::gemm_phase<pg8::EpiGL8, pg8::GridOrder, true, true>(lds, 512, S8, E8); }
            SEAM();
        }
        if (IN(pb + 1)) { PHASE_IDS();
            if (bx < 16) {
                const int b = bx >> 3, h = bx & 7, t0 = tid * 16; float v[16]; float run = 0.f;
#pragma unroll
                for (int j = 0; j < 16; ++j) { run += LOGF[((size_t)b * SEQ + t0 + j) * 8 + h]; v[j] = run; }
                float inc = run;
#pragma unroll
                for (int o = 1; o < 64; o <<= 1) { const float n = __int_as_float(__builtin_amdgcn_ds_bpermute((lane - o) << 2, __float_as_int(inc))); if (lane >= o) inc += n; }
                LAS float* wt = (LAS float*)lds;
                if (lane == 63) wt[wave] = inc;
                __syncthreads();
                float base = inc - run;
                for (int w = 0; w < wave; ++w) base += wt[w];
#pragma unroll
                for (int j = 0; j < 16; ++j) { const float bk = -(base + v[j]) * LOG2E; const unsigned short h0 = f2bf(bk); const float r1 = bk - bf2f(h0); const unsigned short h1 = f2bf(r1); const unsigned short h2 = f2bf(r1 - bf2f(h1));
                    *(u32x4*)(CUMB + ((size_t)bx * SEQ + t0 + j) * 8) = (u32x4){(unsigned)h0 | ((unsigned)h1 << 16), (unsigned)h2, 0u, 0u}; CUMF[(size_t)bx * SEQ + t0 + j] = bf2f(h0) + bf2f(h1) + bf2f(h2); }
                __syncthreads();
            }
            if (bx >= 192) { pg8::GridOrder S; S.init(64, 1, 64, bx - 192, XB, WIN, 1024); S.pn_off = 17;
              pg8::EpiP1 E{FQ, FK, FV, RQ, KG, RV, RG, GATES, CQ, CKV, KR, LOGF, SSQC, SSQK, SSQ16, T64, T32, args.in[3] + l * 8, (unsigned*)(ws + WS_CTL) + CW_KMSQ + 64 * l};
              pg8::gemm_phase<pg8::EpiP1, pg8::GridOrder, true>(lds, 1024, S, E); }
            else { pg8::GridOrder S; S.init(64, 3, 192, bx, CQ, ws + WS_WUQ + l * MiB, 384); pg8::EpiMQ E{MQ, SSQC, T32};
              pg8::gemm_phase<pg8::EpiMQ, pg8::GridOrder, true>(lds, 384, S, E); }
            { pg8::GridOrder S; S.init(64, 4, G, bx, CKV, ws + WS_WUKV + l * (MiB / 2), 256); pg8::EpiKV E{KN, MV, SSQK};
              pg8::gemm_phase<pg8::EpiKV, pg8::GridOrder, true>(lds, 256, S, E); }
            if (bx >= 192) att::tstate_run(2 * (bx - 192), 1, 2, KG, RV, Tst, (LAS char*)lds);
            else if (bx >= 16) att::tstate_run(128 + bx - 16, 176, (1024 - (128 + bx - 16) + 175) / 176, KG, RV, Tst, (LAS char*)lds);
            SEAM();
        }
        if (IN(pb + 2)) { PHASE_IDS();
            for (int e = bx * 512 + tid; e < 16 * 8192; e += G * 512) { const int bh = e >> 13, el = e & 8191; const float lg = lg2gamma(bh & 7), g1 = fexp2(lg), g127 = fexp2(127.f * lg), g128 = fexp2(128.f * lg);
                float R = 0.f; const size_t base = (size_t)bh * 64 * 8192 + el; float Tc[64];
#pragma unroll
                for (int c = 0; c < 64; ++c) Tc[c] = Tst[base + (size_t)c * 8192];
                asm volatile("" ::: "memory");
#pragma unroll
                for (int c = 0; c < 64; ++c) { RP[base + (size_t)c * 8192] = f2bf(g1 * R); R = g128 * R + g127 * Tc[c]; } }
            SEAM();
        }
        if (IN(pb + 3)) {
            unsigned* qctr = (unsigned*)(ws + WS_CTL) + CW_QCTR + 64 * l;
            const unsigned* kmsq = (const unsigned*)(ws + WS_CTL) + CW_KMSQ + 64 * l;
            if (CVT_IS_BLOCK() && (l == 0 ? CVT_L1_IN_P4 : CVT_MOE_IN_P4)) { PHASE_IDS(); (void)tid;
                { const int cw_ = CVT_RANK() * 8 + wave; const int gw = cw_, NGW = 512; int rot = 0;
                  if constexpr (l == 0) { CVT_LAYER(1); CVT_DENSE(); } else moe_cvt_run(args.in[19], args.in[20], args.in[21], args.in[14] + 1024, ws, (LAS unsigned*)scr, cw_, NGW, 8 * 2688 - 896, lane); }
                __syncthreads(); }
            const int tid0 = opaque_tid();
            unsigned nxt_ = 0u; if (tid0 == 0) nxt_ = __hip_atomic_fetch_add(qctr, 1u, __ATOMIC_RELAXED, __HIP_MEMORY_SCOPE_AGENT);
            for (;;) {
                if (tid0 == 0) MISC[40] = nxt_;
                __syncthreads();
                const int idx = (int)MISC[40];
                __syncthreads();
                if (idx >= 1536) break;
                if (tid0 == 0) nxt_ = __hip_atomic_fetch_add(qctr, 1u, __ATOMIC_RELAXED, __HIP_MEMORY_SCOPE_AGENT);
                if (idx < 1024) { const int qb = 31 - (idx >> 5), w = idx & 31, bh = w & 15, b = bh >> 3, h = bh & 7; const size_t rb = (size_t)b * SEQ;
                    if (w < 16) att::attn_unit2<5, true, 9>(qb, FQ + rb * 512 + h * 64, 512, FK + rb * 512 + h * 64, 512, CUMB + (size_t)bh * SEQ * 8, 8, FV + rb * 512 + h * 64, 512, OCAT + rb * 2048 + h * 64, 2048, CUMF + (size_t)bh * SEQ, 1.01f * __builtin_sqrtf(__uint_as_float(kmsq[bh * 2]) + __uint_as_float(kmsq[bh * 2 + 1])), (LAS char*)lds);
                    else att::attn_unit2<6, false, 12>(qb, MQ + rb * 768 + h * 96, 768, KN + rb * 512 + h * 64, 512, KR + rb * 32, 32, MV + rb * 512 + h * 64, 512, OCAT + rb * 2048 + 1536 + h * 64, 2048, (const float*)nullptr, 0.f, (LAS char*)lds);
                } else { const int u = idx - 1024; att::ret_unit(u >> 5, u & 31, RQ, KG, RV, RP, RG, args.in[4] + l * 1024, OCAT, (LAS char*)lds); }
            }
            SEAM();
        }
        if (IN(pb + 4)) {
            pg8::GridOrder S; S.init(64, 4, G, bx, OCAT, ws + WS_WBCAT + l * 4 * MiB, 2048); pg8::EpiMerge E{(const unsigned char*)GATES, MERGED};
            pg8::gemm_phase<pg8::EpiMerge, pg8::GridOrder, true>(lds, 2048, S, E);
            SEAM();
        }
        if (IN(pb + 5)) {
            pg8::GridOrder S; S.init(64, 4, G, bx, MERGED, ws + WS_WOUT + l * 2 * MiB, 1024); pg8::EpiResid E{xin, l == 0 ? (float*)nullptr : XRES, l == 0 ? X1B : (bf16_t*)nullptr, SSQ16, l == 0 ? (unsigned char*)nullptr : ws + WS_XB8, XB};
            pg8::gemm_phase<pg8::EpiResid, pg8::GridOrder, true>(lds, 1024, S, E);
            SEAM();
        }
        if (l == 0) {
            if (IN(pb + 6)) {
#if FP8_DENSE_GU
                pg8::GridOrder S; S.init(64, 28, G, bx, ws + WS_XB8, ws + WS_WGU, 512); pg8::EpiSwiglu<false> E{ACT, SSQ16, 0};
                RS_PREFILL(); E.pre = 1; E.wsc = 1.f / 32.f;
                pg8::gemm_phase<pg8::EpiSwiglu<false>, pg8::GridOrder, true, true>(lds, 512, S, E);
#else
                pg8::GridOrder S; S.init(64, 28, G, bx, X1B, ws + WS_WGU, 1024); pg8::EpiSwiglu<false> E{ACT, SSQ16, 0};
                RS_PREFILL(); E.pre = 1;
                pg8::gemm_phase<pg8::EpiSwiglu<false>, pg8::GridOrder, true>(lds, 1024, S, E);
#endif
                SEAM();
            }
            if (IN(pb + 7)) {
                pg8::GridOrder S; S.init(64, 4, G, bx, ACT, ws + WS_WDN, DFF); pg8::EpiResid E{(const float*)nullptr, (float*)nullptr, XB, SSQ16, ws + WS_XB8, X1B};
                pg8::gemm_phase<pg8::EpiResid, pg8::GridOrder, true>(lds, DFF, S, E);
                SEAM();
            }
        } else {
            int* CNT = (int*)(ws + WS_CNT); f32x4* SEL = (f32x4*)(ws + WS_SEL); int* SLOT = (int*)(ws + WS_SLOT); float* RSL = (float*)(ws + WS_RSL);
            bf16_t* HS = (bf16_t*)(ws + WS_HS); bf16_t* Y = (bf16_t*)(ws + WS_Y); bf16_t* ACTM = (bf16_t*)(ws + WS_ACTM);
            if (IN(pb + 6)) { PHASE_IDS();
                LAS float* wrl = (LAS float*)lds;
                { float wq_[16], gq_[16];
#pragma unroll
                  for (int p = 0; p < 16; ++p) { const int i = tid + 512 * p; wq_[p] = args.in[18][i]; gq_[p] = args.in[14][1024 + (i >> 3)]; }
#pragma unroll
                  for (int p = 0; p < 16; ++p) { const int i = tid + 512 * p; wrl[(i & 7) * 1024 + (i >> 3)] = wq_[p] * gq_[p]; } }
                __syncthreads();
                volatile LAS unsigned char* selb = (volatile LAS unsigned char*)(lds + 65536);
                for (int tb = bx; tb < 256; tb += G) {
                    f32x4 xq_[4];
#pragma unroll
                    for (int j = 0; j < 4; ++j) xq_[j] = ((const f32x4*)(XRES + (size_t)(tb * 64 + wave * 8) * 1024) + lane)[64 * j];
                    for (int tk = 0; tk < 8; ++tk) { const int tl = wave * 8 + tk, t = tb * 64 + tl;
                        f32x4 xc_[4], xn_[4];
#pragma unroll
                        for (int j = 0; j < 4; ++j) xc_[j] = xq_[j];
                        if (tk < 7) {
#pragma unroll
                            for (int j = 0; j < 4; ++j) xn_[j] = ((const f32x4*)(XRES + (size_t)(t + 1) * 1024) + lane)[64 * j]; }
                        float ssq = 0.f; float a[8];
#pragma unroll
                        for (int e = 0; e < 8; ++e) a[e] = 0.f;
#pragma unroll
                        for (int j = 0; j < 4; ++j) { const f32x4 v = xc_[j]; ssq += (v.x * v.x + v.y * v.y) + (v.z * v.z + v.w * v.w); const int k = 4 * (64 * j + lane);
#pragma unroll
                            for (int e = 0; e < 8; ++e) { const f32x4 w = *(const LAS f32x4*)(wrl + e * 1024 + k); a[e] += (v.x * w.x + v.y * w.y) + (v.z * w.z + v.w * w.w); } }
                        ssq = wave_sum(ssq);
#pragma unroll
                        for (int e = 0; e < 8; ++e) a[e] = wave_sum(a[e]);
                        const float r = __builtin_amdgcn_rsqf(ssq * (1.f / 1024.f) + EPS);
                        int i0 = 0; float v0 = a[0];
#pragma unroll
                        for (int e = 1; e < 8; ++e) if (a[e] > v0) { v0 = a[e]; i0 = e; }
                        int i1 = -1; float v1 = -INFINITY;
#pragma unroll
                        for (int e = 0; e < 8; ++e) if (e != i0 && a[e] > v1) { v1 = a[e]; i1 = e; }
                        const float e1 = __expf((v1 - v0) * r), w0 = 1.f / (1.f + e1), w1 = e1 * w0;
                        if (lane == 0) { SEL[t] = (f32x4){__uint_as_float((unsigned)i0 | ((unsigned)i1 << 8)), w0, w1, r}; selb[tl * 2] = (unsigned char)i0; selb[tl * 2 + 1] = (unsigned char)i1; }
                        if (tk < 7) {
#pragma unroll
                            for (int j = 0; j < 4; ++j) xq_[j] = xn_[j]; } }
                    __syncthreads();
                    if (tid < 8) { int c = 0; for (int i = 0; i < 128; ++i) c += (selb[i] == tid) ? 1 : 0; CNT[tb * 8 + tid] = c; }
                    __syncthreads();
                }
                { int rot = 0; if (CVT_MOE_IN_P4) CVT_MOE(7, 8, false); else CVT_MOE(0, 8, true); }
                SEAM();
            }
            if (IN(pb + 7)) { PHASE_IDS();
                volatile LAS int* lslot = (volatile LAS int*)lds;
                for (int tb = bx; tb < 256; tb += G) {
                    moe_table(CNT, MISC, tid, lane, wave, tb);
                    if (wave == 0) { const int t = tb * 64 + lane; const f32x4 se = SEL[t]; const unsigned ee = __float_as_uint(se.x); const int e0 = ee & 255, e1 = (ee >> 8) & 255; int s0 = 0, s1 = 0, off = 0;
                        for (int e = 0; e < 8; ++e) { const unsigned long long mk = __ballot(e0 == e || e1 == e); const int rank = __popcll(mk & ((1ull << lane) - 1ull)); const int sl = off + (int)MISC[24 + e] + rank;
                            if (e0 == e) s0 = sl; if (e1 == e) s1 = sl; off += (((int)MISC[16 + e] + 255) >> 8) << 8; }
                        SLOT[t * 2] = s0; SLOT[t * 2 + 1] = s1; RSL[s0] = se.w; RSL[s1] = se.w; lslot[lane * 2] = s0; lslot[lane * 2 + 1] = s1; }
                    __syncthreads();
#if FP8_MOE_GU
                    { u32x4 rowv[8];
#pragma unroll
                      for (int i = 0; i < 8; ++i) rowv[i] = ((const u32x4*)(ws + WS_XB8 + (size_t)(tb * 64 + wave * 8 + i) * 1024))[lane];
                      asm volatile("" ::: "memory");
#pragma unroll
                      for (int i = 0; i < 16; ++i) { const int sl = lslot[wave * 16 + i]; ((u32x4*)((unsigned char*)HS + (size_t)sl * 1024))[lane] = rowv[i >> 1]; } }
#else
                    for (int p = wave * 16; p < wave * 16 + 16; ++p) { const int t = tb * 64 + (p >> 1), sl = lslot[p]; const u32x4* src = (const u32x4*)(X1B + (size_t)t * 1024); u32x4* dst = (u32x4*)(HS + (size_t)sl * 1024);
                        dst[lane] = src[lane]; dst[lane + 64] = src[lane + 64]; }
#endif
                    __syncthreads();
                }
                SEAM();
            }
            for (int ci = 0; ci < 2; ++ci) {
                if (IN(pb + 8 + 2 * ci)) { PHASE_IDS();
                    const int Tt = (int)MISC[32], t0 = 64 * ci, t1 = ci == 0 ? (Tt < 64 ? Tt : 64) : Tt;
                    if (t0 < t1) { pg8::MoeOrder S{t0, t1 - t0, 28, G, bx, 0, (const char*)HS, (const char*)ws, (size_t)256 * 1024, (size_t)0, (const LAS unsigned char*)(lds + MISC_OFF + 256)};
                        pg8::EpiSwiglu<true, FP8_MOE_DN != 0> E{ACTM, RSL, t0}; if (FP8_MOE_GU) E.wsc = 1.f / 32.f;
                        if (ci == 0 && t1 == 64) {
                            LAS float* rt8_ = (LAS float*)(lds + 131072 + 1024) + 256; { const float a_ = RSL[(bx & 7) * 2048 + tid], b_ = RSL[(bx & 7) * 2048 + tid + 512], c_ = RSL[(bx & 7) * 2048 + tid + 1024], d_ = RSL[(bx & 7) * 2048 + tid + 1536];
                              rt8_[tid] = a_; rt8_[tid + 512] = b_; rt8_[tid + 1024] = c_; rt8_[tid + 1536] = d_; } __syncthreads(); E.pre = 1; }
                        else if ((t1 - t0) * 28 <= 8 * G) {
                            LAS float* rt8_ = (LAS float*)(lds + 131072 + 1024) + 256; float vq[4];
#pragma unroll
                            for (int p = 0; p < 4; ++p) { const int idx = tid + 512 * p; pg8::Unit uu; vq[p] = S.next(idx >> 8, uu) ? RSL[uu.pm * 256 + (idx & 255)] : 0.f; }
#pragma unroll
                            for (int p = 0; p < 4; ++p) rt8_[tid + 512 * p] = vq[p];
                            __syncthreads(); E.pre = 2; }
                        pg8::gemm_phase<pg8::EpiSwiglu<true, FP8_MOE_DN != 0>, pg8::MoeOrder, true, FP8_MOE_GU != 0>(lds, FP8_MOE_GU ? 512 : 1024, S, E); }
                    SEAM();
                }
                if (IN(pb + 9 + 2 * ci)) { PHASE_IDS();
                    const int Tt = (int)MISC[32], t0 = 64 * ci, t1 = ci == 0 ? (Tt < 64 ? Tt : 64) : Tt;
                    const int t1w = t1 < 128 ? t1 : 128;
                    constexpr int DB = FP8_MOE_DN ? 1 : 2; constexpr float OSC = FP8_MOE_DN ? 1.f / (32.f * pg8::ACT8_SC) : 1.f;
                    if (t0 < t1w) { pg8::MoeOrder S{t0, t1w - t0, 4, G, bx, t0, (const char*)ACTM, (const char*)ws, (size_t)256 * DFF * DB, (size_t)0, (const LAS unsigned char*)(lds + MISC_OFF + 256), 0, 1};
                        pg8::EpiY E{Y, OSC}; pg8::gemm_phase<pg8::EpiY, pg8::MoeOrder, true, FP8_MOE_DN != 0>(lds, DFF * DB / 2, S, E); }
                    if (ci == 1 && t1 > 128) { pg8::MoeOrder S{128, t1 - 128, 4 * YPARTS, G, bx, t0, (const char*)ACTM, (const char*)ws, (size_t)256 * DFF * DB, (size_t)0, (const LAS unsigned char*)(lds + MISC_OFF + 256), 896 * 2, 1};
                        pg8::EpiYPart E{(bf16_t*)(ws + WS_YP), 128 * 256, OSC}; pg8::gemm_phase<pg8::EpiYPart, pg8::MoeOrder, true, FP8_MOE_DN != 0>(lds, DFF * DB / 2, S, E, 896); }
                    SEAM();
                }
            }
            if (IN(pb + 14)) { PHASE_IDS();
                const f32x4* fw = (const f32x4*)args.in[22] + lane;
                for (int m = gw; m < M; m += NGW) { const f32x4 se = SEL[m]; const int s0 = SLOT[m * 2], s1 = SLOT[m * 2 + 1];
                    f32x4* xr = (f32x4*)(XRES + (size_t)m * 1024) + lane; const bf16_t* YP = (const bf16_t*)(ws + WS_YP);
                    f32x4 v[4]; float ss = 0.f;
#pragma unroll
                    for (int j = 0; j < 4; ++j) v[j] = xr[64 * j];
#pragma unroll
                    for (int k = 0; k < 2; ++k) { const int sl = k == 0 ? s0 : s1; const float wk = k == 0 ? se.y : se.z;
                        const bool part = sl >= 128 * 256;
                        if (!part) { const unsigned* y8 = (const unsigned*)((const unsigned char*)Y + (size_t)sl * 1024) + lane; const float wq = wk * (1.f / pg8::Y8_SC);
#pragma unroll
                            for (int j = 0; j < 4; ++j) { const unsigned w = y8[64 * j]; const auto lo = __builtin_amdgcn_cvt_pk_f32_fp8((int)w, false), hi = __builtin_amdgcn_cvt_pk_f32_fp8((int)w, true);
                                v[j] += (f32x4){lo[0], lo[1], hi[0], hi[1]} * wq; } }
                        else { const u32x2* yb_ = (const u32x2*)(YP + (size_t)(sl - 128 * 256) * 1024) + lane;
                        for (int p = 0; p < YPARTS; ++p) { const u32x2* yp = yb_ + (size_t)p * 2048 * 1024 / 4;
#pragma unroll
                            for (int j = 0; j < 4; ++j) { const u32x2 a = yp[64 * j];
                                const f32x4 ya = {__uint_as_float(a.x << 16), __uint_as_float(a.x & 0xffff0000u), __uint_as_float(a.y << 16), __uint_as_float(a.y & 0xffff0000u)}; v[j] += ya * wk; } } } }
#pragma unroll
                    for (int j = 0; j < 4; ++j) ss += (v[j].x * v[j].x + v[j].y * v[j].y) + (v[j].z * v[j].z + v[j].w * v[j].w);
                    const float r = __builtin_amdgcn_rsqf(wave_sum(ss) * (1.f / 1024.f) + EPS);
#pragma unroll
                    for (int j = 0; j < 4; ++j) xr[64 * j] = v[j] * r * fw[64 * j]; }
            }
        }
}

__global__ void __launch_bounds__(512, 2) hybrid_fwd(Args args) {
    extern __shared__ __attribute__((aligned(16))) unsigned char lds_raw[];
    LAS unsigned char* lds = (LAS unsigned char*)lds_raw;
    volatile LAS unsigned* MISC = (volatile LAS unsigned*)(lds + MISC_OFF);
    const int G = gridDim.x, bx = blockIdx.x, vcu = (bx & 7) * (G >> 3) + (bx >> 3), NGW = G * 8;
    unsigned char* ws = args.ws;
    for (int u = threadIdx.x; u < (LDS_BYTES - MISC_OFF) / 4; u += 512) MISC[u] = 0u;
    __syncthreads();
    XcdBarrier bar; bar.bar = (unsigned*)(ws + WS_CTL); bar.x = 0; bar.st = nullptr;
    if (!MK_PER_PHASE) bar = xcd_barrier_post((unsigned*)(ws + WS_CTL), MISC + 8);
    const int lo = args.ph_lo, hi = args.ph_hi;
    float* XRES = args.out;
    float* SSQ16 = (float*)(ws + WS_SSQ16); const f32x2* T64 = (const f32x2*)(ws + WS_TAB64); const f32x2* T32 = (const f32x2*)(ws + WS_TAB32);
    float* SSQC = (float*)(ws + WS_SSQC); float* SSQK = (float*)(ws + WS_SSQK); float* LOGF = (float*)(ws + WS_LOGF);
    bf16_t* CUMB = (bf16_t*)(ws + WS_CUMB); bf16_t* KR = (bf16_t*)(ws + WS_KR); float* CUMF = (float*)(ws + WS_CUMF);
    bf16_t* XB = (bf16_t*)(ws + WS_XB); bf16_t* MERGED = (bf16_t*)(ws + WS_FQ);
    bf16_t *FQ = (bf16_t*)(ws + WS_FQ), *FK = (bf16_t*)(ws + WS_FK), *FV = (bf16_t*)(ws + WS_FV), *RQ = (bf16_t*)(ws + WS_RQ), *KG = (bf16_t*)(ws + WS_KG), *RV = (bf16_t*)(ws + WS_RV);
    bf16_t *RG = (bf16_t*)(ws + WS_RG), *GATES = (bf16_t*)(ws + WS_GATES), *CQ = (bf16_t*)(ws + WS_CQ), *CKV = (bf16_t*)(ws + WS_CKV);
    bf16_t *MQ = (bf16_t*)(ws + WS_MQ), *KN = (bf16_t*)(ws + WS_KN), *MV = (bf16_t*)(ws + WS_MV), *OCAT = (bf16_t*)(ws + WS_OCAT), *RP = (bf16_t*)(ws + WS_RP), *X1B = (bf16_t*)(ws + WS_X1B);
    float* Tst = (float*)(ws + WS_T); bf16_t* ACT = (bf16_t*)(ws + WS_ACT);

    if (IN(0)) { PHASE_IDS();
        int rot = 0;
        if (!CVT_L1_IN_P4) { CVT_LAYER(1); CVT_DENSE(); }
        CVT_LAYER(0);
        for (int idx = bx * 512 + tid; idx < SEQ * 32; idx += G * 512) { const int pos = idx >> 5, i = idx & 31; const double inv = exp2(-(double)(2 * i) / 64.0 * 13.287712379549449), ang = (double)pos * inv;
            ((f32x2*)(ws + WS_TAB64))[idx] = (f32x2){(float)cos(ang), (float)sin(ang)}; }
        for (int idx = bx * 512 + tid; idx < SEQ * 16; idx += G * 512) { const int pos = idx >> 4, i = idx & 15; const double inv = exp2(-(double)(2 * i) / 32.0 * 13.287712379549449), ang = (double)pos * inv;
            ((f32x2*)(ws + WS_TAB32))[idx] = (f32x2){(float)cos(ang), (float)sin(ang)}; }
        for (int m = gw; m < M; m += NGW) { const f32x4* xr = (const f32x4*)(args.in[0] + (size_t)m * 1024) + lane; u32x2* o8 = (u32x2*)(XB + (size_t)m * 1024) + lane; float s = 0.f;
#pragma unroll
            for (int j = 0; j < 4; ++j) { const f32x4 v = xr[64 * j]; s += (v.x * v.x + v.y * v.y) + (v.z * v.z + v.w * v.w); o8[64 * j] = (u32x2){pk2(v.x, v.y), pk2(v.z, v.w)};
                ((unsigned*)(ws + WS_XB8 + (size_t)m * 1024))[64 * j + lane] = pk4_fp8(v.x, v.y, v.z, v.w); }
            s = wave_sum(s); if (lane < 16) SSQ16[(size_t)m * 16 + lane] = lane == 0 ? s : 0.f; }
        SEAM();
    }

    layer_body<0>(args, lds, MISC, bar, lo, hi);
    layer_body<1>(args, lds, MISC, bar, lo, hi);
}
#undef IN
#undef SEAM

extern "C" void kernel_launch(void* const* d_in, const int* in_sizes, int n_in, void* d_out, int out_size, void* d_ws, size_t ws_size, hipStream_t stream) {
    static int ready = 0;
    if (ready == 0) {
        ready = -1;
        if (n_in != 23 || in_sizes[0] != M * DM || out_size != M * DM || ws_size < WS_END) { fprintf(stderr, "kernel_launch: unexpected shapes (n_in %d, in0 %d, out %d, ws %zu < %zu); nothing launched\n", n_in, n_in > 0 ? in_sizes[0] : -1, out_size, ws_size, (size_t)WS_END); return; }
        if (hipFuncSetAttribute((const void*)hybrid_fwd, hipFuncAttributeMaxDynamicSharedMemorySize, LDS_BYTES) != hipSuccess) { fprintf(stderr, "kernel_launch: hipFuncSetAttribute failed\n"); return; }
        int per_cu = 0; if (hipOccupancyMaxActiveBlocksPerMultiprocessor(&per_cu, (const void*)hybrid_fwd, 512, LDS_BYTES) != hipSuccess || per_cu < 1) fprintf(stderr, "kernel_launch: occupancy query says %d\n", per_cu);
        (void)hipGetLastError();
        ready = 1;
    }
    if (ready < 0) return;
    (void)hipMemsetAsync((char*)d_ws + WS_CTL, 0, CTL_ZERO_BYTES, stream);
    Args a{};
    for (int i = 0; i < 23; ++i) a.in[i] = (const float*)d_in[i];
    a.out = (float*)d_out; a.ws = (unsigned char*)d_ws;
#if MK_PER_PHASE
    for (int p = 0; p < NPH; ++p) {
        const bool exists = p == 0 || (p >= PH(0, 0) && p <= PH(0, 7)) || (p >= PH(1, 0) && p <= PH(1, 14));
        if (!exists) continue;
        a.ph_lo = p; a.ph_hi = p + 1;
        hipLaunchKernelGGL(hybrid_fwd, dim3(256), dim3(512), LDS_BYTES, stream, a);
    }
#else
    a.ph_lo = 0; a.ph_hi = NPH;
    hipLaunchKernelGGL(hybrid_fwd, dim3(256), dim3(512), LDS_BYTES, stream, a);
#endif
}
```

```cpp
#include <hip/hip_runtime.h>
#include <hip/hip_bf16.h>
#include <cstdio>
#include <cstdint>

#ifndef FP8_MOE_GU
#define FP8_MOE_GU 1
#endif
#ifndef FP8_MOE_DN
#define FP8_MOE_DN 1
#endif
#ifndef CVT_MOE_IN_P4
#define CVT_MOE_IN_P4 1
#endif
#ifndef CVT_L1_IN_P4
#define CVT_L1_IN_P4 1
#endif
#ifndef FP8_DENSE_GU
#define FP8_DENSE_GU 0
#endif
#define YPARTS (FP8_MOE_DN ? 7 : 4)
#define YPART_BYTES (FP8_MOE_DN ? 512 : 1792)
#ifndef MK_PER_PHASE
#define MK_PER_PHASE 0
#endif

#define LAS __attribute__((address_space(3)))
typedef unsigned short bf16_t;
typedef short bf16x8 __attribute__((ext_vector_type(8)));
typedef short s16x4 __attribute__((ext_vector_type(4)));
typedef float f32x2 __attribute__((ext_vector_type(2)));
typedef float f32x4 __attribute__((ext_vector_type(4)));
typedef float f32x16 __attribute__((ext_vector_type(16)));
typedef unsigned u32x2 __attribute__((ext_vector_type(2)));
typedef unsigned u32x4 __attribute__((ext_vector_type(4)));
typedef __bf16 bf16x2_t __attribute__((ext_vector_type(2)));

constexpr int BATCH = 2, SEQ = 8192, DM = 1024, M = BATCH * SEQ;
constexpr int DIN = 8360, NP1 = 8448;
constexpr int DFF = 3584, NEXP = 8;
constexpr int MAXT = 136;
constexpr float EPS = 1e-6f;
constexpr float LOG2E = 1.4426950408889634f;
constexpr float C2F = 0.125f * LOG2E;
constexpr float C2M = 0.10206207261596575f * LOG2E;

__device__ __forceinline__ int opaque_tid() { int t = threadIdx.x; asm volatile("" : "+v"(t)); return t; }
template <int MASK> __device__ __forceinline__ float add_xor(float v) {
    if constexpr (MASK == 32) { auto rr = __builtin_amdgcn_permlane32_swap(__float_as_uint(v), __float_as_uint(v), false, false); return __uint_as_float(rr[0]) + __uint_as_float(rr[1]); }
    else return v + __int_as_float(__builtin_amdgcn_ds_swizzle(__float_as_int(v), (MASK << 10) | 0x1F));
}
__device__ __forceinline__ unsigned pk2(float lo, float hi) { f32x2 v = {lo, hi}; bf16x2_t b = __builtin_convertvector(v, bf16x2_t); return __builtin_bit_cast(unsigned, b); }
__device__ __forceinline__ unsigned pk4_fp8(float a, float b, float c, float d) { a = __builtin_amdgcn_fmed3f(a, -448.f, 448.f); b = __builtin_amdgcn_fmed3f(b, -448.f, 448.f); c = __builtin_amdgcn_fmed3f(c, -448.f, 448.f); d = __builtin_amdgcn_fmed3f(d, -448.f, 448.f); int v = __builtin_amdgcn_cvt_pk_fp8_f32(a, b, 0, false); v = __builtin_amdgcn_cvt_pk_fp8_f32(c, d, v, true); return (unsigned)v; }
__device__ __forceinline__ float bf2f(unsigned short u) { return __uint_as_float((unsigned)u << 16); }
__device__ __forceinline__ unsigned short f2bf(float f) { return (unsigned short)(pk2(f, 0.f) & 0xffffu); }
__device__ __forceinline__ float fexp2(float x) { return __builtin_amdgcn_exp2f(x); }
__device__ __forceinline__ float sigmoidf_(float x) { return __builtin_amdgcn_rcpf(1.f + fexp2(-x * LOG2E)); }
__device__ __forceinline__ float lg2gamma(int h) { const float e = fexp2((float)(-5 - h)); return -(e * (1.f + e * (0.5f + e * (0.33333333f + e * (0.25f + e * (0.2f + e * 0.16666667f)))))) * LOG2E; }

namespace pg8 {
constexpr int BM = 256, BK = 64, HALF = 128, HTB = HALF * BK * 2, STAGE_BYTES = 8 * HTB, NXCD = 8, WGM = 8;
__host__ __device__ __forceinline__ int lds_byte(int r, int c) { const int st = (r >> 4) * 2 + (c >> 5), rr = r & 15, cc = c & 31, ob = rr * 64 + cc * 2; return st * 1024 + (ob ^ (((ob >> 9) & 1) << 5)); }
__host__ __device__ __forceinline__ void stage_rc(int b, int& R, int& C) { const int st = b / 1024, sb = b % 1024, swz = sb ^ (((sb >> 9) & 1) << 5); R = (st >> 1) * 16 + swz / 64; C = (st & 1) * 32 + (swz % 64) / 2; }
__host__ __device__ __forceinline__ int perm32(int rho) { const int n = rho >> 4, i = rho & 15; return 8 * (i >> 2) + 4 * n + (i & 3); }

struct Unit { int pm, pn; const char* A; const char* B; int k; };

__device__ __forceinline__ bool grid_order(int i, int G, int c, int nM, int nN, int& pm, int& pn) {
    const int nwg = nM * nN; const long L = (long)i * G + c; if (L >= nwg) return false;
    int wgid = (int)L; { const int q = nwg / NXCD, r = nwg % NXCD, xcd = wgid % NXCD, off = wgid / NXCD; wgid = (xcd < r ? xcd * (q + 1) : r * (q + 1) + (xcd - r) * q) + off; }
    const int nig = WGM * nN, gid = wgid / nig, fm = gid * WGM, gsz = (nM - fm) < WGM ? (nM - fm) : WGM;
    pm = fm + ((wgid % nig) % gsz); pn = (wgid % nig) / gsz; return true;
}
struct GridOrder {
    int nM, nN, G, c; const char* A; const char* Bt; size_t tstep; int pn_off = 0, pn_skip = 1 << 30, pn_add = 1;
    __device__ __forceinline__ void init(int nM_, int nN_, int G_, int c_, const void* A_, const void* Bt_, int K) { nM = nM_; nN = nN_; G = G_; c = c_; A = (const char*)A_; Bt = (const char*)Bt_; tstep = (size_t)BM * K * 2; }
    __device__ __forceinline__ bool next(int i, Unit& u) const { if (!grid_order(i, G, c, nM, nN, u.pm, u.pn)) return false; u.pn += pn_off; if (u.pn >= pn_skip) u.pn += pn_add;
        u.A = A + (size_t)u.pm * tstep; u.B = Bt + (size_t)u.pn * tstep; return true; }
};
__host__ __device__ __forceinline__ size_t moe_gu_base(int e) { return e < 5 ? ((size_t)12 << 20) + (size_t)e * (7u << 20) : ((size_t)60 << 20) + (size_t)(e - 5) * (7u << 20); }
__host__ __device__ __forceinline__ size_t moe_dn_base(int e) { return e == 0 ? ((size_t)47 << 20) : e < 6 ? ((size_t)353 << 20) + (size_t)(e - 1) * (7u << 19) : e == 6 ? ((size_t)525 << 20) : ((size_t)461 << 20); }
struct MoeOrder {
    int t0, nM, nN, G, c, arow0; const char* A; const char* Bt; size_t tstep, estride; const LAS unsigned char* te; int kpart_bytes = 0, dn = 0;
    __device__ __forceinline__ bool next(int i, Unit& u) const { int pm, pn; if (!grid_order(i, G, c, nM, nN, pm, pn)) return false; u.pm = t0 + pm; u.pn = pn; u.k = i;
        const int kp = kpart_bytes ? (pn >> 2) : 0, pnn = kpart_bytes ? (pn & 3) : pn;
        u.A = A + (size_t)(u.pm - arow0) * tstep + (size_t)kp * kpart_bytes; u.B = Bt + (dn ? moe_dn_base(te[u.pm]) : moe_gu_base(te[u.pm])) + (size_t)pnn * tstep + (size_t)kp * kpart_bytes; return true; }
};

typedef int i32x4_t __attribute__((ext_vector_type(4)));
typedef int i32x8_t __attribute__((ext_vector_type(8)));
__device__ __forceinline__ i32x8_t cat8(const bf16x8 lo, const bf16x8 hi) { return __builtin_shufflevector(__builtin_bit_cast(i32x4_t, lo), __builtin_bit_cast(i32x4_t, hi), 0, 1, 2, 3, 4, 5, 6, 7); }
template <class Epi, class Sched, bool ALIGN_EPI, bool FP8 = false>
__device__ __forceinline__ void gemm_phase(LAS unsigned char* lds, const int K, const Sched& S, const Epi& E, const int KLEN = 0) {
    const int tid = opaque_tid(), wid = __builtin_amdgcn_readfirstlane(tid >> 6), lane = tid & 63, wr = wid >> 2, wc = wid & 3, fr = lane & 15, fq = lane >> 4;
    const int nt = (KLEN ? KLEN : K) / BK;
    LAS float* rtab = (LAS float*)(lds + 131072 + 1024);
    unsigned voffA[2], voffB[2];
#pragma unroll
    for (int i = 0; i < 2; ++i) { int R, C; stage_rc(tid * 16 + i * 8192, R, C); const int Rb = (R & ~31) + perm32(R & 31);
        voffA[i] = (unsigned)(R * K + C) * 2u; voffB[i] = (unsigned)(Rb * K + C) * 2u; }
    const size_t kstep = (size_t)(BK * 2);
    const size_t hstep = (size_t)HALF * K * 2;
    const unsigned ldsw = (unsigned)wid * 1024u;
    const int aoff = lds_byte(wr * 64 + fr, fq * 8), boff = lds_byte(wc * 32 + fr, fq * 8);
#define PG8_SA(b, h) (((b) * 2 + (h)) * HTB)
#define PG8_SB(b, h) ((4 + (b) * 2 + (h)) * HTB)
#define PG8_STAGE(bufoff, gbase, voff) do { _Pragma("unroll") for (int _i = 0; _i < 2; ++_i) \
        __builtin_amdgcn_global_load_lds((const unsigned*)((const char*)(gbase) + (voff)[_i]), (LAS unsigned*)(lds + (bufoff) + ldsw + _i * 8192), 16, 0, 0); } while (0)
#define PG8_LDA(dst, b, h) do { _Pragma("unroll") for (int m = 0; m < 4; ++m) { if constexpr (FP8) dst##8[m] = cat8(*(const LAS bf16x8*)(lds + PG8_SA(b, h) + aoff + m * 2048), *(const LAS bf16x8*)(lds + PG8_SA(b, h) + aoff + m * 2048 + 1024)); \
        else { _Pragma("unroll") for (int k = 0; k < 2; ++k) dst[m][k] = *(const LAS bf16x8*)(lds + PG8_SA(b, h) + aoff + m * 2048 + k * 1024); } } } while (0)
#define PG8_LDB(dst, b, h) do { _Pragma("unroll") for (int n = 0; n < 2; ++n) { if constexpr (FP8) dst##8[n] = cat8(*(const LAS bf16x8*)(lds + PG8_SB(b, h) + boff + n * 2048), *(const LAS bf16x8*)(lds + PG8_SB(b, h) + boff + n * 2048 + 1024)); \
        else { _Pragma("unroll") for (int k = 0; k < 2; ++k) dst[n][k] = *(const LAS bf16x8*)(lds + PG8_SB(b, h) + boff + n * 2048 + k * 1024); } } } while (0)
#define PG8_MMA(ai, bj, At, Bt) do { __builtin_amdgcn_s_setprio(1); _Pragma("unroll") for (int m = 0; m < 4; ++m) _Pragma("unroll") for (int n = 0; n < 2; ++n) { \
        if constexpr (FP8) asm volatile("s_nop 1\n\tv_mfma_scale_f32_16x16x128_f8f6f4 %0, %1, %2, %0, %3, %3 op_sel_hi:[0,0,0]" : "+v"(acc[ai][bj][m][n]) : "v"(Bt##8[n]), "v"(At##8[m]), "v"(sc1_)); \
        else { _Pragma("unroll") for (int k = 0; k < 2; ++k) acc[ai][bj][m][n] = __builtin_amdgcn_mfma_f32_16x16x32_bf16(Bt[n][k], At[m][k], acc[ai][bj][m][n], 0, 0, 0); } } __builtin_amdgcn_s_setprio(0); } while (0)
#define PG8_WAIT_V(n) asm volatile("s_waitcnt vmcnt(" #n ")" ::: "memory")
#define PG8_WAIT_L(n) asm volatile("s_waitcnt lgkmcnt(" #n ")" ::: "memory")
#define PG8_BAR __builtin_amdgcn_s_barrier()
#define PG8_SCHED __builtin_amdgcn_sched_barrier(0)
    Unit cur, nxt; int ui = 0;
    if (!S.next(0, cur)) return;
    f32x4 acc[2][2][4][2];
    if constexpr (Epi::HAS_INIT) E.init(acc, cur, wr, wc, fr, fq);
    else {
#pragma unroll
    for (int a = 0; a < 2; ++a)
#pragma unroll
        for (int b = 0; b < 2; ++b)
#pragma unroll
            for (int m = 0; m < 4; ++m)
#pragma unroll
                for (int n = 0; n < 2; ++n) acc[a][b][m][n] = (f32x4){0.f, 0.f, 0.f, 0.f};
    }
    int sc1_ = 0x7F7F7F7F; asm volatile("" : "+v"(sc1_));
    bf16x8 At[4][2], B0[2][2], B1[2][2]; i32x8_t At8[4], B08[2], B18[2]; (void)At; (void)B0; (void)B1; (void)At8; (void)B08; (void)B18;
    const char* cA = cur.A; const char* cB = cur.B;
    PG8_STAGE(PG8_SB(0, 0), cB, voffB); PG8_STAGE(PG8_SB(0, 1), cB + hstep, voffB); PG8_STAGE(PG8_SA(0, 0), cA, voffA); PG8_STAGE(PG8_SA(0, 1), cA + hstep, voffA);
    if (wr == 1) PG8_BAR;
    PG8_WAIT_V(2); PG8_BAR;
    PG8_STAGE(PG8_SB(1, 0), cB + kstep, voffB); PG8_STAGE(PG8_SA(1, 0), cA + kstep, voffA); PG8_STAGE(PG8_SB(1, 1), cB + hstep + kstep, voffB);
    PG8_WAIT_V(6); PG8_BAR;
    for (;;) {
        const bool has_next = S.next(ui + 1, nxt);
        const char* nA = has_next ? nxt.A : cA; const char* nB = has_next ? nxt.B : cB;
        int t = 0;
#pragma nounroll
        for (int sg = 0; sg < (Epi::HAS_MID ? 3 : 1); ++sg) {
        int tend = nt; if constexpr (Epi::HAS_MID) tend = sg == 0 ? Epi::MID0 : (sg == 1 ? Epi::MID1 : nt);
#pragma nounroll
        for (; t < tend; t += 2) {
            const bool last = (t == nt - 2);
            const char* a1 = cA + (size_t)(t + 1) * kstep;
            const char* a2 = last ? nA : cA + (size_t)(t + 2) * kstep; const char* b2 = last ? nB : cB + (size_t)(t + 2) * kstep;
            const char* a3 = a2 + kstep; const char* b3 = b2 + kstep;
            PG8_LDB(B0, 0, 0); PG8_LDB(B1, 0, 1); PG8_SCHED; PG8_LDA(At, 0, 0); PG8_STAGE(PG8_SA(1, 1), a1 + hstep, voffA);
            PG8_WAIT_V(8); PG8_WAIT_L(0); PG8_BAR; PG8_MMA(0, 0, At, B0); PG8_MMA(0, 1, At, B1); PG8_BAR; PG8_SCHED;
            PG8_LDA(At, 0, 1); PG8_STAGE(PG8_SB(0, 0), b2, voffB); PG8_STAGE(PG8_SB(0, 1), b2 + hstep, voffB); PG8_STAGE(PG8_SA(0, 0), a2, voffA);
            PG8_WAIT_V(8); PG8_WAIT_L(0); PG8_BAR; PG8_MMA(1, 0, At, B0); PG8_MMA(1, 1, At, B1); PG8_BAR; PG8_SCHED;
            PG8_LDB(B0, 1, 0); PG8_LDB(B1, 1, 1); PG8_SCHED; PG8_LDA(At, 1, 0); PG8_STAGE(PG8_SA(0, 1), a2 + hstep, voffA);
            PG8_WAIT_V(8); PG8_WAIT_L(0); PG8_BAR; PG8_MMA(0, 0, At, B0); PG8_MMA(0, 1, At, B1); PG8_BAR; PG8_SCHED;
            PG8_LDA(At, 1, 1); PG8_STAGE(PG8_SB(1, 0), b3, voffB); PG8_STAGE(PG8_SB(1, 1), b3 + hstep, voffB); PG8_STAGE(PG8_SA(1, 0), a3, voffA);
            PG8_WAIT_V(8); PG8_WAIT_L(0); PG8_BAR; PG8_MMA(1, 0, At, B0); PG8_MMA(1, 1, At, B1); PG8_BAR; PG8_SCHED;
        }
        if constexpr (Epi::HAS_MID) { if (sg < 2) E.mid(acc, cur, wr, wc, fr, fq, t); }
        }
        if constexpr (FP8) { asm volatile("s_nop 15\n\ts_nop 7" ::: "memory"); PG8_SCHED; }
        if constexpr (ALIGN_EPI) { if (wr == 0) PG8_BAR; }
        if constexpr (Epi::NEEDS_RS) { static_assert(ALIGN_EPI, "r-table needs aligned halves"); if (!E.prefilled()) { E.rs_table(cur, rtab); PG8_WAIT_L(0); PG8_BAR; asm volatile("" ::: "memory"); } }
        E(acc, cur, wr, wc, fr, fq, rtab);
        if (!has_next) break;
        if constexpr (Epi::HAS_INIT) E.init(acc, nxt, wr, wc, fr, fq);
        else {
#pragma unroll
        for (int a = 0; a < 2; ++a)
#pragma unroll
            for (int b = 0; b < 2; ++b)
#pragma unroll
                for (int m = 0; m < 4; ++m)
#pragma unroll
                    for (int n = 0; n < 2; ++n) acc[a][b][m][n] = (f32x4){0.f, 0.f, 0.f, 0.f};
        }
        cur = nxt; cA = nA; cB = nB; ++ui;
        if constexpr (ALIGN_EPI) { if (wr == 1) PG8_BAR; }
    }
    PG8_WAIT_V(0);
    if constexpr (!ALIGN_EPI) { if (wr == 0) PG8_BAR; }
    PG8_BAR;
#undef PG8_SA
#undef PG8_SB
#undef PG8_STAGE
#undef PG8_LDA
#undef PG8_LDB
#undef PG8_MMA
#undef PG8_WAIT_V
#undef PG8_WAIT_L
#undef PG8_BAR
#undef PG8_SCHED
}

template <int NP> __device__ __forceinline__ void rs_fill(const float* part, int row_first, float inv_n, LAS float* rtab) {
    const int tid = opaque_tid(), rl = tid >> 1, half = tid & 1; const float* p = part + (size_t)(row_first + rl) * NP + half * (NP / 2); float s;
    if constexpr (NP == 16) { const f32x4 a = *(const f32x4*)p, b = *(const f32x4*)(p + 4); s = ((a.x + a.y) + (a.z + a.w)) + ((b.x + b.y) + (b.z + b.w)); }
    else if constexpr (NP == 12) { const f32x2 a = *(const f32x2*)p, b = *(const f32x2*)(p + 2), c = *(const f32x2*)(p + 4); s = (a.x + a.y) + (b.x + b.y) + (c.x + c.y); }
    else { const f32x4 a = *(const f32x4*)p; s = (a.x + a.y) + (a.z + a.w); }
    s = add_xor<1>(s);
    if (half == 0) rtab[rl] = __builtin_amdgcn_rsqf(s * inv_n + EPS);
}
#define ST16(p, v) (*(u32x4*)(p) = (v))
__device__ __forceinline__ u32x4 pack8(const f32x4 a, const f32x4 b) { u32x4 w; w.x = pk2(a.x, a.y); w.y = pk2(a.z, a.w); w.z = pk2(b.x, b.y); w.w = pk2(b.z, b.w); return w; }
__device__ __forceinline__ float sum8sq(const f32x4 a, const f32x4 b) { return ((a.x * a.x + a.y * a.y) + (a.z * a.z + a.w * a.w)) + ((b.x * b.x + b.y * b.y) + (b.z * b.z + b.w * b.w)); }
__device__ __forceinline__ void rope4(f32x4& x1, f32x4& x2, const f32x4 t0, const f32x4 t1) {
    const f32x4 c = {t0.x, t0.z, t1.x, t1.z}, s = {t0.y, t0.w, t1.y, t1.w};
    const f32x4 y1 = x1 * c - x2 * s, y2 = x2 * c + x1 * s; x1 = y1; x2 = y2;
}

#define RS_(ai, m) rt[(ai) * HALF + (m) * 16]
struct EpiP1 {
    bf16_t *FQ, *FK, *FV, *RQ, *KG, *RV, *RG, *GATES, *CQ, *CKV, *KR; float *LOGF, *SSQC, *SSQK;
    const float* SSQ16; const f32x2* T64; const f32x2* T32; const float* fbias; unsigned* KMSQ;
    int pre = 0;
    static constexpr bool NEEDS_RS = true, HAS_MID = false, HAS_INIT = false;
    __device__ __forceinline__ bool prefilled() const { return pre != 0; }
    __device__ __forceinline__ void rs_table(const Unit& u, LAS float* rtab) const { rs_fill<16>(SSQ16, u.pm * BM, 1.f / 1024.f, rtab); }
    __device__ __forceinline__ void operator()(const f32x4 (&acc)[2][2][4][2], const Unit& u, int wr, int wc, int fr, int fq, const LAS float* rtab) const {
        const int pn = u.pn, row0 = u.pm * BM + wr * 64 + fr, ct0 = wc * 32 + fq * 8; const LAS float* rt = rtab + (pre ? 256 + (u.pm & 7) * 256 : 0) + wr * 64 + fr;
        if (pn < 6 || (pn >= 10 && pn < 14)) {
            bf16_t* dst; int ld, cb; float sc = 1.f;
            if (pn < 2) { dst = FQ; ld = 512; cb = pn * 256; sc = C2F; } else if (pn < 4) { dst = FK; ld = 512; cb = (pn - 2) * 256; } else if (pn < 6) { dst = FV; ld = 512; cb = (pn - 4) * 256; } else { dst = RV; ld = 1024; cb = (pn - 10) * 256; }
            float mx[2] = {0.f, 0.f};
#pragma unroll
            for (int ai = 0; ai < 2; ++ai)
#pragma unroll
                for (int m = 0; m < 4; ++m) { const int row = row0 + ai * HALF + m * 16; const float s = RS_(ai, m) * sc; bf16_t* rp = dst + (size_t)row * ld + cb + ct0;
#pragma unroll
                    for (int bj = 0; bj < 2; ++bj) { const f32x4 a = acc[ai][bj][m][0] * s, b = acc[ai][bj][m][1] * s; ST16(rp + bj * HALF, pack8(a, b));
                        if (pn == 2 || pn == 3) { float q = sum8sq(a, b); q = add_xor<16>(q); q = add_xor<32>(q); mx[bj] = fmaxf(mx[bj], q); } } }
            if (pn == 2 || pn == 3) {
#pragma unroll
                for (int bj = 0; bj < 2; ++bj) { float q = mx[bj];
                    q = fmaxf(q, __int_as_float(__builtin_amdgcn_ds_swizzle(__float_as_int(q), (1 << 10) | 0x1F))); q = fmaxf(q, __int_as_float(__builtin_amdgcn_ds_swizzle(__float_as_int(q), (2 << 10) | 0x1F)));
                    q = fmaxf(q, __int_as_float(__builtin_amdgcn_ds_swizzle(__float_as_int(q), (4 << 10) | 0x1F))); q = fmaxf(q, __int_as_float(__builtin_amdgcn_ds_swizzle(__float_as_int(q), (8 << 10) | 0x1F)));
                    const int colb = (pn - 2) * 256 + bj * HALF + wc * 32;
                    if (fr == 0 && fq == 0) atomicMax(KMSQ + (((u.pm * BM) >> 13) * 8 + (colb >> 6)) * 2 + ((colb >> 5) & 1), __float_as_uint(q)); } }
        } else if (pn >= 14 && pn < 30) {
            const bool gl = pn >= 18; const int cb = (pn - 14) * 256;
            bf16_t* gfb = GATES + ((size_t)(((pn - 18) >> 2) * 64 + u.pm) * 4 + ((pn - 18) & 3)) * (8 * 16 * 64 * 8) + (size_t)((wr * 4 + wc) * 16) * 512 + (fq * 16 + fr) * 8;
#pragma unroll
            for (int ai = 0; ai < 2; ++ai)
#pragma unroll
                for (int m = 0; m < 4; ++m) { const int row = row0 + ai * HALF + m * 16; const float s = RS_(ai, m); bf16_t* rp = gl ? gfb + (ai * 8 + m * 2) * 512 - 0 : RG + (size_t)row * 1024 + cb + ct0; const int bstep = gl ? 512 : HALF;
#pragma unroll
                    for (int bj = 0; bj < 2; ++bj) { f32x4 v[2];
#pragma unroll
                        for (int n = 0; n < 2; ++n) { const f32x4 x = acc[ai][bj][m][n] * s; f32x4 sg; sg.x = sigmoidf_(x.x); sg.y = sigmoidf_(x.y); sg.z = sigmoidf_(x.z); sg.w = sigmoidf_(x.w); v[n] = gl ? sg : x * sg; }
                        ST16(rp + bj * bstep, pack8(v[0], v[1])); } }
        } else if (pn >= 6 && pn < 10) {
            const bool isk = pn >= 8; bf16_t* dst = isk ? KG : RQ; const int cb = (pn - (isk ? 8 : 6)) * 256; const int i0 = 16 * (wc & 1) + 4 * fq;
#pragma unroll
            for (int ai = 0; ai < 2; ++ai) {
                f32x4 tq0[4], tq1[4];
#pragma unroll
                for (int m = 0; m < 4; ++m) { const int pos = (row0 + ai * HALF + m * 16) & (SEQ - 1); const f32x4* tp = (const f32x4*)(T64 + (size_t)pos * 32 + i0); tq0[m] = tp[0]; tq1[m] = tp[1]; }
                asm volatile("" ::: "memory");
#pragma unroll
                for (int m = 0; m < 4; ++m) { const int row = row0 + ai * HALF + m * 16, pos = row & (SEQ - 1); const float s = RS_(ai, m); bf16_t* rp = dst + (size_t)row * 512 + cb + ct0;
                    const f32x4 t0 = tq0[m], t1 = tq1[m];
#pragma unroll
                    for (int bj = 0; bj < 2; ++bj) { f32x4 x1 = acc[ai][bj][m][0] * s, x2 = acc[ai][bj][m][1] * s; rope4(x1, x2, t0, t1);
                        if (isk) { const int head = (cb + bj * HALF + wc * 32) >> 6; const float ks = 0.125f * fexp2(-(float)(pos & 127) * lg2gamma(head)); x1 = x1 * ks; x2 = x2 * ks; }
                        ST16(rp + bj * HALF, pack8(x1, x2)); } }
                asm volatile("" ::: "memory"); }
        } else {
#pragma unroll
            for (int bj = 0; bj < 2; ++bj) {
                int kind, col, grp;
                if (pn == 30) { kind = 0; col = bj * HALF + ct0; grp = 4 * bj + wc; }
                else if (pn == 31) { if (bj == 0) { kind = 0; col = 256 + ct0; grp = 8 + wc; } else { kind = 1; col = ct0; grp = wc; } }
                else { if (bj == 0) { kind = 1; col = HALF + ct0; grp = 4 + wc; } else { kind = 2; col = 0; grp = 0; } }
                if (kind < 2) {
                    bf16_t* dst = kind == 0 ? CQ : CKV; const int ld = kind == 0 ? 384 : 256; float* sq = kind == 0 ? SSQC : SSQK; const int np = kind == 0 ? 12 : 8;
#pragma unroll
                    for (int ai = 0; ai < 2; ++ai)
#pragma unroll
                        for (int m = 0; m < 4; ++m) { const int row = row0 + ai * HALF + m * 16; const float s = RS_(ai, m); const f32x4 a = acc[ai][bj][m][0] * s, b = acc[ai][bj][m][1] * s;
                            ST16(dst + (size_t)row * ld + col, pack8(a, b));
                            float q = sum8sq(a, b); q = add_xor<16>(q); q = add_xor<32>(q);
                            if (fq == 0) sq[(size_t)row * np + grp] = q; }
                } else if (wc == 0) {
#pragma unroll
                    for (int ai = 0; ai < 2; ++ai) {
                        f32x4 tq0[4], tq1[4];
#pragma unroll
                        for (int m = 0; m < 4; ++m) { const int pos = (row0 + ai * HALF + m * 16) & (SEQ - 1); const f32x4* tp = (const f32x4*)(T32 + (size_t)pos * 16 + 4 * fq); tq0[m] = tp[0]; tq1[m] = tp[1]; }
                        asm volatile("" ::: "memory");
#pragma unroll
                        for (int m = 0; m < 4; ++m) { const int row = row0 + ai * HALF + m * 16; const float s = RS_(ai, m);
                            f32x4 x1 = acc[ai][bj][m][0] * s, x2 = acc[ai][bj][m][1] * s; rope4(x1, x2, tq0[m], tq1[m]);
                            ST16(KR + (size_t)row * 32 + 8 * fq, pack8(x1, x2)); }
                        asm volatile("" ::: "memory"); }
                } else if (wc == 1 && fq == 0) {
                    const f32x4 b0 = *(const f32x4*)(fbias), b1 = *(const f32x4*)(fbias + 4);
#pragma unroll
                    for (int ai = 0; ai < 2; ++ai)
#pragma unroll
                        for (int m = 0; m < 4; ++m) { const int row = row0 + ai * HALF + m * 16; const float s = RS_(ai, m);
                            const f32x4 a = acc[ai][bj][m][0] * s + b0, b = acc[ai][bj][m][1] * s + b1; f32x4 la, lb;
                            la.x = fminf(a.x, 0.f) - __logf(1.f + __expf(-fabsf(a.x))); la.y = fminf(a.y, 0.f) - __logf(1.f + __expf(-fabsf(a.y))); la.z = fminf(a.z, 0.f) - __logf(1.f + __expf(-fabsf(a.z))); la.w = fminf(a.w, 0.f) - __logf(1.f + __expf(-fabsf(a.w)));
                            lb.x = fminf(b.x, 0.f) - __logf(1.f + __expf(-fabsf(b.x))); lb.y = fminf(b.y, 0.f) - __logf(1.f + __expf(-fabsf(b.y))); lb.z = fminf(b.z, 0.f) - __logf(1.f + __expf(-fabsf(b.z))); lb.w = fminf(b.w, 0.f) - __logf(1.f + __expf(-fabsf(b.w)));
                            *(f32x4*)(LOGF + (size_t)row * 8) = la; *(f32x4*)(LOGF + (size_t)row * 8 + 4) = lb; }
                }
            }
        }
    }
};

__device__ __forceinline__ unsigned pk4_gate(const f32x4 g) {
    const unsigned a = (unsigned)fmaxf(g.x * 255.f + 0.5f, 1.f), b = (unsigned)fmaxf(g.y * 255.f + 0.5f, 1.f), c = (unsigned)fmaxf(g.z * 255.f + 0.5f, 1.f), d = (unsigned)fmaxf(g.w * 255.f + 0.5f, 1.f);
    return a | (b << 8) | (c << 16) | (d << 24); }
struct EpiGL8 {
    unsigned char* GATES;
    static constexpr bool NEEDS_RS = true, HAS_MID = false, HAS_INIT = false;
    __device__ __forceinline__ bool prefilled() const { return true; }
    __device__ __forceinline__ void rs_table(const Unit&, LAS float*) const {}
    __device__ __forceinline__ void operator()(const f32x4 (&acc)[2][2][4][2], const Unit& u, int wr, int wc, int fr, int fq, const LAS float* rtab) const {
        const LAS float* rt = rtab + 256 + (u.pm & 7) * 256 + wr * 64 + fr;
        unsigned char* gfb = GATES + ((size_t)((u.pn >> 2) * 64 + u.pm) * 4 + (u.pn & 3)) * (8 * 16 * 64 * 8) + (size_t)((wr * 4 + wc) * 16) * 512 + (fq * 16 + fr) * 8;
#pragma unroll
        for (int ai = 0; ai < 2; ++ai)
#pragma unroll
            for (int m = 0; m < 4; ++m) { const float s = RS_(ai, m) * (-LOG2E / 32.f);
#pragma unroll
                for (int bj = 0; bj < 2; ++bj) { f32x4 v[2];
#pragma unroll
                    for (int n = 0; n < 2; ++n) { const f32x4 t = acc[ai][bj][m][n] * s; v[n].x = __builtin_amdgcn_rcpf(1.f + fexp2(t.x)); v[n].y = __builtin_amdgcn_rcpf(1.f + fexp2(t.y)); v[n].z = __builtin_amdgcn_rcpf(1.f + fexp2(t.z)); v[n].w = __builtin_amdgcn_rcpf(1.f + fexp2(t.w)); }
                    *(u32x2*)(gfb + (ai * 8 + m * 2 + bj) * 512) = (u32x2){pk4_gate(v[0]), pk4_gate(v[1])}; } }
    }
};
struct EpiMQ {
    bf16_t* MQ; const float* SSQC; const f32x2* T32;
    static constexpr bool NEEDS_RS = true, HAS_MID = false, HAS_INIT = false;
    __device__ __forceinline__ bool prefilled() const { return false; }
    __device__ __forceinline__ void rs_table(const Unit& u, LAS float* rtab) const { rs_fill<12>(SSQC, u.pm * BM, 1.f / 384.f, rtab); }
    __device__ __forceinline__ void operator()(const f32x4 (&acc)[2][2][4][2], const Unit& u, int wr, int wc, int fr, int fq, const LAS float* rtab) const {
        const int row0 = u.pm * BM + wr * 64 + fr, ct0 = wc * 32 + fq * 8; const LAS float* rt = rtab + wr * 64 + fr;
#pragma unroll
        for (int ai = 0; ai < 2; ++ai) {
            f32x4 tq0[4], tq1[4];
#pragma unroll
            for (int m = 0; m < 4; ++m) { const int pos = (row0 + ai * HALF + m * 16) & (SEQ - 1); const f32x4* tp = (const f32x4*)(T32 + (size_t)pos * 16 + 4 * fq); tq0[m] = tp[0]; tq1[m] = tp[1]; }
            asm volatile("" ::: "memory");
#pragma unroll
            for (int m = 0; m < 4; ++m) { const int row = row0 + ai * HALF + m * 16; const float s = RS_(ai, m); bf16_t* rp = MQ + (size_t)row * 768 + u.pn * 256 + ct0;
                const f32x4 t0 = tq0[m], t1 = tq1[m];
#pragma unroll
                for (int bj = 0; bj < 2; ++bj) { const int G = 8 * u.pn + 4 * bj + wc; f32x4 x1 = acc[ai][bj][m][0] * s, x2 = acc[ai][bj][m][1] * s;
                    if (G % 3 == 2) rope4(x1, x2, t0, t1);
                    ST16(rp + bj * HALF, pack8(x1 * C2M, x2 * C2M)); } }
            asm volatile("" ::: "memory"); }
    }
};
struct EpiKV {
    bf16_t *KN, *MV; const float* SSQK;
    static constexpr bool NEEDS_RS = true, HAS_MID = false, HAS_INIT = false;
    __device__ __forceinline__ bool prefilled() const { return false; }
    __device__ __forceinline__ void rs_table(const Unit& u, LAS float* rtab) const { rs_fill<8>(SSQK, u.pm * BM, 1.f / 256.f, rtab); }
    __device__ __forceinline__ void operator()(const f32x4 (&acc)[2][2][4][2], const Unit& u, int wr, int wc, int fr, int fq, const LAS float* rtab) const {
        const int row0 = u.pm * BM + wr * 64 + fr, ct0 = wc * 32 + fq * 8; const LAS float* rt = rtab + wr * 64 + fr;
        bf16_t* dst = u.pn < 2 ? KN : MV; const int cb = (u.pn & 1) * 256;
#pragma unroll
        for (int ai = 0; ai < 2; ++ai)
#pragma unroll
            for (int m = 0; m < 4; ++m) { const int row = row0 + ai * HALF + m * 16; const float s = RS_(ai, m); bf16_t* rp = dst + (size_t)row * 512 + cb + ct0;
#pragma unroll
                for (int bj = 0; bj < 2; ++bj) ST16(rp + bj * HALF, pack8(acc[ai][bj][m][0] * s, acc[ai][bj][m][1] * s)); }
    }
};
struct EpiMerge {
    const unsigned char* GATES; bf16_t* MERGED;
    static constexpr bool NEEDS_RS = false, HAS_MID = true, HAS_INIT = false; static constexpr int MID0 = 8, MID1 = 24;
    static __device__ __forceinline__ void unpack_gate(const u32x2 g, f32x4& g0, f32x4& g1) {
        g0 = (f32x4){(float)(g.x & 255u), (float)((g.x >> 8) & 255u), (float)((g.x >> 16) & 255u), (float)(g.x >> 24)};
        g1 = (f32x4){(float)(g.y & 255u), (float)((g.y >> 8) & 255u), (float)((g.y >> 16) & 255u), (float)(g.y >> 24)}; }
    __device__ __forceinline__ void mid(f32x4 (&acc)[2][2][4][2], const Unit& u, int wr, int wc, int fr, int fq, int t) const {
        int row0 = ((wr * 4 + wc) * 16) * 512 + (fq * 16 + fr) * 8; asm volatile("" : "+v"(row0));
        const int br = t == MID0 ? 0 : 1;
        const unsigned char* gfb = GATES + ((size_t)(br * 64 + u.pm) * 4 + u.pn) * (8 * 16 * 64 * 8) + (size_t)row0;
#pragma unroll
        for (int ai = 0; ai < 2; ++ai) {
            u32x2 pq[8], nq[8];
#pragma unroll
            for (int sl = 0; sl < 8; ++sl) { const unsigned char* gp = gfb + (ai * 8 + sl) * 512; pq[sl] = *(const u32x2*)gp; nq[sl] = *(const u32x2*)(gp + (size_t)64 * 4 * (8 * 16 * 64 * 8)); }
            asm volatile("" ::: "memory");
#pragma unroll
            for (int m = 0; m < 4; ++m) {
#pragma unroll
                for (int bj = 0; bj < 2; ++bj) {
                    f32x4 p0, p1, n0, n1; unpack_gate(pq[m * 2 + bj], p0, p1); unpack_gate(nq[m * 2 + bj], n0, n1);
                    n0.x = __builtin_amdgcn_rcpf(n0.x); n0.y = __builtin_amdgcn_rcpf(n0.y); n0.z = __builtin_amdgcn_rcpf(n0.z); n0.w = __builtin_amdgcn_rcpf(n0.w);
                    n1.x = __builtin_amdgcn_rcpf(n1.x); n1.y = __builtin_amdgcn_rcpf(n1.y); n1.z = __builtin_amdgcn_rcpf(n1.z); n1.w = __builtin_amdgcn_rcpf(n1.w);
                    acc[ai][bj][m][0] = acc[ai][bj][m][0] * (p0 * n0); acc[ai][bj][m][1] = acc[ai][bj][m][1] * (p1 * n1); }
                }
            asm volatile("" ::: "memory"); }
    }
    __device__ __forceinline__ void operator()(const f32x4 (&acc)[2][2][4][2], const Unit& u, int wr, int wc, int fr, int fq, const LAS float* rtab) const {
        const int row0 = u.pm * BM + wr * 64 + fr, c0 = u.pn * BM + wc * 32 + fq * 8;
        const unsigned char* gfb = GATES + ((size_t)(2 * 64 + u.pm) * 4 + u.pn) * (8 * 16 * 64 * 8) + (size_t)((wr * 4 + wc) * 16) * 512 + (fq * 16 + fr) * 8;
        u32x2 gq[16];
#pragma unroll
        for (int sl = 0; sl < 16; ++sl) gq[sl] = *(const u32x2*)(gfb + sl * 512);
        asm volatile("" ::: "memory");
#pragma unroll
        for (int ai = 0; ai < 2; ++ai)
#pragma unroll
            for (int m = 0; m < 4; ++m) { const int row = row0 + ai * HALF + m * 16;
#pragma unroll
                for (int bj = 0; bj < 2; ++bj) { const int col = c0 + bj * HALF; f32x4 g0, g1; unpack_gate(gq[ai * 8 + m * 2 + bj], g0, g1);
                    *(u32x4*)(MERGED + (size_t)row * 1024 + col) = pack8(acc[ai][bj][m][0] * (g0 * (1.f / 255.f)), acc[ai][bj][m][1] * (g1 * (1.f / 255.f))); }
                }
    }
};
struct EpiResid {
    const float* xin; float* xo; bf16_t* XB; float* SSQ16; unsigned char* XB8 = nullptr;
    const bf16_t* xin16 = nullptr;
    static constexpr bool NEEDS_RS = false, HAS_MID = false, HAS_INIT = true;
    __device__ __forceinline__ void init(f32x4 (&acc)[2][2][4][2], const Unit& u, int wr, int wc, int fr, int fq) const {
        const int row0 = u.pm * BM + wr * 64 + fr, c0 = u.pn * BM + wc * 32 + fq * 8;
#pragma unroll
        for (int ai = 0; ai < 2; ++ai)
#pragma unroll
            for (int m = 0; m < 4; ++m)
#pragma unroll
                for (int bj = 0; bj < 2; ++bj) { const size_t off = (size_t)(row0 + ai * HALF + m * 16) * 1024 + c0 + bj * HALF;
                    if (xin16) { const u32x4 w = *(const u32x4*)(xin16 + off);
                        acc[ai][bj][m][0] = (f32x4){__uint_as_float(w.x << 16), __uint_as_float(w.x & 0xffff0000u), __uint_as_float(w.y << 16), __uint_as_float(w.y & 0xffff0000u)};
                        acc[ai][bj][m][1] = (f32x4){__uint_as_float(w.z << 16), __uint_as_float(w.z & 0xffff0000u), __uint_as_float(w.w << 16), __uint_as_float(w.w & 0xffff0000u)}; }
                    else { const float* p = xin + off; acc[ai][bj][m][0] = *(const f32x4*)p; acc[ai][bj][m][1] = *(const f32x4*)(p + 4); } }
    }
    __device__ __forceinline__ void operator()(const f32x4 (&acc)[2][2][4][2], const Unit& u, int wr, int wc, int fr, int fq, const LAS float* rtab) const {
        const int row0 = u.pm * BM + wr * 64 + fr, c0 = u.pn * BM + wc * 32 + fq * 8;
#pragma unroll
        for (int ai = 0; ai < 2; ++ai)
#pragma unroll
            for (int m = 0; m < 4; ++m) { const int row = row0 + ai * HALF + m * 16; float q = 0.f;
#pragma unroll
                for (int bj = 0; bj < 2; ++bj) { const size_t off = (size_t)row * 1024 + c0 + bj * HALF; const f32x4 a = acc[ai][bj][m][0], b = acc[ai][bj][m][1];
                    if (xo) { *(f32x4*)(xo + off) = a; *(f32x4*)(xo + off + 4) = b; } if (XB) *(u32x4*)(XB + off) = pack8(a, b); q += sum8sq(a, b);
                    if (XB8) *(u32x2*)(XB8 + off) = (u32x2){pk4_fp8(a.x, a.y, a.z, a.w), pk4_fp8(b.x, b.y, b.z, b.w)}; }
                q = add_xor<16>(q); q = add_xor<32>(q);
                if (fq == 0) SSQ16[(size_t)row * 16 + 4 * u.pn + wc] = q; }
    }
};
constexpr float ACT8_SC = 8.f;
template <bool MOE, bool OUT8 = false> struct EpiSwiglu {
    bf16_t* ACT; const float* RS; int arow0;
    int pre = 0; float wsc = 1.f;
    static constexpr bool NEEDS_RS = true, HAS_MID = false, HAS_INIT = false;
    __device__ __forceinline__ bool prefilled() const { return pre != 0; }
    __device__ __forceinline__ void rs_table(const Unit& u, LAS float* rtab) const {
        if constexpr (MOE) { const int tid = opaque_tid(); if ((tid & 1) == 0) rtab[tid >> 1] = RS[u.pm * BM + (tid >> 1)]; } else rs_fill<16>(RS, u.pm * BM, 1.f / 1024.f, rtab); }
    __device__ __forceinline__ void operator()(const f32x4 (&acc)[2][2][4][2], const Unit& u, int wr, int wc, int fr, int fq, const LAS float* rtab) const {
        const int row0 = u.pm * BM + wr * 64 + fr, c0 = u.pn * HALF + wc * 32 + fq * 8;
        const LAS float* rt = rtab + (pre ? 256 + ((pre == 2 ? u.k : u.pm) & 7) * 256 : 0) + wr * 64 + fr;
#pragma unroll
        for (int ai = 0; ai < 2; ++ai)
#pragma unroll
            for (int m = 0; m < 4; ++m) { const int row = row0 + ai * HALF + m * 16 - (MOE ? arow0 * BM : 0); const float s = RS_(ai, m) * wsc; f32x4 v[2];
#pragma unroll
                for (int n = 0; n < 2; ++n) { const f32x4 g = acc[ai][0][m][n] * s, up = acc[ai][1][m][n] * s; f32x4 sg; sg.x = sigmoidf_(g.x); sg.y = sigmoidf_(g.y); sg.z = sigmoidf_(g.z); sg.w = sigmoidf_(g.w); v[n] = g * sg * up; }
                if constexpr (OUT8) { v[0] *= ACT8_SC; v[1] *= ACT8_SC; *(u32x2*)((unsigned char*)ACT + (size_t)row * DFF + c0) = (u32x2){pk4_fp8(v[0].x, v[0].y, v[0].z, v[0].w), pk4_fp8(v[1].x, v[1].y, v[1].z, v[1].w)}; }
                else ST16(ACT + (size_t)row * DFF + c0, pack8(v[0], v[1])); }
    }
};
constexpr float Y8_SC = 16.f;
struct EpiY {
    bf16_t* Y; float osc = 1.f;
    static constexpr bool NEEDS_RS = false, HAS_MID = false, HAS_INIT = false;
    __device__ __forceinline__ void operator()(const f32x4 (&acc)[2][2][4][2], const Unit& u, int wr, int wc, int fr, int fq, const LAS float* rtab) const {
        const int row0 = u.pm * BM + wr * 64 + fr, c0 = u.pn * BM + wc * 32 + fq * 8;
#pragma unroll
        for (int ai = 0; ai < 2; ++ai)
#pragma unroll
            for (int m = 0; m < 4; ++m) { unsigned char* rp = (unsigned char*)Y + (size_t)(row0 + ai * HALF + m * 16) * 1024 + c0; const float sc = osc * Y8_SC;
#pragma unroll
                for (int bj = 0; bj < 2; ++bj) { const f32x4 a = acc[ai][bj][m][0] * sc, b = acc[ai][bj][m][1] * sc; *(u32x2*)(rp + bj * HALF) = (u32x2){pk4_fp8(a.x, a.y, a.z, a.w), pk4_fp8(b.x, b.y, b.z, b.w)}; } }
    }
};
struct EpiYPart {
    bf16_t* YP; int row_base; float osc = 1.f;
    static constexpr bool NEEDS_RS = false, HAS_MID = false, HAS_INIT = false;
    __device__ __forceinline__ void operator()(const f32x4 (&acc)[2][2][4][2], const Unit& u, int wr, int wc, int fr, int fq, const LAS float* rtab) const {
        const int row0 = u.pm * BM + wr * 64 + fr - row_base, c0 = (u.pn & 3) * BM + wc * 32 + fq * 8; bf16_t* base = YP + (size_t)(u.pn >> 2) * 2048 * 1024;
#pragma unroll
        for (int ai = 0; ai < 2; ++ai)
#pragma unroll
            for (int m = 0; m < 4; ++m) { bf16_t* rp = base + (size_t)(row0 + ai * HALF + m * 16) * 1024 + c0;
#pragma unroll
                for (int bj = 0; bj < 2; ++bj) *(u32x4*)(rp + bj * HALF) = pack8(acc[ai][bj][m][0] * osc, acc[ai][bj][m][1] * osc); }
    }
};
}

namespace att {
__device__ __forceinline__ int crow(int r, int hi) { return (r & 3) + 8 * (r >> 2) + 4 * hi; }
__device__ __forceinline__ void glds16(const void* gsrc, unsigned lds_dst) { unsigned keep;
    asm volatile("s_mov_b32 %0, m0\n\ts_mov_b32 m0, %2\n\ts_nop 0\n\tglobal_load_lds_dwordx4 %1, off\n\ts_mov_b32 m0, %0" : "=&s"(keep) : "v"(gsrc), "s"(lds_dst) : "memory"); }
#define ATT_RFL(x) ((unsigned)__builtin_amdgcn_readfirstlane((int)(x)))
#define ATT_WAIT_BAR(N) asm volatile("s_waitcnt vmcnt(" #N ") lgkmcnt(0)\n\ts_barrier" ::: "memory")
#define ATT_SBAR() __builtin_amdgcn_sched_barrier(0)
#define ATT_MFMA(a, b, c) __builtin_amdgcn_mfma_f32_32x32x16_bf16(a, b, c, 0, 0, 0)
typedef LAS const char* lds_cptr;
typedef short v4i16_t __attribute__((ext_vector_type(4)));
__device__ __forceinline__ bf16x8 ldsv(lds_cptr p) { return *(const LAS bf16x8*)p; }
#define ATT_TRI(lo_, hi_, base, off0, off1) do { asm volatile("ds_read_b64_tr_b16 %0, %1 offset:%c2" : "=&v"(lo_) : "v"(base), "i"(off0) : "memory"); \
    asm volatile("ds_read_b64_tr_b16 %0, %1 offset:%c2" : "=&v"(hi_) : "v"(base), "i"(off1) : "memory"); } while (0)
#define ATT_TRW() do { asm volatile("s_waitcnt lgkmcnt(0)" ::: "memory"); ATT_SBAR(); } while (0)
#define ATT_FR(lo_, hi_) ((bf16x8){lo_[0], lo_[1], lo_[2], lo_[3], hi_[0], hi_[1], hi_[2], hi_[3]})

__device__ __forceinline__ float rowmax32(const f32x16& p0, const f32x16& p1) {
    float a = fmaxf(fmaxf(p0[0], p0[1]), p1[0]), b = fmaxf(fmaxf(p0[2], p0[3]), p1[1]); a = fmaxf(fmaxf(a, p1[2]), p1[3]);
#pragma unroll
    for (int r = 4; r < 16; r += 4) { a = fmaxf(fmaxf(a, p0[r]), p0[r + 1]); b = fmaxf(fmaxf(b, p0[r + 2]), p0[r + 3]); a = fmaxf(fmaxf(a, p1[r]), p1[r + 1]); b = fmaxf(fmaxf(b, p1[r + 2]), p1[r + 3]); }
    const float m = fmaxf(a, b); auto rr = __builtin_amdgcn_permlane32_swap(__float_as_uint(m), __float_as_uint(m), false, false);
    return fmaxf(__uint_as_float(rr[0]), __uint_as_float(rr[1]));
}

template <int NS, bool BIAS, int NCH>
__device__ __forceinline__ void attn_unit2(int qb, const bf16_t* Qh, int qp, const bf16_t* KAh, int kap, const bf16_t* KBh, int kbp, const bf16_t* Vh, int vp, bf16_t* Oh, int op, const float* cumf, float kmax, LAS char* shm) {
    constexpr int NQ = BIAS ? NS - 1 : NS, NM = 2 * NS;
    constexpr int KSL = NCH * 1024, LDS_K = 0, LDS_V = 4 * KSL, LDS_WS = LDS_V + 3 * 8192, LDS_QX = LDS_WS + 8 * 256, LDS_OST = LDS_QX + 64;
    static_assert(LDS_OST + 8 * 4096 <= 131072 && (NM == 10 || NM == 12), "attention LDS / k-steps");
    const int tid = opaque_tid(), lane = tid & 63, r32 = lane & 31, hi = lane >> 5; const int wid = __builtin_amdgcn_readfirstlane(tid >> 6);
    const int q0 = qb * 256, NT = (q0 + 256) / 64;
    const bf16_t* Qw = Qh + (long)(q0 + wid * 32) * qp;
    const unsigned lds0 = (unsigned)(uintptr_t)shm;
    LAS float* wsf = (LAS float*)(shm + LDS_WS) + wid * 64;
    const bool hasB = wid < NCH - 8;
    const bf16_t* ksrcA = KAh + (long)lane * kap + wid * 8;
    const bf16_t* ksrcB = KBh + (long)lane * kbp + (BIAS ? 0 : wid * 8);
    const bf16_t* vsrc = Vh + (long)(16 * (wid & 3) + (lane >> 2)) * vp + (wid >> 2) * 32 + (lane & 3) * 8;
    const unsigned kdstA = lds0 + LDS_K + wid * 1024, kdstB = lds0 + LDS_K + (8 + wid) * 1024, vdst = lds0 + LDS_V + wid * 1024;
#define A2_TILE(s) ((s) < 4 ? NT - 4 + (s) : NT - 1 - (s))
#define A2_DMA_K(t, sb) do { glds16(ksrcA + (long)A2_TILE(t) * 64 * kap, ATT_RFL(kdstA + (sb))); if (hasB) glds16(ksrcB + (long)A2_TILE(t) * 64 * kbp, ATT_RFL(kdstB + (sb))); } while (0)
#define A2_DMA_V(t, sb) glds16(vsrc + (long)A2_TILE(t) * 64 * vp, ATT_RFL(vdst + (sb)))
#define A2_WB(a, b) do { if (hasB) { ATT_WAIT_BAR(b); } else { ATT_WAIT_BAR(a); } } while (0)
#define A2_KS(t) (((t) & 3) * KSL)
    const lds_cptr vp0 = (lds_cptr)shm + LDS_V + ((lane >> 4) & 1) * 32 + (lane & 3) * 8 + (4 * hi + ((lane & 15) >> 2)) * 64;
    const lds_cptr kp0 = (lds_cptr)shm + LDS_K + hi * 1024 + r32 * 16, kpb = (lds_cptr)shm + LDS_K + 8192 + r32 * 16;
    A2_DMA_K(0, 0); A2_DMA_V(0, 0); A2_DMA_K(1, KSL);
    bf16x8 qr[NS];
#pragma unroll
    for (int d0 = 0; d0 < NQ; ++d0) qr[d0] = *(const bf16x8*)(Qw + (long)r32 * qp + d0 * 16 + hi * 8);
    if constexpr (BIAS) { const short o1 = hi ? (short)0 : (short)0x3F80; qr[NS - 1] = (bf16x8){o1, o1, o1, 0, 0, 0, 0, 0}; }
    float mhat = 0.f, l_reg = 0.f; f32x16 o[2];
#pragma unroll
    for (int r = 0; r < 16; ++r) { o[0][r] = 0.f; o[1][r] = 0.f; }
    f32x16 negm;
#pragma unroll
    for (int r = 0; r < 16; ++r) negm[r] = 0.f;
    asm volatile("" : "+v"(negm));
    const int qrel = wid * 32 + r32; bool resc = false;
    f32x16 pA0, pA1, pB0, pB1; bf16x8 kf[4]; s16x4 vlo[8], vhi[8]; u32x4 pw0, pw1, pw2, pw3;
    int vs_prev = 0, vs_cur = 0, vs_next = 8192;
#define A2_ROT() do { vs_prev = vs_cur; vs_cur = vs_next; vs_next = (vs_next == 16384) ? 0 : vs_next + 8192; } while (0)
#define A2_KADDR(kq, kqb, j) ((BIAS && ((j) >> 1) == NS - 1) ? ((kqb) + ((j) & 1) * 512) : ((kq) + ((j) >> 1) * 2048 + ((j) & 1) * 512))
#define A2_CMASK(P0, P1, t) do { const int jb_ = (t) - (NT - 4); if (jb_ >= 0) { const int kb_ = 64 * jb_ + 4 * hi; \
        _Pragma("unroll") for (int r = 0; r < 16; ++r) { const int kv_ = kb_ + (r & 3) + 8 * (r >> 2); if (kv_ > qrel) P0[r] = -INFINITY; if (kv_ + 32 > qrel) P1[r] = -INFINITY; } } } while (0)
#define A2_RESC() do { if (resc) { asm volatile("s_waitcnt lgkmcnt(0)" ::: "memory"); \
        _Pragma("unroll") for (int d_ = 0; d_ < 2; ++d_) _Pragma("unroll") for (int r = 0; r < 16; ++r) o[d_][r] *= wsf[crow(r, hi)]; } } while (0)
    A2_DMA_K(2, 2 * KSL);
    if constexpr (BIAS) {
        float qs = 0.f;
#pragma unroll
        for (int d0 = 0; d0 < NQ; ++d0)
#pragma unroll
            for (int j = 0; j < 8; ++j) { const float v = bf2f((unsigned short)qr[d0][j]); qs += v * v; }
        { auto rr = __builtin_amdgcn_permlane32_swap(__float_as_uint(qs), __float_as_uint(qs), false, false); qs = __uint_as_float(rr[0]) + __uint_as_float(rr[1]); }
        qs = fmaxf(qs, __int_as_float(__builtin_amdgcn_ds_swizzle(__float_as_int(qs), (1 << 10) | 0x1F))); qs = fmaxf(qs, __int_as_float(__builtin_amdgcn_ds_swizzle(__float_as_int(qs), (2 << 10) | 0x1F)));
        qs = fmaxf(qs, __int_as_float(__builtin_amdgcn_ds_swizzle(__float_as_int(qs), (4 << 10) | 0x1F))); qs = fmaxf(qs, __int_as_float(__builtin_amdgcn_ds_swizzle(__float_as_int(qs), (8 << 10) | 0x1F)));
        qs = fmaxf(qs, __int_as_float(__builtin_amdgcn_ds_swizzle(__float_as_int(qs), (16 << 10) | 0x1F)));
        if (lane == 0) ((LAS float*)(shm + LDS_QX))[wid] = qs;
    }
    A2_WB(3, 5);
    int NSTEP = NT;
    if constexpr (BIAS) { if (NT > 4) {
        const LAS float* qx = (const LAS float*)(shm + LDS_QX); float qm = fmaxf(fmaxf(fmaxf(qx[0], qx[1]), fmaxf(qx[2], qx[3])), fmaxf(fmaxf(qx[4], qx[5]), fmaxf(qx[6], qx[7])));
        const float lim = cumf[q0] - 32.f - 2.f * __builtin_sqrtf(qm) * kmax * 1.0001f;
        const int T0 = lane, T1 = lane + 64; const bool c0 = (T0 < NT - 4) && (cumf[64 * T0 + 63] <= lim), c1 = (T1 < NT - 4) && (cumf[64 * T1 + 63] <= lim);
        const int nskip = (__popcll(__ballot(c0)) + __popcll(__ballot(c1))) & ~1; NSTEP = __builtin_amdgcn_readfirstlane(NT - nskip); } }
    { const lds_cptr kq_ = kp0, kqb_ = kpb;
#pragma unroll
      for (int j = 0; j < NM; ++j) { const bf16x8 f = ldsv(A2_KADDR(kq_, kqb_, j)); if (j & 1) pA1 = ATT_MFMA(f, qr[j >> 1], j < 2 ? negm : pA1); else pA0 = ATT_MFMA(f, qr[j >> 1], j < 2 ? negm : pA0); } }
    A2_CMASK(pA0, pA1, A2_TILE(0));
    { const float rm = rowmax32(pA0, pA1); mhat += rm;
#pragma unroll
      for (int r = 0; r < 16; ++r) { pA0[r] -= rm; pA1[r] -= rm; }
#pragma unroll
      for (int r = 0; r < 16; ++r) negm[r] = -mhat;
      asm volatile("" : "+v"(negm));
#pragma unroll
      for (int r = 0; r < 16; ++r) { pA0[r] = fexp2(pA0[r]); pA1[r] = fexp2(pA1[r]); } }
    ATT_WAIT_BAR(0);
    A2_DMA_K(3, 3 * KSL); A2_DMA_V(1, 8192);
    A2_ROT();
    { const lds_cptr kq_ = kp0 + A2_KS(1), kqb_ = kpb + A2_KS(1); kf[0] = ldsv(A2_KADDR(kq_, kqb_, 0)); kf[1] = ldsv(A2_KADDR(kq_, kqb_, 1)); kf[2] = ldsv(A2_KADDR(kq_, kqb_, 2)); }
#define A2_PKW(P, B) pk2(P[B], P[B + 1])
#define A2_PAF(k) __builtin_bit_cast(bf16x8, pw##k)
#define A2_VFR(i) ((bf16x8){vlo[i][0], vlo[i][1], vlo[i][2], vlo[i][3], vhi[i][0], vhi[i][1], vhi[i][2], vhi[i][3]})
#define A2_PIN(x) asm volatile("" : "+v"(x))
#define A2_VTR(p) __builtin_bit_cast(s16x4, __builtin_amdgcn_ds_read_tr16_b64_v4i16((LAS v4i16_t*)(p)))
#define A2_VRD(i) do { vlo[i] = A2_VTR(vp_ + (((i) >> 2) * 4096 + ((i) & 3) * 1024)); vhi[i] = A2_VTR(vp_ + (((i) >> 2) * 4096 + ((i) & 3) * 1024 + 512)); } while (0)
#define A2_KJ(j) do { if ((j) < NM) kf[(j) % 4] = ldsv(A2_KADDR(kq_, kqb_, (j))); } while (0)
#define A2_GAPA(MF, a0, a1, a2, a3, W0, W1, PW) do { MF; sacc += a0; sacc += a1; sacc += a2; sacc += a3; A2_PIN(sacc); W0; W1; A2_PIN(PW); ATT_SBAR(); } while (0)
#define A2_GAPB(MF, X, B) do { MF; X[B] = fexp2(X[B]); X[B + 1] = fexp2(X[B + 1]); X[B + 2] = fexp2(X[B + 2]); X[B + 3] = fexp2(X[B + 3]); A2_PIN(X); ATT_SBAR(); } while (0)
#define A2_MX3(a, b, c) __builtin_fmaxf(__builtin_fmaxf((a), (b)), (c))
#define A2_STEP(C0, C1, P0, P1, t, GK, GV, GL) do { ATT_SBAR(); \
    const lds_cptr vp_ = vp0 + vs_prev; const lds_cptr kq_ = kp0 + A2_KS(t), kqb_ = kpb + A2_KS(t); \
    A2_VRD(0); A2_KJ(3); ATT_SBAR(); float sacc = (P0[0] + P0[1]); \
    A2_GAPA(C0 = ATT_MFMA(kf[0], qr[0], negm), P0[2], P0[3], P0[4], P0[5],     pw0[0] = A2_PKW(P0, 0), pw0[1] = A2_PKW(P0, 2), pw0); \
    A2_VRD(4); A2_KJ(4); ATT_SBAR(); A2_GAPA(C1 = ATT_MFMA(kf[1], qr[0], negm), P0[6], P0[7], P0[8], P0[9],     pw0[2] = A2_PKW(P0, 4), pw0[3] = A2_PKW(P0, 6), pw0); \
    A2_VRD(1); A2_KJ(5); ATT_SBAR(); A2_GAPA(C0 = ATT_MFMA(kf[2], qr[1], C0),   P0[10], P0[11], P0[12], P0[13], pw1[0] = A2_PKW(P0, 8), pw1[1] = A2_PKW(P0, 10), pw1); \
    A2_VRD(5); A2_KJ(6); ATT_SBAR(); A2_GAPA(C1 = ATT_MFMA(kf[3], qr[1], C1),   P0[14], P0[15], P1[0], P1[1],   pw1[2] = A2_PKW(P0, 12), pw1[3] = A2_PKW(P0, 14), pw1); \
    A2_VRD(2); A2_KJ(7); ATT_SBAR(); A2_GAPA(C0 = ATT_MFMA(kf[0], qr[2], C0),   P1[2], P1[3], P1[4], P1[5],     pw2[0] = A2_PKW(P1, 0), pw2[1] = A2_PKW(P1, 2), pw2); \
    A2_VRD(6); A2_KJ(8); ATT_SBAR(); A2_GAPA(C1 = ATT_MFMA(kf[1], qr[2], C1),   P1[6], P1[7], P1[8], P1[9],     pw2[2] = A2_PKW(P1, 4), pw2[3] = A2_PKW(P1, 6), pw2); \
    A2_VRD(3); A2_KJ(9); ATT_SBAR(); A2_GAPA(C0 = ATT_MFMA(kf[2], qr[3], C0),   P1[10], P1[11], P1[12], P1[13], pw3[0] = A2_PKW(P1, 8), pw3[1] = A2_PKW(P1, 10), pw3); \
    A2_VRD(7); A2_KJ(10); ATT_SBAR(); A2_GAPA(C1 = ATT_MFMA(kf[3], qr[3], C1),  P1[14], P1[15], 0.f, 0.f,       pw3[2] = A2_PKW(P1, 12), pw3[3] = A2_PKW(P1, 14), pw3); \
    A2_KJ(11); ATT_SBAR(); C0 = ATT_MFMA(kf[0], qr[4], C0); ATT_SBAR(); \
    C1 = ATT_MFMA(kf[1], qr[4], C1); ATT_SBAR(); \
    if constexpr (NM > 10) { C0 = ATT_MFMA(kf[2], qr[NS - 1], C0); ATT_SBAR(); C1 = ATT_MFMA(kf[3], qr[NS - 1], C1); ATT_SBAR(); } \
    l_reg += sacc; \
    if (GK) { A2_DMA_K((t) + 3, A2_KS((t) + 3)); } if (GV) { A2_DMA_V((t) + 1, vs_next); } \
    A2_CMASK(C0, C1, A2_TILE(t)); \
    { float a = A2_MX3(C0[0], C0[1], C1[0]), b = A2_MX3(C0[2], C0[3], C1[1]); a = A2_MX3(a, C1[2], C1[3]); \
      _Pragma("unroll") for (int r = 4; r < 16; r += 4) { a = A2_MX3(a, C0[r], C0[r + 1]); b = A2_MX3(b, C0[r + 2], C0[r + 3]); a = A2_MX3(a, C1[r], C1[r + 1]); b = A2_MX3(b, C1[r + 2], C1[r + 3]); } \
      float rm = __builtin_fmaxf(a, b); { auto rr = __builtin_amdgcn_permlane32_swap(__float_as_uint(rm), __float_as_uint(rm), false, false); rm = __builtin_fmaxf(__uint_as_float(rr[0]), __uint_as_float(rr[1])); } \
      resc = false; \
      if (__builtin_expect(__any(rm > 8.f), 0)) { const float dl = __builtin_fmaxf(rm, 0.f); mhat += dl; \
        _Pragma("unroll") for (int r = 0; r < 16; ++r) { C0[r] -= dl; C1[r] -= dl; } \
        _Pragma("unroll") for (int r = 0; r < 16; ++r) negm[r] = -mhat; asm volatile("" : "+v"(negm)); \
        const float f = fexp2(-dl); l_reg *= f; if (hi == 0) wsf[r32] = f; resc = true; } } \
    ATT_SBAR(); \
    A2_GAPB(o[0] = ATT_MFMA(A2_PAF(0), A2_VFR(0), o[0]), C0, 0); \
    A2_GAPB(o[1] = ATT_MFMA(A2_PAF(0), A2_VFR(4), o[1]), C0, 4); \
    A2_GAPB(o[0] = ATT_MFMA(A2_PAF(1), A2_VFR(1), o[0]), C0, 8); \
    if (GL) { const lds_cptr kn_ = kp0 + A2_KS((t) + 1), knb_ = kpb + A2_KS((t) + 1); kf[0] = ldsv(A2_KADDR(kn_, knb_, 0)); kf[1] = ldsv(A2_KADDR(kn_, knb_, 1)); kf[2] = ldsv(A2_KADDR(kn_, knb_, 2)); ATT_SBAR(); } \
    A2_GAPB(o[1] = ATT_MFMA(A2_PAF(1), A2_VFR(5), o[1]), C0, 12); \
    A2_GAPB(o[0] = ATT_MFMA(A2_PAF(2), A2_VFR(2), o[0]), C1, 0); \
    A2_GAPB(o[1] = ATT_MFMA(A2_PAF(2), A2_VFR(6), o[1]), C1, 4); \
    A2_GAPB(o[0] = ATT_MFMA(A2_PAF(3), A2_VFR(3), o[0]), C1, 8); \
    A2_GAPB(o[1] = ATT_MFMA(A2_PAF(3), A2_VFR(7), o[1]), C1, 12); \
    } while (0)
    int t = 1;
    for (; t + 5 < NSTEP; t += 2) {
        A2_STEP(pB0, pB1, pA0, pA1, t, true, true, true);     A2_WB(2, 3); A2_RESC(); A2_ROT();
        A2_STEP(pA0, pA1, pB0, pB1, t + 1, true, true, true); A2_WB(2, 3); A2_RESC(); A2_ROT();
    }
#define A2_ENDW(tt) do { if ((tt) + 3 < NSTEP) { A2_WB(2, 3); } else if ((tt) + 2 < NSTEP) { ATT_WAIT_BAR(1); } else { ATT_WAIT_BAR(0); } } while (0)
    for (; t + 1 < NSTEP; t += 2) {
        A2_STEP(pB0, pB1, pA0, pA1, t, (t + 3 < NSTEP), (t + 1 < NSTEP), (t + 1 < NSTEP));         A2_ENDW(t);     A2_RESC(); A2_ROT();
        A2_STEP(pA0, pA1, pB0, pB1, t + 1, (t + 4 < NSTEP), (t + 2 < NSTEP), (t + 2 < NSTEP));     A2_ENDW(t + 1); A2_RESC(); A2_ROT();
    }
    A2_STEP(pB0, pB1, pA0, pA1, NSTEP - 1, false, false, false); A2_RESC();
    { float sacc = pB0[0] + pB0[1];
#pragma unroll
      for (int r = 2; r < 16; ++r) sacc += pB0[r];
#pragma unroll
      for (int r = 0; r < 16; ++r) sacc += pB1[r];
      l_reg += sacc;
      pw0 = (u32x4){A2_PKW(pB0, 0), A2_PKW(pB0, 2), A2_PKW(pB0, 4), A2_PKW(pB0, 6)}; pw1 = (u32x4){A2_PKW(pB0, 8), A2_PKW(pB0, 10), A2_PKW(pB0, 12), A2_PKW(pB0, 14)};
      pw2 = (u32x4){A2_PKW(pB1, 0), A2_PKW(pB1, 2), A2_PKW(pB1, 4), A2_PKW(pB1, 6)}; pw3 = (u32x4){A2_PKW(pB1, 8), A2_PKW(pB1, 10), A2_PKW(pB1, 12), A2_PKW(pB1, 14)};
      const lds_cptr vp_ = vp0 + vs_cur;
#pragma unroll
      for (int i = 0; i < 8; ++i) A2_VRD(i);
      o[0] = ATT_MFMA(A2_PAF(0), A2_VFR(0), o[0]); o[1] = ATT_MFMA(A2_PAF(0), A2_VFR(4), o[1]); o[0] = ATT_MFMA(A2_PAF(1), A2_VFR(1), o[0]); o[1] = ATT_MFMA(A2_PAF(1), A2_VFR(5), o[1]);
      o[0] = ATT_MFMA(A2_PAF(2), A2_VFR(2), o[0]); o[1] = ATT_MFMA(A2_PAF(2), A2_VFR(6), o[1]); o[0] = ATT_MFMA(A2_PAF(3), A2_VFR(3), o[0]); o[1] = ATT_MFMA(A2_PAF(3), A2_VFR(7), o[1]); }
    { auto rr = __builtin_amdgcn_permlane32_swap(__float_as_uint(l_reg), __float_as_uint(l_reg), false, false); l_reg = __uint_as_float(rr[0]) + __uint_as_float(rr[1]); }
    if (hi == 0) wsf[32 + r32] = l_reg;
    asm volatile("s_waitcnt lgkmcnt(0)" ::: "memory");
    float rli[16];
#pragma unroll
    for (int r = 0; r < 16; ++r) rli[r] = __builtin_amdgcn_rcpf(wsf[32 + crow(r, hi)]);
    bf16_t* Ow = Oh + (long)(q0 + wid * 32) * op;
    { LAS bf16_t* stg = (LAS bf16_t*)(shm + LDS_OST) + wid * 2048;
#pragma unroll
        for (int r = 0; r < 16; ++r) { const int orow = crow(r, hi);
#pragma unroll
            for (int d0 = 0; d0 < 2; ++d0) stg[orow * 64 + d0 * 32 + r32] = f2bf(o[d0][r] * rli[r]); }
        asm volatile("s_waitcnt lgkmcnt(0)" ::: "memory");
#pragma unroll
        for (int i = 0; i < 4; ++i) { const int row = i * 8 + (lane >> 3), ch = lane & 7; const u32x4 v = *(const LAS u32x4*)(stg + row * 64 + ch * 8); *(u32x4*)(Ow + (long)row * op + ch * 8) = v; } }
    asm volatile("s_waitcnt lgkmcnt(0)\n\ts_barrier" ::: "memory");
#undef A2_TILE
#undef A2_DMA_K
#undef A2_DMA_V
#undef A2_WB
#undef A2_KS
#undef A2_ROT
#undef A2_KADDR
#undef A2_CMASK
#undef A2_RESC
#undef A2_PKW
#undef A2_PAF
#undef A2_VFR
#undef A2_PIN
#undef A2_VTR
#undef A2_VRD
#undef A2_KJ
#undef A2_GAPA
#undef A2_GAPB
#undef A2_MX3
#undef A2_STEP
#undef A2_ENDW
}

__device__ __forceinline__ void tstate_run(int u0, int stride, int n, const bf16_t* KG, const bf16_t* RV, float* T, LAS char* shm) {
    const int tid = opaque_tid(), lane = tid & 63, r32 = lane & 31, hi = lane >> 5; const int wid = __builtin_amdgcn_readfirstlane(tid >> 6);
    const unsigned lds0 = (unsigned)(uintptr_t)shm;
    const int dblk = wid >> 2, db = wid & 3;
#define TS_DMA(u, buf) do { const int bh_ = (u) >> 6, c_ = (u) & 63; const long row0_ = (long)(bh_ >> 3) * SEQ + (long)c_ * 128; const int h_ = bh_ & 7; \
    _Pragma("unroll") for (int i = 0; i < 2; ++i) { const int kp = wid * 2 + i, c8 = kp >> 1, rh = kp & 1; glds16(KG + (row0_ + 64 * rh + lane) * 512 + h_ * 64 + 8 * c8, ATT_RFL(lds0 + (buf) * 49152 + c8 * 2048 + rh * 1024)); } \
    _Pragma("unroll") for (int i = 0; i < 4; ++i) { const int vp = wid * 4 + i, db_ = vp >> 3, j = vp & 7; glds16(RV + (row0_ + 16 * j + (lane >> 2)) * 1024 + h_ * 128 + 32 * db_ + (lane & 3) * 8, ATT_RFL(lds0 + (buf) * 49152 + 16384 + db_ * 8192 + j * 1024)); } } while (0)
    if (n <= 0) return;
    TS_DMA(u0, 0);
    for (int k = 0; k < n; ++k) {
        const int u = u0 + k * stride, buf = k & 1;
        if (k + 1 < n) { TS_DMA(u + stride, buf ^ 1); ATT_WAIT_BAR(6); } else ATT_WAIT_BAR(0);
        const int ab = (int)lds0 + buf * 49152 + (4 * dblk + 2 * ((lane >> 4) & 1) + ((lane & 3) >> 1)) * 2048 + (8 * hi + ((lane & 15) >> 2)) * 16 + (lane & 1) * 8;
        const int vb = (int)lds0 + buf * 49152 + 16384 + db * 8192 + (8 * hi + ((lane & 15) >> 2)) * 64 + ((lane >> 4) & 1) * 32 + (lane & 3) * 8;
        f32x16 acc;
#pragma unroll
        for (int r = 0; r < 16; ++r) acc[r] = 0.f;
#pragma unroll
        for (int ks = 0; ks < 8; ks += 2) { s16x4 al0, ah0, bl0, bh0, al1, ah1, bl1, bh1;
            ATT_TRI(al0, ah0, ab, ks * 256, ks * 256 + 64); ATT_TRI(bl0, bh0, vb, ks * 1024, ks * 1024 + 256); ATT_TRI(al1, ah1, ab, ks * 256 + 256, ks * 256 + 320); ATT_TRI(bl1, bh1, vb, ks * 1024 + 1024, ks * 1024 + 1280);
            ATT_TRW(); acc = ATT_MFMA(ATT_FR(al0, ah0), ATT_FR(bl0, bh0), acc); acc = ATT_MFMA(ATT_FR(al1, ah1), ATT_FR(bl1, bh1), acc); }
        float* Tp = T + ((size_t)u * 64 + 32 * dblk) * 128 + 32 * db + r32;
#pragma unroll
        for (int r = 0; r < 16; ++r) Tp[(size_t)crow(r, hi) * 128] = acc[r];
        asm volatile("s_waitcnt lgkmcnt(0)\n\ts_barrier" ::: "memory");
    }
#undef TS_DMA
}

__device__ __forceinline__ void ret_unit(int bh, int cp, const bf16_t* RQ, const bf16_t* KG, const bf16_t* RV, const bf16_t* RP, const bf16_t* RG, const float* gnw, bf16_t* OR, LAS char* shm) {
    const int tid = opaque_tid(), lane = tid & 63, r32 = lane & 31, hi = lane >> 5; const int wid = __builtin_amdgcn_readfirstlane(tid >> 6);
    const int hw = wid >> 2, wq = wid & 3, b = bh >> 3, h = bh & 7, c = 2 * cp + hw; const long row0 = (long)b * SEQ + (long)c * 128;
    const unsigned lds0 = (unsigned)(uintptr_t)shm + hw * 65536u;
    bf16x8 qr[4];
#pragma unroll
    for (int d0 = 0; d0 < 4; ++d0) qr[d0] = *(const bf16x8*)(RQ + (row0 + 32 * wq + r32) * 512 + h * 64 + 16 * d0 + 8 * hi);
#pragma unroll
    for (int i = 0; i < 4; ++i) { const int kp = wq * 4 + i, c8 = kp >> 1, rh = kp & 1; glds16(KG + (row0 + 64 * rh + lane) * 512 + h * 64 + 8 * c8, ATT_RFL(lds0 + c8 * 2048 + rh * 1024)); }
#pragma unroll
    for (int i = 0; i < 8; ++i) { const int vp = wq * 8 + i, db = vp >> 3, j = vp & 7; glds16(RV + (row0 + 16 * j + (lane >> 2)) * 1024 + h * 128 + 32 * db + (lane & 3) * 8, ATT_RFL(lds0 + 16384 + db * 8192 + j * 1024)); }
#pragma unroll
    for (int i = 0; i < 4; ++i) { const int rp = wq * 4 + i, db = rp >> 2, j = rp & 3; glds16(RP + ((size_t)(bh * 64 + c) * 64 + 16 * j + (lane >> 2)) * 128 + 32 * db + (lane & 3) * 8, ATT_RFL(lds0 + 49152 + db * 4096 + j * 1024)); }
    ATT_WAIT_BAR(0);
    f32x16 o[4];
#pragma unroll
    for (int d = 0; d < 4; ++d)
#pragma unroll
        for (int r = 0; r < 16; ++r) o[d][r] = 0.f;
    const lds_cptr kbase = (lds_cptr)shm + hw * 65536 + hi * 2048 + r32 * 16;
    const int vb0 = (int)lds0 + 16384 + ((lane >> 4) & 1) * 32 + (lane & 3) * 8 + (4 * hi + ((lane & 15) >> 2)) * 64;
    for (int kt = 0; kt <= wq; ++kt) {
        f32x16 p;
#pragma unroll
        for (int r = 0; r < 16; ++r) p[r] = 0.f;
#pragma unroll
        for (int d0 = 0; d0 < 4; ++d0) p = ATT_MFMA(ldsv(kbase + d0 * 4096 + kt * 512), qr[d0], p);
        if (kt == wq) {
#pragma unroll
            for (int r = 0; r < 16; ++r) if (crow(r, hi) > r32) p[r] = 0.f; }
        const u32x4 pw0 = {pk2(p[0], p[1]), pk2(p[2], p[3]), pk2(p[4], p[5]), pk2(p[6], p[7])}, pw1 = {pk2(p[8], p[9]), pk2(p[10], p[11]), pk2(p[12], p[13]), pk2(p[14], p[15])};
        const int vb = vb0 + kt * 2048;
        { s16x4 l0[4], h0[4], l1[4], h1[4];
#pragma unroll
          for (int db = 0; db < 4; ++db) { ATT_TRI(l0[db], h0[db], vb, db * 8192, db * 8192 + 512); ATT_TRI(l1[db], h1[db], vb, db * 8192 + 1024, db * 8192 + 1536); }
          ATT_TRW();
#pragma unroll
          for (int db = 0; db < 4; ++db) { o[db] = ATT_MFMA(__builtin_bit_cast(bf16x8, pw0), ATT_FR(l0[db], h0[db]), o[db]); o[db] = ATT_MFMA(__builtin_bit_cast(bf16x8, pw1), ATT_FR(l1[db], h1[db]), o[db]); } }
    }
    { const int rb = (int)lds0 + 49152 + ((lane >> 4) & 1) * 32 + (lane & 3) * 8 + (8 * hi + ((lane & 15) >> 2)) * 64;
#pragma unroll
        for (int dp = 0; dp < 4; dp += 2) { s16x4 l0[2], h0[2], l1[2], h1[2], l2[2], h2[2], l3[2], h3[2];
#pragma unroll
            for (int e = 0; e < 2; ++e) { const int db = dp + e; ATT_TRI(l0[e], h0[e], rb, db * 4096, db * 4096 + 256); ATT_TRI(l1[e], h1[e], rb, db * 4096 + 1024, db * 4096 + 1280); ATT_TRI(l2[e], h2[e], rb, db * 4096 + 2048, db * 4096 + 2304); ATT_TRI(l3[e], h3[e], rb, db * 4096 + 3072, db * 4096 + 3328); }
            ATT_TRW();
#pragma unroll
            for (int e = 0; e < 2; ++e) { const int db = dp + e; o[db] = ATT_MFMA(qr[0], ATT_FR(l0[e], h0[e]), o[db]); o[db] = ATT_MFMA(qr[1], ATT_FR(l1[e], h1[e]), o[db]); o[db] = ATT_MFMA(qr[2], ATT_FR(l2[e], h2[e]), o[db]); o[db] = ATT_MFMA(qr[3], ATT_FR(l3[e], h3[e]), o[db]); } } }
    asm volatile("s_waitcnt lgkmcnt(0)\n\ts_barrier" ::: "memory");
    const float lg = lg2gamma(h);
    float gw[4];
#pragma unroll
    for (int db = 0; db < 4; ++db) gw[db] = gnw[h * 128 + 32 * db + r32];
    float s1[16], s2[16];
#pragma unroll
    for (int r = 0; r < 16; ++r) { const int n = 32 * wq + crow(r, hi); const float g = fexp2((float)n * lg);
        o[0][r] *= g; o[1][r] *= g; o[2][r] *= g; o[3][r] *= g; s1[r] = (o[0][r] + o[1][r]) + (o[2][r] + o[3][r]); }
#pragma unroll
    for (int r = 0; r < 16; ++r) s1[r] = add_xor<1>(s1[r]);
#pragma unroll
    for (int r = 0; r < 16; ++r) s1[r] = add_xor<2>(s1[r]);
#pragma unroll
    for (int r = 0; r < 16; ++r) s1[r] = add_xor<4>(s1[r]);
#pragma unroll
    for (int r = 0; r < 16; ++r) s1[r] = add_xor<8>(s1[r]);
#pragma unroll
    for (int r = 0; r < 16; ++r) s1[r] = add_xor<16>(s1[r]);
#pragma unroll
    for (int r = 0; r < 16; ++r) { const float mu = s1[r] * (1.f / 128.f); o[0][r] -= mu; o[1][r] -= mu; o[2][r] -= mu; o[3][r] -= mu; s2[r] = (o[0][r] * o[0][r] + o[1][r] * o[1][r]) + (o[2][r] * o[2][r] + o[3][r] * o[3][r]); }
#pragma unroll
    for (int r = 0; r < 16; ++r) s2[r] = add_xor<1>(s2[r]);
#pragma unroll
    for (int r = 0; r < 16; ++r) s2[r] = add_xor<2>(s2[r]);
#pragma unroll
    for (int r = 0; r < 16; ++r) s2[r] = add_xor<4>(s2[r]);
#pragma unroll
    for (int r = 0; r < 16; ++r) s2[r] = add_xor<8>(s2[r]);
#pragma unroll
    for (int r = 0; r < 16; ++r) s2[r] = add_xor<16>(s2[r]);
    { LAS bf16_t* stg = (LAS bf16_t*)shm + wid * 4096;
#pragma unroll
      for (int r = 0; r < 16; ++r) { const float rstd = __builtin_amdgcn_rsqf(s2[r] * (1.f / 128.f) + EPS); const int orow = crow(r, hi);
#pragma unroll
          for (int db = 0; db < 4; ++db) stg[orow * 128 + db * 32 + r32] = f2bf(o[db][r] * rstd * gw[db]); }
      u32x4 gq[8];
#pragma unroll
      for (int i = 0; i < 8; ++i) { const int row = i * 4 + (lane >> 4), ch = lane & 15; gq[i] = *(const u32x4*)(RG + (size_t)(row0 + 32 * wq + row) * 1024 + h * 128 + ch * 8); }
      asm volatile("s_waitcnt lgkmcnt(0)" ::: "memory");
#pragma unroll
      for (int i = 0; i < 8; ++i) { const int row = i * 4 + (lane >> 4), ch = lane & 15; const u32x4 v = *(const LAS u32x4*)(stg + row * 128 + ch * 8);
          const size_t grow = (size_t)(row0 + 32 * wq + row); const u32x4 g = gq[i];
          u32x4 w;
          w.x = pk2(__uint_as_float(v.x << 16) * __uint_as_float(g.x << 16), __uint_as_float(v.x & 0xffff0000u) * __uint_as_float(g.x & 0xffff0000u));
          w.y = pk2(__uint_as_float(v.y << 16) * __uint_as_float(g.y << 16), __uint_as_float(v.y & 0xffff0000u) * __uint_as_float(g.y & 0xffff0000u));
          w.z = pk2(__uint_as_float(v.z << 16) * __uint_as_float(g.z << 16), __uint_as_float(v.z & 0xffff0000u) * __uint_as_float(g.z & 0xffff0000u));
          w.w = pk2(__uint_as_float(v.w << 16) * __uint_as_float(g.w << 16), __uint_as_float(v.w & 0xffff0000u) * __uint_as_float(g.w & 0xffff0000u));
          *(u32x4*)(OR + grow * 2048 + 512 + h * 128 + ch * 8) = w; } }
    asm volatile("s_waitcnt lgkmcnt(0)\n\ts_barrier" ::: "memory");
}
}

constexpr size_t MiB = 1u << 20;
constexpr size_t WS_CTL = 0, CTL_ZERO_BYTES = 64 * 1024;
constexpr size_t WS_SSQ16 = 1 * MiB;
constexpr size_t WS_TAB64 = 2 * MiB, WS_TAB32 = 4 * MiB;
constexpr size_t WS_SSQC = 5 * MiB, WS_SSQK = 6 * MiB, WS_LOGF = 6 * MiB + 512 * 1024;
constexpr size_t WS_SEL = 7 * MiB, WS_SLOT = 7 * MiB + 256 * 1024, WS_CNT = 7 * MiB + 384 * 1024, WS_RSL = 7 * MiB + 512 * 1024;
constexpr size_t WS_CUMB = 8 * MiB, WS_KR = 10 * MiB, WS_CUMF = 11 * MiB  ;
constexpr int CW_KMSQ = 8448;
constexpr int CW_QCTR = 8192;
constexpr size_t WS_WIN = 12 * MiB, WIN_STRIDE = (size_t)NP1 * 1024 * 2;
constexpr size_t WS_WUQ = 45 * MiB, WS_WUKV = 47 * MiB, WS_WBCAT = 48 * MiB  , WS_WOUT = 56 * MiB, WS_WGU = 60 * MiB, WS_WDN = 74 * MiB;
constexpr size_t WS_XB = 81 * MiB;
constexpr size_t WS_FQ = 113 * MiB, WS_FK = 129 * MiB, WS_FV = 145 * MiB, WS_RQ = 161 * MiB, WS_KG = 177 * MiB, WS_RV = 193 * MiB, WS_RG = 225 * MiB, WS_GATES = 257 * MiB;
constexpr size_t WS_ACT = 225 * MiB;
constexpr size_t WS_CQ = 353 * MiB, WS_CKV = 365 * MiB;
constexpr size_t WS_MQ = 373 * MiB, WS_KN = 397 * MiB, WS_MV = 413 * MiB, WS_T = 429 * MiB, WS_OCAT = 429 * MiB, WS_X1B = 461 * MiB, WS_RP = 493 * MiB;
constexpr size_t WS_ACTM = 81 * MiB  , WS_YP = 150 * MiB  , WS_HS = 180 * MiB, WS_Y = 248 * MiB;
constexpr size_t WS_XB8 = 509 * MiB  , WS_WGL8 = 525 * MiB  , WS_END = 531 * MiB;

constexpr int RING_BYTES = 131072, MISC_OFF = RING_BYTES, LDS_BYTES = 147456;

#define RLX_AGENT __ATOMIC_RELAXED, __HIP_MEMORY_SCOPE_AGENT
#define XB_TMO      128
#define XB_XCNT(j)  (256  + 64 * (j))
#define XB_XSUB(j)  (1280 + 64 * (j))
#define XB_XGEN(j)  (2304 + 64 * (j))
#define XB_TOP      3328
#define XB_TOPGEN   3392
#define XCD_BAR_WORDS 3456
#define XB_SPIN_CAP (1u << 18)
__device__ __forceinline__ unsigned xb_ld(unsigned* p)              { return __hip_atomic_load(p, __ATOMIC_RELAXED, __HIP_MEMORY_SCOPE_AGENT); }
__device__ __forceinline__ unsigned xb_add(unsigned* p, unsigned v) { return __hip_atomic_fetch_add(p, v, __ATOMIC_RELAXED, __HIP_MEMORY_SCOPE_AGENT); }
__device__ __forceinline__ unsigned xb_xcc_id() { return (unsigned)__builtin_amdgcn_s_getreg((3 << 11) | 20) & 0xFu; }
#define XB_SPIN(cond, bar) do { unsigned _sp = 0; while (cond) { __builtin_amdgcn_s_sleep(1); \
    if ((++_sp & 255u) == 0u) { if (xb_ld(&(bar)[XB_TMO])) break; if (_sp > XB_SPIN_CAP) { atomicAdd(&(bar)[XB_TMO], 1u); break; } } } } while (0)
struct XcdBarrier { unsigned* bar; unsigned x; volatile LAS unsigned* st; };
__device__ __forceinline__ XcdBarrier xcd_barrier_post(unsigned* bar, volatile LAS unsigned* st) {
    XcdBarrier b; b.bar = bar; b.x = xb_xcc_id(); b.st = st;
    if (threadIdx.x == 0) (void)xb_add(&bar[XB_XCNT(b.x)], 1u);
    return b;
}
__device__ __forceinline__ void xcd_barrier_complete(unsigned* bar, unsigned x, unsigned& nloc, unsigned& nx) {
    const unsigned G = gridDim.x * gridDim.y * gridDim.z;
    unsigned sum, cnt, mine, sp = 0u;
    for (;;) {
        sum = 0u; cnt = 0u; mine = 0u;
#pragma unroll
        for (unsigned j = 0; j < 16; ++j) { const unsigned c = xb_ld(&bar[XB_XCNT(j)]); sum += c; cnt += (c > 0u) ? 1u : 0u; mine = (j == x) ? c : mine; }
        if (sum == G) break;
        __builtin_amdgcn_s_sleep(1);
        if ((++sp & 255u) == 0u) { if (xb_ld(&bar[XB_TMO])) break; if (sp > XB_SPIN_CAP) { atomicAdd(&bar[XB_TMO], 1u); break; } }
    }
    nloc = mine > 0u ? mine : 1u; nx = cnt > 0u ? cnt : 1u;
}
__device__ __forceinline__ void xcd_barrier(const XcdBarrier& b) {
    asm volatile("s_waitcnt vmcnt(0)" ::: "memory");
    __syncthreads();
    if (threadIdx.x == 0) {
        unsigned* bar = b.bar;
        __builtin_amdgcn_s_waitcnt(0);
        unsigned nloc = b.st[0], nx = b.st[1];
        if (nloc == 0u) { xcd_barrier_complete(bar, b.x, nloc, nx); b.st[0] = nloc; b.st[1] = nx; }
        const unsigned old = xb_add(&bar[XB_XSUB(b.x)], 1u);
        const unsigned gen = old / nloc;
        if (old + 1u == (gen + 1u) * nloc) {
            __builtin_amdgcn_fence(__ATOMIC_RELEASE, "agent");
            asm volatile("s_waitcnt vmcnt(0)" ::: "memory");
            const unsigned og = xb_add(&bar[XB_TOP], 1u);
            const unsigned tg = og / nx;
            if (og + 1u == (tg + 1u) * nx) xb_add(&bar[XB_TOPGEN], 1u);
            else XB_SPIN(xb_ld(&bar[XB_TOPGEN]) == tg, bar);
            __builtin_amdgcn_fence(__ATOMIC_ACQUIRE, "agent");
            xb_add(&bar[XB_XGEN(b.x)], 1u);
            asm volatile("s_waitcnt vmcnt(0)" ::: "memory");
        } else {
            XB_SPIN(xb_ld(&bar[XB_XGEN(b.x)]) == gen, bar);
            __builtin_amdgcn_fence(__ATOMIC_ACQUIRE, "agent");
            asm volatile("s_waitcnt vmcnt(0)" ::: "memory");
        }
    }
    __syncthreads();
}

#define LDS_WAIT() asm volatile("s_waitcnt lgkmcnt(0)" ::: "memory")
__device__ __forceinline__ float wave_sum(float v) { v = add_xor<1>(v); v = add_xor<2>(v); v = add_xor<4>(v); v = add_xor<8>(v); v = add_xor<16>(v); return add_xor<32>(v); }
__device__ __forceinline__ int rp64(int j) { const int head = j >> 6, d = j & 63, i = d & 31, x2 = d >> 5; return 64 * head + 8 * (i >> 2) + 4 * x2 + (i & 3); }
__device__ __forceinline__ int rp32(int d) { const int i = d & 15, x2 = d >> 4; return 8 * (i >> 2) + 4 * x2 + (i & 3); }
template <int KIND> __device__ __forceinline__ int map_col(int j) {
    if (KIND == 0) return j;
    if (KIND == 1) {
        if (j < 1536) return j;
        if (j < 1544) return 8352 + (j - 1536);
        if (j < 2056) return 1536 + rp64(j - 1544);
        if (j < 2568) return 2048 + rp64(j - 2056);
        if (j < 3592) return 2560 + (j - 2568);
        if (j < 4616) return 3584 + (j - 3592);
        if (j < 5000) return 7680 + (j - 4616);
        if (j < 5256) return 8064 + (j - 5000);
        if (j < 5288) return 8320 + rp32(j - 5256);
        return 4608 + (j - 5288);
    }
    if (KIND == 2) { const int head = j / 96, d = j - 96 * head; return d < 64 ? 96 * head + d : 96 * head + 64 + rp32(d - 64); }
    if (KIND == 3) return 256 * (j >> 7) + (j & 127);
    return 256 * (j >> 7) + 128 + (j & 127);
}
template <int KIND> __device__ __forceinline__ void tr_item(const float* W, int ldw, int ncols, int K, const float* ksc, bf16_t* WT, int ldk, int koff, int row_off, LAS unsigned* scr, int item, int lane) {
    const int nblk = (ncols + 63) >> 6, kb = item / nblk, nb = item - kb * nblk, k0 = 64 * kb, n0 = 64 * nb, col = n0 + lane; const bool ok = col < ncols;
    const float* src = W + (size_t)k0 * ldw + (ok ? col : 0);
    float v[64];
#pragma unroll
    for (int i = 0; i < 64; ++i) v[i] = src[(size_t)i * ldw];
    if (ksc) {
#pragma unroll
        for (int i = 0; i < 64; ++i) v[i] *= ksc[k0 + i]; }
#pragma unroll
    for (int i = 0; i < 32; ++i) scr[lane * 34 + i] = pk2(v[2 * i], v[2 * i + 1]);
    LDS_WAIT(); asm volatile("" ::: "memory");
    const int c = lane & 7;
#pragma unroll
    for (int j = 0; j < 8; ++j) { const int n = (lane >> 3) + 8 * j; const u32x2 a = *(const LAS u32x2*)(scr + n * 34 + c * 4), b = *(const LAS u32x2*)(scr + n * 34 + c * 4 + 2);
        if (n0 + n < ncols) *(u32x4*)(WT + (size_t)(row_off + map_col<KIND>(n0 + n)) * ldk + koff + k0 + 8 * c) = (u32x4){a.x, a.y, b.x, b.y}; }
    LDS_WAIT(); asm volatile("" ::: "memory");
}
template <int KIND> __device__ __forceinline__ void tr8_item(const float* W, int ldw, int ncols, int K, const float* ksc, unsigned char* WT8, LAS unsigned* scr, int item, int lane) {
    const int nblk = (ncols + 63) >> 6, kb = item / nblk, nb = item - kb * nblk, k0 = 64 * kb, n0 = 64 * nb, col = n0 + lane; const bool ok = col < ncols;
    const float* src = W + (size_t)k0 * ldw + (ok ? col : 0);
    float v[64];
#pragma unroll
    for (int i = 0; i < 64; ++i) v[i] = src[(size_t)i * ldw];
#pragma unroll
    for (int i = 0; i < 64; ++i) v[i] *= ksc ? ksc[k0 + i] * 32.f : 32.f;
#pragma unroll
    for (int i = 0; i < 16; ++i) scr[lane * 18 + i] = pk4_fp8(v[4 * i], v[4 * i + 1], v[4 * i + 2], v[4 * i + 3]);
    LDS_WAIT(); asm volatile("" ::: "memory");
    const int c = lane & 3;
#pragma unroll
    for (int j = 0; j < 4; ++j) { const int n = (lane >> 2) + 16 * j; const u32x2 a = *(const LAS u32x2*)(scr + n * 18 + c * 4), b = *(const LAS u32x2*)(scr + n * 18 + c * 4 + 2);
        if (n0 + n < ncols) *(u32x4*)(WT8 + (size_t)map_col<KIND>(n0 + n) * K + k0 + 16 * c) = (u32x4){a.x, a.y, b.x, b.y}; }
    LDS_WAIT(); asm volatile("" ::: "memory");
}
struct MoeCvtItem { const char* src; const float* ksc; unsigned char* dst; int ldw, K, k0, n0, job; };
__device__ __forceinline__ MoeCvtItem moe_cvt_item(const float* wg, const float* wu, const float* wd, const float* gain, unsigned char* ws, int g, int lane) {
    MoeCvtItem it; const int e = g / 2688, r = g - e * 2688, job = r / 896, i = r - job * 896; it.job = job;
    if (job < 2) { const int kb = i / 56, nb = i - kb * 56; it.k0 = 64 * kb; it.n0 = 64 * nb; it.ldw = DFF; it.K = 1024; it.ksc = gain; it.dst = ws + pg8::moe_gu_base(e);
        it.src = (const char*)((job == 0 ? wg : wu) + (size_t)e * 1024 * DFF + (size_t)it.k0 * DFF + it.n0); }
    else { const int kb = i >> 4, nb = i & 15; it.k0 = 64 * kb; it.n0 = 64 * nb; it.ldw = 1024; it.K = DFF; it.ksc = nullptr; it.dst = ws + pg8::moe_dn_base(e);
        it.src = (const char*)(wd + (size_t)e * DFF * 1024 + (size_t)it.k0 * 1024 + it.n0); }
    return it;
}
__device__ __forceinline__ void moe_cvt_load(float (&v)[64], const MoeCvtItem& it, int lane) {
    const unsigned step = (unsigned)it.ldw * 4u; const __amdgpu_buffer_rsrc_t rs = __builtin_amdgcn_make_buffer_rsrc((void*)it.src, (short)0, (int)(64u * step), 0x00020000); const int vo = lane * 4;
#pragma unroll
    for (int i = 0; i < 64; ++i) v[i] = __uint_as_float(__builtin_amdgcn_raw_buffer_load_b32(rs, vo, (int)(i * step), 2  ));
}
__device__ __forceinline__ void moe_cvt_finish(float (&v)[64], const MoeCvtItem& it, LAS unsigned* scr, int lane) {
    if (it.ksc) {
#pragma unroll
        for (int i = 0; i < 64; ++i) v[i] *= it.ksc[it.k0 + i] * 32.f;
    } else {
#pragma unroll
        for (int i = 0; i < 64; ++i) v[i] *= 32.f;
    }
#pragma unroll
    for (int i = 0; i < 16; ++i) scr[lane * 18 + i] = pk4_fp8(v[4 * i], v[4 * i + 1], v[4 * i + 2], v[4 * i + 3]);
    LDS_WAIT(); asm volatile("" ::: "memory");
    const int c = lane & 3;
#pragma unroll
    for (int j = 0; j < 4; ++j) { const int n = it.n0 + (lane >> 2) + 16 * j; const u32x2 a = *(const LAS u32x2*)(scr + ((lane >> 2) + 16 * j) * 18 + c * 4), b = *(const LAS u32x2*)(scr + ((lane >> 2) + 16 * j) * 18 + c * 4 + 2);
        const int row = it.job == 2 ? n : 256 * (n >> 7) + 128 * it.job + (n & 127);
        *(u32x4*)(it.dst + (size_t)row * it.K + it.k0 + 16 * c) = (u32x4){a.x, a.y, b.x, b.y}; }
    LDS_WAIT(); asm volatile("" ::: "memory");
}
__device__ __forceinline__ void moe_cvt_run(const float* wg, const float* wu, const float* wd, const float* gain, unsigned char* ws, LAS unsigned* scr, int w, int nw, int nitems, int lane) {
    float va[64], vb[64]; int g = w; MoeCvtItem ia, ib;
    if (g < nitems) { ia = moe_cvt_item(wg, wu, wd, gain, ws, g, lane); moe_cvt_load(va, ia, lane); }
    while (g < nitems) {
        const bool hb = g + nw < nitems;
        if (hb) { ib = moe_cvt_item(wg, wu, wd, gain, ws, g + nw, lane); moe_cvt_load(vb, ib, lane); }
        moe_cvt_finish(va, ia, scr, lane);
        g += nw; if (!hb) break;
        const bool ha = g + nw < nitems;
        if (ha) { ia = moe_cvt_item(wg, wu, wd, gain, ws, g + nw, lane); moe_cvt_load(va, ia, lane); }
        moe_cvt_finish(vb, ib, scr, lane);
        g += nw; if (!ha) break;
    }
}
#define TR8_JOB(KIND, W, ldw, ncols, K, ksc, WT8) do { const int nit_ = ((K) / 64) * (((ncols) + 63) / 64); int st_ = gw - rot; if (st_ < 0) st_ += NGW; \
    for (int it_ = st_; it_ < nit_; it_ += NGW) tr8_item<KIND>(W, ldw, ncols, K, ksc, WT8, (LAS unsigned*)scr, it_, lane); rot = (rot + nit_) % NGW; } while (0)
#define TR_JOB(KIND, W, ldw, ncols, K, ksc, WT, row_off) TR_JOB2(KIND, W, ldw, ncols, K, ksc, WT, K, 0, row_off)
#define TR_JOB2(KIND, W, ldw, ncols, K, ksc, WT, ldk, koff, row_off) do { const int nit_ = ((K) / 64) * (((ncols) + 63) / 64); int st_ = gw - rot; if (st_ < 0) st_ += NGW; \
    for (int it_ = st_; it_ < nit_; it_ += NGW) tr_item<KIND>(W, ldw, ncols, K, ksc, WT, ldk, koff, row_off, (LAS unsigned*)scr, it_, lane); rot = (rot + nit_) % NGW; } while (0)
#define CVT_LAYER(l_) do { bf16_t* WIN_ = (bf16_t*)(ws + WS_WIN + (l_) * WIN_STRIDE); \
        TR_JOB(1, args.in[2] + (size_t)(l_) * 1024 * DIN, DIN, 5288, 1024, args.in[1] + (l_) * 1024, WIN_, 0);     \
        for (int i = gw * 64 + lane; i < (NP1 - DIN) * 1024 / 8; i += NGW * 64) *(u32x4*)(WIN_ + (size_t)DIN * 1024 + (size_t)i * 8) = (u32x4){0u, 0u, 0u, 0u};     \
        TR8_JOB(0, args.in[2] + (size_t)(l_) * 1024 * DIN + 5288, DIN, 3072, 1024, args.in[1] + (l_) * 1024, ws + WS_WGL8 + (size_t)(l_) * 3 * MiB); \
        TR_JOB(2, args.in[7] + (size_t)(l_) * 384 * 768, 768, 768, 384, args.in[5] + (l_) * 384, (bf16_t*)(ws + WS_WUQ + (l_) * MiB), 0); \
        TR_JOB(0, args.in[8] + (size_t)(l_) * 256 * 512, 512, 512, 256, args.in[6] + (l_) * 256, (bf16_t*)(ws + WS_WUKV + (l_) * (MiB / 2)), 0); \
        TR_JOB(0, args.in[9] + (size_t)(l_) * 256 * 512, 512, 512, 256, args.in[6] + (l_) * 256, (bf16_t*)(ws + WS_WUKV + (l_) * (MiB / 2)), 512); \
        TR_JOB2(0, args.in[10] + (size_t)(l_) * 512 * 1024, 1024, 1024, 512, (const float*)nullptr, (bf16_t*)(ws + WS_WBCAT + (l_) * 4 * MiB), 2048, 0, 0); \
        TR_JOB2(0, args.in[11] + (size_t)(l_) * 1024 * 1024, 1024, 1024, 1024, (const float*)nullptr, (bf16_t*)(ws + WS_WBCAT + (l_) * 4 * MiB), 2048, 512, 0); \
        TR_JOB2(0, args.in[12] + (size_t)(l_) * 512 * 1024, 1024, 1024, 512, (const float*)nullptr, (bf16_t*)(ws + WS_WBCAT + (l_) * 4 * MiB), 2048, 1536, 0); \
        TR_JOB(0, args.in[13] + (size_t)(l_) * 1024 * 1024, 1024, 1024, 1024, (const float*)nullptr, (bf16_t*)(ws + WS_WOUT + (l_) * 2 * MiB), 0); } while (0)
#define CVT_DENSE() do { \
        TR_JOB(3, args.in[15], DFF, DFF, 1024, args.in[14], (bf16_t*)(ws + WS_WGU), 0); \
        TR_JOB(4, args.in[16], DFF, DFF, 1024, args.in[14], (bf16_t*)(ws + WS_WGU), 0); \
        TR_JOB(0, args.in[17], 1024, 1024, DFF, (const float*)nullptr, (bf16_t*)(ws + WS_WDN), 0); } while (0)
#define CVT_MOE(e0_, e1_, gu_) do { for (int e = (e0_); e < (e1_); ++e) { \
        if (gu_) { TR8_JOB(3, args.in[19] + (size_t)e * 1024 * DFF, DFF, DFF, 1024, args.in[14] + 1024, ws + pg8::moe_gu_base(e)); \
                   TR8_JOB(4, args.in[20] + (size_t)e * 1024 * DFF, DFF, DFF, 1024, args.in[14] + 1024, ws + pg8::moe_gu_base(e)); } \
        TR8_JOB(0, args.in[21] + (size_t)e * DFF * 1024, 1024, 1024, DFF, (const float*)nullptr, ws + pg8::moe_dn_base(e)); } } while (0)
#define CVT_IS_BLOCK() (((bx >> 3) & 3) == 0)
#define CVT_RANK() ((bx >> 5) * 8 + (bx & 7))

struct Args { const float* in[23]; float* out; unsigned char* ws; int ph_lo, ph_hi; };
constexpr int NPH = 32;
__host__ __device__ constexpr int PH(int l, int j) { return 1 + 16 * l + j; }

__device__ __forceinline__ void moe_table(const int* CNT, volatile LAS unsigned* MISC, int tid, int lane, int wave, int tb) {
    { int s = 0, bl = 0;
#pragma unroll
        for (int j = 0; j < 4; ++j) { const int bb = lane + 64 * j; const int c = CNT[bb * 8 + wave]; s += c; bl += (bb < tb) ? c : 0; }
        s = (int)wave_sum((float)s); bl = (int)wave_sum((float)bl);
        if (lane == 0) { MISC[16 + wave] = (unsigned)s; MISC[24 + wave] = (unsigned)bl; } }
    __syncthreads();
    if (tid == 0) { volatile LAS unsigned char* te = (volatile LAS unsigned char*)(MISC + 64); int t = 0;
        for (int e = 0; e < 8; ++e) { const int nt_ = ((int)MISC[16 + e] + 255) >> 8; for (int i = 0; i < nt_ && t < MAXT; ++i) te[t++] = (unsigned char)e; }
        MISC[32] = (unsigned)t; }
    __syncthreads();
}

#define IN(k) (lo <= (k) && (k) < hi)
#define SEAM() do { if (!MK_PER_PHASE) xcd_barrier(bar); } while (0)

#define RS_PREFILL() do { const int t_ = opaque_tid(); LAS float* rt8_ = (LAS float*)(lds + 131072 + 1024) + 256; \
    for (int i_ = t_; i_ < 2048; i_ += 512) { const float* p_ = SSQ16 + ((size_t)(bx & 7) * 2048 + i_) * 16; const f32x4 a_ = *(const f32x4*)p_, b_ = *(const f32x4*)(p_ + 4), c_ = *(const f32x4*)(p_ + 8), d_ = *(const f32x4*)(p_ + 12); \
        rt8_[i_] = __builtin_amdgcn_rsqf((((a_.x + a_.y) + (a_.z + a_.w)) + ((b_.x + b_.y) + (b_.z + b_.w)) + ((c_.x + c_.y) + (c_.z + c_.w)) + ((d_.x + d_.y) + (d_.z + d_.w))) * (1.f / 1024.f) + EPS); } \
    __syncthreads(); } while (0)
#define PHASE_IDS() const int tid = opaque_tid(), lane = tid & 63, wave = __builtin_amdgcn_readfirstlane(tid >> 6), gw = bx * 8 + wave; LAS float* scr = (LAS float*)(lds + wave * 16384); (void)lane; (void)gw; (void)scr
template <int l> __device__ __forceinline__ void layer_body(const Args& args, LAS unsigned char* lds, volatile LAS unsigned* MISC, const XcdBarrier& bar, const int lo, const int hi) {
    const int G = gridDim.x, bx = blockIdx.x, vcu = (bx & 7) * (G >> 3) + (bx >> 3), NGW = G * 8; (void)NGW; (void)vcu;
    unsigned char* ws = args.ws;
    float* XRES = args.out;
    float* SSQ16 = (float*)(ws + WS_SSQ16); const f32x2* T64 = (const f32x2*)(ws + WS_TAB64); const f32x2* T32 = (const f32x2*)(ws + WS_TAB32);
    float* SSQC = (float*)(ws + WS_SSQC); float* SSQK = (float*)(ws + WS_SSQK); float* LOGF = (float*)(ws + WS_LOGF);
    bf16_t* CUMB = (bf16_t*)(ws + WS_CUMB); bf16_t* KR = (bf16_t*)(ws + WS_KR); float* CUMF = (float*)(ws + WS_CUMF);
    bf16_t* XB = (bf16_t*)(ws + WS_XB); bf16_t* MERGED = (bf16_t*)(ws + WS_FQ);
    bf16_t *FQ = (bf16_t*)(ws + WS_FQ), *FK = (bf16_t*)(ws + WS_FK), *FV = (bf16_t*)(ws + WS_FV), *RQ = (bf16_t*)(ws + WS_RQ), *KG = (bf16_t*)(ws + WS_KG), *RV = (bf16_t*)(ws + WS_RV);
    bf16_t *RG = (bf16_t*)(ws + WS_RG), *GATES = (bf16_t*)(ws + WS_GATES), *CQ = (bf16_t*)(ws + WS_CQ), *CKV = (bf16_t*)(ws + WS_CKV);
    bf16_t *MQ = (bf16_t*)(ws + WS_MQ), *KN = (bf16_t*)(ws + WS_KN), *MV = (bf16_t*)(ws + WS_MV), *OCAT = (bf16_t*)(ws + WS_OCAT), *RP = (bf16_t*)(ws + WS_RP), *X1B = (bf16_t*)(ws + WS_X1B);
    float* Tst = (float*)(ws + WS_T); bf16_t* ACT = (bf16_t*)(ws + WS_ACT);

        const int pb = PH(l, 0);
        const bf16_t* WIN = (const bf16_t*)(ws + WS_WIN + l * WIN_STRIDE);
        const float* xin = l == 0 ? args.in[0] : (const float*)XRES;
        if (IN(pb + 0)) {
            pg8::GridOrder S; S.init(64, 20, G, bx, XB, WIN, 1024); S.pn_skip = 17; S.pn_add = 13;
            pg8::EpiP1 E{FQ, FK, FV, RQ, KG, RV, RG, GATES, CQ, CKV, KR, LOGF, SSQC, SSQK, SSQ16, T64, T32, args.in[3] + l * 8, (unsigned*)(ws + WS_CTL) + CW_KMSQ + 64 * l};
            RS_PREFILL(); E.pre = 1;
            pg8::gemm_phase<pg8::EpiP1, pg8::GridOrder, true>(lds, 1024, S, E);
            { pg8::GridOrder S8; S8.init(64, 12, G, bx, ws + WS_XB8, ws + WS_WGL8 + (size_t)l * 3 * MiB, 512); pg8::EpiGL8 E8{(unsigned char*)GATES};
              pg8::gemm_phase<pg8::EpiGL8, pg8::GridOrder, true, true>(lds, 512, S8, E8); }
            SEAM();
        }
        if (IN(pb + 1)) { PHASE_IDS();
            if (bx < 16) {
                const int b = bx >> 3, h = bx & 7, t0 = tid * 16; float v[16]; float run = 0.f;
#pragma unroll
                for (int j = 0; j < 16; ++j) { run += LOGF[((size_t)b * SEQ + t0 + j) * 8 + h]; v[j] = run; }
                float inc = run;
#pragma unroll
                for (int o = 1; o < 64; o <<= 1) { const float n = __int_as_float(__builtin_amdgcn_ds_bpermute((lane - o) << 2, __float_as_int(inc))); if (lane >= o) inc += n; }
                LAS float* wt = (LAS float*)lds;
                if (lane == 63) wt[wave] = inc;
                __syncthreads();
                float base = inc - run;
                for (int w = 0; w < wave; ++w) base += wt[w];
#pragma unroll
                for (int j = 0; j < 16; ++j) { const float bk = -(base + v[j]) * LOG2E; const unsigned short h0 = f2bf(bk); const float r1 = bk - bf2f(h0); const unsigned short h1 = f2bf(r1); const unsigned short h2 = f2bf(r1 - bf2f(h1));
                    *(u32x4*)(CUMB + ((size_t)bx * SEQ + t0 + j) * 8) = (u32x4){(unsigned)h0 | ((unsigned)h1 << 16), (unsigned)h2, 0u, 0u}; CUMF[(size_t)bx * SEQ + t0 + j] = bf2f(h0) + bf2f(h1) + bf2f(h2); }
                __syncthreads();
            }
            if (bx >= 192) { pg8::GridOrder S; S.init(64, 1, 64, bx - 192, XB, WIN, 1024); S.pn_off = 17;
              pg8::EpiP1 E{FQ, FK, FV, RQ, KG, RV, RG, GATES, CQ, CKV, KR, LOGF, SSQC, SSQK, SSQ16, T64, T32, args.in[3] + l * 8, (unsigned*)(ws + WS_CTL) + CW_KMSQ + 64 * l};
              pg8::gemm_phase<pg8::EpiP1, pg8::GridOrder, true>(lds, 1024, S, E); }
            else { pg8::GridOrder S; S.init(64, 3, 192, bx, CQ, ws + WS_WUQ + l * MiB, 384); pg8::EpiMQ E{MQ, SSQC, T32};
              pg8::gemm_phase<pg8::EpiMQ, pg8::GridOrder, true>(lds, 384, S, E); }
            { pg8::GridOrder S; S.init(64, 4, G, bx, CKV, ws + WS_WUKV + l * (MiB / 2), 256); pg8::EpiKV E{KN, MV, SSQK};
              pg8::gemm_phase<pg8::EpiKV, pg8::GridOrder, true>(lds, 256, S, E); }
            if (bx >= 192) att::tstate_run(2 * (bx - 192), 1, 2, KG, RV, Tst, (LAS char*)lds);
            else if (bx >= 16) att::tstate_run(128 + bx - 16, 176, (1024 - (128 + bx - 16) + 175) / 176, KG, RV, Tst, (LAS char*)lds);
            SEAM();
        }
        if (IN(pb + 2)) { PHASE_IDS();
            for (int e = bx * 512 + tid; e < 16 * 8192; e += G * 512) { const int bh = e >> 13, el = e & 8191; const float lg = lg2gamma(bh & 7), g1 = fexp2(lg), g127 = fexp2(127.f * lg), g128 = fexp2(128.f * lg);
                float R = 0.f; const size_t base = (size_t)bh * 64 * 8192 + el; float Tc[64];
#pragma unroll
                for (int c = 0; c < 64; ++c) Tc[c] = Tst[base + (size_t)c * 8192];
                asm volatile("" ::: "memory");
#pragma unroll
                for (int c = 0; c < 64; ++c) { RP[base + (size_t)c * 8192] = f2bf(g1 * R); R = g128 * R + g127 * Tc[c]; } }
            SEAM();
        }
        if (IN(pb + 3)) {
            unsigned* qctr = (unsigned*)(ws + WS_CTL) + CW_QCTR + 64 * l;
            const unsigned* kmsq = (const unsigned*)(ws + WS_CTL) + CW_KMSQ + 64 * l;
            if (CVT_IS_BLOCK() && (l == 0 ? CVT_L1_IN_P4 : CVT_MOE_IN_P4)) { PHASE_IDS(); (void)tid;
                { const int cw_ = CVT_RANK() * 8 + wave; const int gw = cw_, NGW = 512; int rot = 0;
                  if constexpr (l == 0) { CVT_LAYER(1); CVT_DENSE(); } else moe_cvt_run(args.in[19], args.in[20], args.in[21], args.in[14] + 1024, ws, (LAS unsigned*)scr, cw_, NGW, 8 * 2688 - 896, lane); }
                __syncthreads(); }
            const int tid0 = opaque_tid();
            unsigned nxt_ = 0u; if (tid0 == 0) nxt_ = __hip_atomic_fetch_add(qctr, 1u, __ATOMIC_RELAXED, __HIP_MEMORY_SCOPE_AGENT);
            for (;;) {
                if (tid0 == 0) MISC[40] = nxt_;
                __syncthreads();
                const int idx = (int)MISC[40];
                __syncthreads();
                if (idx >= 1536) break;
                if (tid0 == 0) nxt_ = __hip_atomic_fetch_add(qctr, 1u, __ATOMIC_RELAXED, __HIP_MEMORY_SCOPE_AGENT);
                if (idx < 1024) { const int qb = 31 - (idx >> 5), w = idx & 31, bh = w & 15, b = bh >> 3, h = bh & 7; const size_t rb = (size_t)b * SEQ;
                    if (w < 16) att::attn_unit2<5, true, 9>(qb, FQ + rb * 512 + h * 64, 512, FK + rb * 512 + h * 64, 512, CUMB + (size_t)bh * SEQ * 8, 8, FV + rb * 512 + h * 64, 512, OCAT + rb * 2048 + h * 64, 2048, CUMF + (size_t)bh * SEQ, 1.01f * __builtin_sqrtf(__uint_as_float(kmsq[bh * 2]) + __uint_as_float(kmsq[bh * 2 + 1])), (LAS char*)lds);
                    else att::attn_unit2<6, false, 12>(qb, MQ + rb * 768 + h * 96, 768, KN + rb * 512 + h * 64, 512, KR + rb * 32, 32, MV + rb * 512 + h * 64, 512, OCAT + rb * 2048 + 1536 + h * 64, 2048, (const float*)nullptr, 0.f, (LAS char*)lds);
                } else { const int u = idx - 1024; att::ret_unit(u >> 5, u & 31, RQ, KG, RV, RP, RG, args.in[4] + l * 1024, OCAT, (LAS char*)lds); }
            }
            SEAM();
        }
        if (IN(pb + 4)) {
            pg8::GridOrder S; S.init(64, 4, G, bx, OCAT, ws + WS_WBCAT + l * 4 * MiB, 2048); pg8::EpiMerge E{(const unsigned char*)GATES, MERGED};
            pg8::gemm_phase<pg8::EpiMerge, pg8::GridOrder, true>(lds, 2048, S, E);
            SEAM();
        }
        if (IN(pb + 5)) {
            pg8::GridOrder S; S.init(64, 4, G, bx, MERGED, ws + WS_WOUT + l * 2 * MiB, 1024); pg8::EpiResid E{xin, l == 0 ? (float*)nullptr : XRES, l == 0 ? X1B : (bf16_t*)nullptr, SSQ16, l == 0 ? (unsigned char*)nullptr : ws + WS_XB8, XB};
            pg8::gemm_phase<pg8::EpiResid, pg8::GridOrder, true>(lds, 1024, S, E);
            SEAM();
        }
        if (l == 0) {
            if (IN(pb + 6)) {
#if FP8_DENSE_GU
                pg8::GridOrder S; S.init(64, 28, G, bx, ws + WS_XB8, ws + WS_WGU, 512); pg8::EpiSwiglu<false> E{ACT, SSQ16, 0};
                RS_PREFILL(); E.pre = 1; E.wsc = 1.f / 32.f;
                pg8::gemm_phase<pg8::EpiSwiglu<false>, pg8::GridOrder, true, true>(lds, 512, S, E);
#else
                pg8::GridOrder S; S.init(64, 28, G, bx, X1B, ws + WS_WGU, 1024); pg8::EpiSwiglu<false> E{ACT, SSQ16, 0};
                RS_PREFILL(); E.pre = 1;
                pg8::gemm_phase<pg8::EpiSwiglu<false>, pg8::GridOrder, true>(lds, 1024, S, E);
#endif
                SEAM();
            }
            if (IN(pb + 7)) {
                pg8::GridOrder S; S.init(64, 4, G, bx, ACT, ws + WS_WDN, DFF); pg8::EpiResid E{(const float*)nullptr, (float*)nullptr, XB, SSQ16, ws + WS_XB8, X1B};
                pg8::gemm_phase<pg8::EpiResid, pg8::GridOrder, true>(lds, DFF, S, E);
                SEAM();
            }
        } else {
            int* CNT = (int*)(ws + WS_CNT); f32x4* SEL = (f32x4*)(ws + WS_SEL); int* SLOT = (int*)(ws + WS_SLOT); float* RSL = (float*)(ws + WS_RSL);
            bf16_t* HS = (bf16_t*)(ws + WS_HS); bf16_t* Y = (bf16_t*)(ws + WS_Y); bf16_t* ACTM = (bf16_t*)(ws + WS_ACTM);
            if (IN(pb + 6)) { PHASE_IDS();
                LAS float* wrl = (LAS float*)lds;
                { float wq_[16], gq_[16];
#pragma unroll
                  for (int p = 0; p < 16; ++p) { const int i = tid + 512 * p; wq_[p] = args.in[18][i]; gq_[p] = args.in[14][1024 + (i >> 3)]; }
#pragma unroll
                  for (int p = 0; p < 16; ++p) { const int i = tid + 512 * p; wrl[(i & 7) * 1024 + (i >> 3)] = wq_[p] * gq_[p]; } }
                __syncthreads();
                volatile LAS unsigned char* selb = (volatile LAS unsigned char*)(lds + 65536);
                for (int tb = bx; tb < 256; tb += G) {
                    f32x4 xq_[4];
#pragma unroll
                    for (int j = 0; j < 4; ++j) xq_[j] = ((const f32x4*)(XRES + (size_t)(tb * 64 + wave * 8) * 1024) + lane)[64 * j];
                    for (int tk = 0; tk < 8; ++tk) { const int tl = wave * 8 + tk, t = tb * 64 + tl;
                        f32x4 xc_[4], xn_[4];
#pragma unroll
                        for (int j = 0; j < 4; ++j) xc_[j] = xq_[j];
                        if (tk < 7) {
#pragma unroll
                            for (int j = 0; j < 4; ++j) xn_[j] = ((const f32x4*)(XRES + (size_t)(t + 1) * 1024) + lane)[64 * j]; }
                        float ssq = 0.f; float a[8];
#pragma unroll
                        for (int e = 0; e < 8; ++e) a[e] = 0.f;
#pragma unroll
                        for (int j = 0; j < 4; ++j) { const f32x4 v = xc_[j]; ssq += (v.x * v.x + v.y * v.y) + (v.z * v.z + v.w * v.w); const int k = 4 * (64 * j + lane);
#pragma unroll
                            for (int e = 0; e < 8; ++e) { const f32x4 w = *(const LAS f32x4*)(wrl + e * 1024 + k); a[e] += (v.x * w.x + v.y * w.y) + (v.z * w.z + v.w * w.w); } }
                        ssq = wave_sum(ssq);
#pragma unroll
                        for (int e = 0; e < 8; ++e) a[e] = wave_sum(a[e]);
                        const float r = __builtin_amdgcn_rsqf(ssq * (1.f / 1024.f) + EPS);
                        int i0 = 0; float v0 = a[0];
#pragma unroll
                        for (int e = 1; e < 8; ++e) if (a[e] > v0) { v0 = a[e]; i0 = e; }
                        int i1 = -1; float v1 = -INFINITY;
#pragma unroll
                        for (int e = 0; e < 8; ++e) if (e != i0 && a[e] > v1) { v1 = a[e]; i1 = e; }
                        const float e1 = __expf((v1 - v0) * r), w0 = 1.f / (1.f + e1), w1 = e1 * w0;
                        if (lane == 0) { SEL[t] = (f32x4){__uint_as_float((unsigned)i0 | ((unsigned)i1 << 8)), w0, w1, r}; selb[tl * 2] = (unsigned char)i0; selb[tl * 2 + 1] = (unsigned char)i1; }
                        if (tk < 7) {
#pragma unroll
                            for (int j = 0; j < 4; ++j) xq_[j] = xn_[j]; } }
                    __syncthreads();
                    if (tid < 8) { int c = 0; for (int i = 0; i < 128; ++i) c += (selb[i] == tid) ? 1 : 0; CNT[tb * 8 + tid] = c; }
                    __syncthreads();
                }
                { int rot = 0; if (CVT_MOE_IN_P4) CVT_MOE(7, 8, false); else CVT_MOE(0, 8, true); }
                SEAM();
            }
            if (IN(pb + 7)) { PHASE_IDS();
                volatile LAS int* lslot = (volatile LAS int*)lds;
                for (int tb = bx; tb < 256; tb += G) {
                    moe_table(CNT, MISC, tid, lane, wave, tb);
                    if (wave == 0) { const int t = tb * 64 + lane; const f32x4 se = SEL[t]; const unsigned ee = __float_as_uint(se.x); const int e0 = ee & 255, e1 = (ee >> 8) & 255; int s0 = 0, s1 = 0, off = 0;
                        for (int e = 0; e < 8; ++e) { const unsigned long long mk = __ballot(e0 == e || e1 == e); const int rank = __popcll(mk & ((1ull << lane) - 1ull)); const int sl = off + (int)MISC[24 + e] + rank;
                            if (e0 == e) s0 = sl; if (e1 == e) s1 = sl; off += (((int)MISC[16 + e] + 255) >> 8) << 8; }
                        SLOT[t * 2] = s0; SLOT[t * 2 + 1] = s1; RSL[s0] = se.w; RSL[s1] = se.w; lslot[lane * 2] = s0; lslot[lane * 2 + 1] = s1; }
                    __syncthreads();
#if FP8_MOE_GU
                    { u32x4 rowv[8];
#pragma unroll
                      for (int i = 0; i < 8; ++i) rowv[i] = ((const u32x4*)(ws + WS_XB8 + (size_t)(tb * 64 + wave * 8 + i) * 1024))[lane];
                      asm volatile("" ::: "memory");
#pragma unroll
                      for (int i = 0; i < 16; ++i) { const int sl = lslot[wave * 16 + i]; ((u32x4*)((unsigned char*)HS + (size_t)sl * 1024))[lane] = rowv[i >> 1]; } }
#else
                    for (int p = wave * 16; p < wave * 16 + 16; ++p) { const int t = tb * 64 + (p >> 1), sl = lslot[p]; const u32x4* src = (const u32x4*)(X1B + (size_t)t * 1024); u32x4* dst = (u32x4*)(HS + (size_t)sl * 1024);
                        dst[lane] = src[lane]; dst[lane + 64] = src[lane + 64]; }
#endif
                    __syncthreads();
                }
                SEAM();
            }
            for (int ci = 0; ci < 2; ++ci) {
                if (IN(pb + 8 + 2 * ci)) { PHASE_IDS();
                    const int Tt = (int)MISC[32], t0 = 64 * ci, t1 = ci == 0 ? (Tt < 64 ? Tt : 64) : Tt;
                    if (t0 < t1) { pg8::MoeOrder S{t0, t1 - t0, 28, G, bx, 0, (const char*)HS, (const char*)ws, (size_t)256 * 1024, (size_t)0, (const LAS unsigned char*)(lds + MISC_OFF + 256)};
                        pg8::EpiSwiglu<true, FP8_MOE_DN != 0> E{ACTM, RSL, t0}; if (FP8_MOE_GU) E.wsc = 1.f / 32.f;
                        if (ci == 0 && t1 == 64) {
                            LAS float* rt8_ = (LAS float*)(lds + 131072 + 1024) + 256; { const float a_ = RSL[(bx & 7) * 2048 + tid], b_ = RSL[(bx & 7) * 2048 + tid + 512], c_ = RSL[(bx & 7) * 2048 + tid + 1024], d_ = RSL[(bx & 7) * 2048 + tid + 1536];
                              rt8_[tid] = a_; rt8_[tid + 512] = b_; rt8_[tid + 1024] = c_; rt8_[tid + 1536] = d_; } __syncthreads(); E.pre = 1; }
                        else if ((t1 - t0) * 28 <= 8 * G) {
                            LAS float* rt8_ = (LAS float*)(lds + 131072 + 1024) + 256; float vq[4];
#pragma unroll
                            for (int p = 0; p < 4; ++p) { const int idx = tid + 512 * p; pg8::Unit uu; vq[p] = S.next(idx >> 8, uu) ? RSL[uu.pm * 256 + (idx & 255)] : 0.f; }
#pragma unroll
                            for (int p = 0; p < 4; ++p) rt8_[tid + 512 * p] = vq[p];
                            __syncthreads(); E.pre = 2; }
                        pg8::gemm_phase<pg8::EpiSwiglu<true, FP8_MOE_DN != 0>, pg8::MoeOrder, true, FP8_MOE_GU != 0>(lds, FP8_MOE_GU ? 512 : 1024, S, E); }
                    SEAM();
                }
                if (IN(pb + 9 + 2 * ci)) { PHASE_IDS();
                    const int Tt = (int)MISC[32], t0 = 64 * ci, t1 = ci == 0 ? (Tt < 64 ? Tt : 64) : Tt;
                    const int t1w = t1 < 128 ? t1 : 128;
                    constexpr int DB = FP8_MOE_DN ? 1 : 2; constexpr float OSC = FP8_MOE_DN ? 1.f / (32.f * pg8::ACT8_SC) : 1.f;
                    if (t0 < t1w) { pg8::MoeOrder S{t0, t1w - t0, 4, G, bx, t0, (const char*)ACTM, (const char*)ws, (size_t)256 * DFF * DB, (size_t)0, (const LAS unsigned char*)(lds + MISC_OFF + 256), 0, 1};
                        pg8::EpiY E{Y, OSC}; pg8::gemm_phase<pg8::EpiY, pg8::MoeOrder, true, FP8_MOE_DN != 0>(lds, DFF * DB / 2, S, E); }
                    if (ci == 1 && t1 > 128) { pg8::MoeOrder S{128, t1 - 128, 4 * YPARTS, G, bx, t0, (const char*)ACTM, (const char*)ws, (size_t)256 * DFF * DB, (size_t)0, (const LAS unsigned char*)(lds + MISC_OFF + 256), YPART_BYTES, 1};
                        pg8::EpiYPart E{(bf16_t*)(ws + WS_YP), 128 * 256, OSC}; pg8::gemm_phase<pg8::EpiYPart, pg8::MoeOrder, true, FP8_MOE_DN != 0>(lds, DFF * DB / 2, S, E, YPART_BYTES / 2); }
                    SEAM();
                }
            }
            if (IN(pb + 14)) { PHASE_IDS();
                const f32x4* fw = (const f32x4*)args.in[22] + lane;
                for (int m = gw; m < M; m += NGW) { const f32x4 se = SEL[m]; const int s0 = SLOT[m * 2], s1 = SLOT[m * 2 + 1];
                    f32x4* xr = (f32x4*)(XRES + (size_t)m * 1024) + lane; const bf16_t* YP = (const bf16_t*)(ws + WS_YP);
                    f32x4 v[4]; float ss = 0.f;
#pragma unroll
                    for (int j = 0; j < 4; ++j) v[j] = xr[64 * j];
#pragma unroll
                    for (int k = 0; k < 2; ++k) { const int sl = k == 0 ? s0 : s1; const float wk = k == 0 ? se.y : se.z;
                        const bool part = sl >= 128 * 256;
                        if (!part) { const unsigned* y8 = (const unsigned*)((const unsigned char*)Y + (size_t)sl * 1024) + lane; const float wq = wk * (1.f / pg8::Y8_SC);
#pragma unroll
                            for (int j = 0; j < 4; ++j) { const unsigned w = y8[64 * j]; const auto lo = __builtin_amdgcn_cvt_pk_f32_fp8((int)w, false), hi = __builtin_amdgcn_cvt_pk_f32_fp8((int)w, true);
                                v[j] += (f32x4){lo[0], lo[1], hi[0], hi[1]} * wq; } }
                        else { const u32x2* yb_ = (const u32x2*)(YP + (size_t)(sl - 128 * 256) * 1024) + lane;
                        for (int p = 0; p < YPARTS; ++p) { const u32x2* yp = yb_ + (size_t)p * 2048 * 1024 / 4;
#pragma unroll
                            for (int j = 0; j < 4; ++j) { const u32x2 a = yp[64 * j];
                                const f32x4 ya = {__uint_as_float(a.x << 16), __uint_as_float(a.x & 0xffff0000u), __uint_as_float(a.y << 16), __uint_as_float(a.y & 0xffff0000u)}; v[j] += ya * wk; } } } }
#pragma unroll
                    for (int j = 0; j < 4; ++j) ss += (v[j].x * v[j].x + v[j].y * v[j].y) + (v[j].z * v[j].z + v[j].w * v[j].w);
                    const float r = __builtin_amdgcn_rsqf(wave_sum(ss) * (1.f / 1024.f) + EPS);
#pragma unroll
                    for (int j = 0; j < 4; ++j) xr[64 * j] = v[j] * r * fw[64 * j]; }
            }
        }
}

__global__ void __launch_bounds__(512, 2) hybrid_fwd(Args args) {
    extern __shared__ __attribute__((aligned(16))) unsigned char lds_raw[];
    LAS unsigned char* lds = (LAS unsigned char*)lds_raw;
    volatile LAS unsigned* MISC = (volatile LAS unsigned*)(lds + MISC_OFF);
    const int G = gridDim.x, bx = blockIdx.x, vcu = (bx & 7) * (G >> 3) + (bx >> 3), NGW = G * 8;
    unsigned char* ws = args.ws;
    for (int u = threadIdx.x; u < (LDS_BYTES - MISC_OFF) / 4; u += 512) MISC[u] = 0u;
    __syncthreads();
    XcdBarrier bar; bar.bar = (unsigned*)(ws + WS_CTL); bar.x = 0; bar.st = nullptr;
    if (!MK_PER_PHASE) bar = xcd_barrier_post((unsigned*)(ws + WS_CTL), MISC + 8);
    const int lo = args.ph_lo, hi = args.ph_hi;
    float* XRES = args.out;
    float* SSQ16 = (float*)(ws + WS_SSQ16); const f32x2* T64 = (const f32x2*)(ws + WS_TAB64); const f32x2* T32 = (const f32x2*)(ws + WS_TAB32);
    float* SSQC = (float*)(ws + WS_SSQC); float* SSQK = (float*)(ws + WS_SSQK); float* LOGF = (float*)(ws + WS_LOGF);
    bf16_t* CUMB = (bf16_t*)(ws + WS_CUMB); bf16_t* KR = (bf16_t*)(ws + WS_KR); float* CUMF = (float*)(ws + WS_CUMF);
    bf16_t* XB = (bf16_t*)(ws + WS_XB); bf16_t* MERGED = (bf16_t*)(ws + WS_FQ);
    bf16_t *FQ = (bf16_t*)(ws + WS_FQ), *FK = (bf16_t*)(ws + WS_FK), *FV = (bf16_t*)(ws + WS_FV), *RQ = (bf16_t*)(ws + WS_RQ), *KG = (bf16_t*)(ws + WS_KG), *RV = (bf16_t*)(ws + WS_RV);
    bf16_t *RG = (bf16_t*)(ws + WS_RG), *GATES = (bf16_t*)(ws + WS_GATES), *CQ = (bf16_t*)(ws + WS_CQ), *CKV = (bf16_t*)(ws + WS_CKV);
    bf16_t *MQ = (bf16_t*)(ws + WS_MQ), *KN = (bf16_t*)(ws + WS_KN), *MV = (bf16_t*)(ws + WS_MV), *OCAT = (bf16_t*)(ws + WS_OCAT), *RP = (bf16_t*)(ws + WS_RP), *X1B = (bf16_t*)(ws + WS_X1B);
    float* Tst = (float*)(ws + WS_T); bf16_t* ACT = (bf16_t*)(ws + WS_ACT);

    if (IN(0)) { PHASE_IDS();
        int rot = 0;
        if (!CVT_L1_IN_P4) { CVT_LAYER(1); CVT_DENSE(); }
        CVT_LAYER(0);
        for (int idx = bx * 512 + tid; idx < SEQ * 32; idx += G * 512) { const int pos = idx >> 5, i = idx & 31; const double inv = exp2(-(double)(2 * i) / 64.0 * 13.287712379549449), ang = (double)pos * inv;
            ((f32x2*)(ws + WS_TAB64))[idx] = (f32x2){(float)cos(ang), (float)sin(ang)}; }
        for (int idx = bx * 512 + tid; idx < SEQ * 16; idx += G * 512) { const int pos = idx >> 4, i = idx & 15; const double inv = exp2(-(double)(2 * i) / 32.0 * 13.287712379549449), ang = (double)pos * inv;
            ((f32x2*)(ws + WS_TAB32))[idx] = (f32x2){(float)cos(ang), (float)sin(ang)}; }
        for (int m = gw; m < M; m += NGW) { const f32x4* xr = (const f32x4*)(args.in[0] + (size_t)m * 1024) + lane; u32x2* o8 = (u32x2*)(XB + (size_t)m * 1024) + lane; float s = 0.f;
#pragma unroll
            for (int j = 0; j < 4; ++j) { const f32x4 v = xr[64 * j]; s += (v.x * v.x + v.y * v.y) + (v.z * v.z + v.w * v.w); o8[64 * j] = (u32x2){pk2(v.x, v.y), pk2(v.z, v.w)};
                ((unsigned*)(ws + WS_XB8 + (size_t)m * 1024))[64 * j + lane] = pk4_fp8(v.x, v.y, v.z, v.w); }
            s = wave_sum(s); if (lane < 16) SSQ16[(size_t)m * 16 + lane] = lane == 0 ? s : 0.f; }
        SEAM();
    }

    layer_body<0>(args, lds, MISC, bar, lo, hi);
    layer_body<1>(args, lds, MISC, bar, lo, hi);
}
#undef IN
#undef SEAM

extern "C" void kernel_launch(void* const* d_in, const int* in_sizes, int n_in, void* d_out, int out_size, void* d_ws, size_t ws_size, hipStream_t stream) {
    static int ready = 0;
    if (ready == 0) {
        ready = -1;
        if (n_in != 23 || in_sizes[0] != M * DM || out_size != M * DM || ws_size < WS_END) { fprintf(stderr, "kernel_launch: unexpected shapes (n_in %d, in0 %d, out %d, ws %zu < %zu); nothing launched\n", n_in, n_in > 0 ? in_sizes[0] : -1, out_size, ws_size, (size_t)WS_END); return; }
        if (hipFuncSetAttribute((const void*)hybrid_fwd, hipFuncAttributeMaxDynamicSharedMemorySize, LDS_BYTES) != hipSuccess) { fprintf(stderr, "kernel_launch: hipFuncSetAttribute failed\n"); return; }
        int per_cu = 0; if (hipOccupancyMaxActiveBlocksPerMultiprocessor(&per_cu, (const void*)hybrid_fwd, 512, LDS_BYTES) != hipSuccess || per_cu < 1) fprintf(stderr, "kernel_launch: occupancy query says %d\n", per_cu);
        (void)hipGetLastError();
        ready = 1;
    }
    if (ready < 0) return;
    (void)hipMemsetAsync((char*)d_ws + WS_CTL, 0, CTL_ZERO_BYTES, stream);
    Args a{};
    for (int i = 0; i < 23; ++i) a.in[i] = (const float*)d_in[i];
    a.out = (float*)d_out; a.ws = (unsigned char*)d_ws;
#if MK_PER_PHASE
    for (int p = 0; p < NPH; ++p) {
        const bool exists = p == 0 || (p >= PH(0, 0) && p <= PH(0, 7)) || (p >= PH(1, 0) && p <= PH(1, 14));
        if (!exists) continue;
        a.ph_lo = p; a.ph_hi = p + 1;
        hipLaunchKernelGGL(hybrid_fwd, dim3(256), dim3(512), LDS_BYTES, stream, a);
    }
#else
    a.ph_lo = 0; a.ph_hi = NPH;
    hipLaunchKernelGGL(hybrid_fwd, dim3(256), dim3(512), LDS_BYTES, stream, a);
#endif
}
```

```cpp
#include <hip/hip_runtime.h>
#include <hip/hip_bf16.h>
#include <cstdio>
#include <cstdint>

#ifndef FP8_MOE_GU
#define FP8_MOE_GU 1
#endif
#ifndef FP8_MOE_DN
#define FP8_MOE_DN 1
#endif
#ifndef CVT_MOE_IN_P4
#define CVT_MOE_IN_P4 1
#endif
#ifndef CVT_L1_IN_P4
#define CVT_L1_IN_P4 1
#endif
#ifndef FP8_DENSE_DN
#define FP8_DENSE_DN 1
#endif
#ifndef FP8_DENSE_GU
#define FP8_DENSE_GU 0
#endif
#define YPARTS (FP8_MOE_DN ? 7 : 4)
#define YPART_BYTES (FP8_MOE_DN ? 512 : 1792)
#ifndef MK_PER_PHASE
#define MK_PER_PHASE 0
#endif

#define LAS __attribute__((address_space(3)))
typedef unsigned short bf16_t;
typedef short bf16x8 __attribute__((ext_vector_type(8)));
typedef short s16x4 __attribute__((ext_vector_type(4)));
typedef float f32x2 __attribute__((ext_vector_type(2)));
typedef float f32x4 __attribute__((ext_vector_type(4)));
typedef float f32x16 __attribute__((ext_vector_type(16)));
typedef unsigned u32x2 __attribute__((ext_vector_type(2)));
typedef unsigned u32x4 __attribute__((ext_vector_type(4)));
typedef __bf16 bf16x2_t __attribute__((ext_vector_type(2)));

constexpr int BATCH = 2, SEQ = 8192, DM = 1024, M = BATCH * SEQ;
constexpr int DIN = 8360, NP1 = 8448;
constexpr int DFF = 3584, NEXP = 8;
constexpr int MAXT = 136;
constexpr float EPS = 1e-6f;
constexpr float LOG2E = 1.4426950408889634f;
constexpr float C2F = 0.125f * LOG2E;
constexpr float C2M = 0.10206207261596575f * LOG2E;

__device__ __forceinline__ int opaque_tid() { int t = threadIdx.x; asm volatile("" : "+v"(t)); return t; }
template <int MASK> __device__ __forceinline__ float add_xor(float v) {
    if constexpr (MASK == 32) { auto rr = __builtin_amdgcn_permlane32_swap(__float_as_uint(v), __float_as_uint(v), false, false); return __uint_as_float(rr[0]) + __uint_as_float(rr[1]); }
    else return v + __int_as_float(__builtin_amdgcn_ds_swizzle(__float_as_int(v), (MASK << 10) | 0x1F));
}
__device__ __forceinline__ unsigned pk2(float lo, float hi) { f32x2 v = {lo, hi}; bf16x2_t b = __builtin_convertvector(v, bf16x2_t); return __builtin_bit_cast(unsigned, b); }
__device__ __forceinline__ unsigned pk4_fp8(float a, float b, float c, float d) { a = __builtin_amdgcn_fmed3f(a, -448.f, 448.f); b = __builtin_amdgcn_fmed3f(b, -448.f, 448.f); c = __builtin_amdgcn_fmed3f(c, -448.f, 448.f); d = __builtin_amdgcn_fmed3f(d, -448.f, 448.f); int v = __builtin_amdgcn_cvt_pk_fp8_f32(a, b, 0, false); v = __builtin_amdgcn_cvt_pk_fp8_f32(c, d, v, true); return (unsigned)v; }
__device__ __forceinline__ float bf2f(unsigned short u) { return __uint_as_float((unsigned)u << 16); }
__device__ __forceinline__ unsigned short f2bf(float f) { return (unsigned short)(pk2(f, 0.f) & 0xffffu); }
__device__ __forceinline__ float fexp2(float x) { return __builtin_amdgcn_exp2f(x); }
__device__ __forceinline__ float sigmoidf_(float x) { return __builtin_amdgcn_rcpf(1.f + fexp2(-x * LOG2E)); }
__device__ __forceinline__ float lg2gamma(int h) { const float e = fexp2((float)(-5 - h)); return -(e * (1.f + e * (0.5f + e * (0.33333333f + e * (0.25f + e * (0.2f + e * 0.16666667f)))))) * LOG2E; }

namespace pg8 {
constexpr int BM = 256, BK = 64, HALF = 128, HTB = HALF * BK * 2, STAGE_BYTES = 8 * HTB, NXCD = 8, WGM = 8;
__host__ __device__ __forceinline__ int lds_byte(int r, int c) { const int st = (r >> 4) * 2 + (c >> 5), rr = r & 15, cc = c & 31, ob = rr * 64 + cc * 2; return st * 1024 + (ob ^ (((ob >> 9) & 1) << 5)); }
__host__ __device__ __forceinline__ void stage_rc(int b, int& R, int& C) { const int st = b / 1024, sb = b % 1024, swz = sb ^ (((sb >> 9) & 1) << 5); R = (st >> 1) * 16 + swz / 64; C = (st & 1) * 32 + (swz % 64) / 2; }
__host__ __device__ __forceinline__ int perm32(int rho) { const int n = rho >> 4, i = rho & 15; return 8 * (i >> 2) + 4 * n + (i & 3); }

struct Unit { int pm, pn; const char* A; const char* B; int k; };

__device__ __forceinline__ bool grid_order(int i, int G, int c, int nM, int nN, int& pm, int& pn) {
    const int nwg = nM * nN; const long L = (long)i * G + c; if (L >= nwg) return false;
    int wgid = (int)L; { const int q = nwg / NXCD, r = nwg % NXCD, xcd = wgid % NXCD, off = wgid / NXCD; wgid = (xcd < r ? xcd * (q + 1) : r * (q + 1) + (xcd - r) * q) + off; }
    const int nig = WGM * nN, gid = wgid / nig, fm = gid * WGM, gsz = (nM - fm) < WGM ? (nM - fm) : WGM;
    pm = fm + ((wgid % nig) % gsz); pn = (wgid % nig) / gsz; return true;
}
struct GridOrder {
    int nM, nN, G, c; const char* A; const char* Bt; size_t tstep; int pn_off = 0, pn_skip = 1 << 30, pn_add = 1;
    __device__ __forceinline__ void init(int nM_, int nN_, int G_, int c_, const void* A_, const void* Bt_, int K) { nM = nM_; nN = nN_; G = G_; c = c_; A = (const char*)A_; Bt = (const char*)Bt_; tstep = (size_t)BM * K * 2; }
    __device__ __forceinline__ bool next(int i, Unit& u) const { if (!grid_order(i, G, c, nM, nN, u.pm, u.pn)) return false; u.pn += pn_off; if (u.pn >= pn_skip) u.pn += pn_add;
        u.A = A + (size_t)u.pm * tstep; u.B = Bt + (size_t)u.pn * tstep; return true; }
};
__host__ __device__ __forceinline__ size_t moe_gu_base(int e) { return e < 5 ? ((size_t)12 << 20) + (size_t)e * (7u << 20) : ((size_t)60 << 20) + (size_t)(e - 5) * (7u << 20); }
__host__ __device__ __forceinline__ size_t moe_dn_base(int e) { return e == 0 ? ((size_t)47 << 20) : e < 6 ? ((size_t)353 << 20) + (size_t)(e - 1) * (7u << 19) : e == 6 ? ((size_t)525 << 20) : ((size_t)461 << 20); }
struct MoeOrder {
    int t0, nM, nN, G, c, arow0; const char* A; const char* Bt; size_t tstep, estride; const LAS unsigned char* te; int kpart_bytes = 0, dn = 0;
    __device__ __forceinline__ bool next(int i, Unit& u) const { int pm, pn; if (!grid_order(i, G, c, nM, nN, pm, pn)) return false; u.pm = t0 + pm; u.pn = pn; u.k = i;
        const int kp = kpart_bytes ? (pn >> 2) : 0, pnn = kpart_bytes ? (pn & 3) : pn;
        u.A = A + (size_t)(u.pm - arow0) * tstep + (size_t)kp * kpart_bytes; u.B = Bt + (dn ? moe_dn_base(te[u.pm]) : moe_gu_base(te[u.pm])) + (size_t)pnn * tstep + (size_t)kp * kpart_bytes; return true; }
};

typedef int i32x4_t __attribute__((ext_vector_type(4)));
typedef int i32x8_t __attribute__((ext_vector_type(8)));
__device__ __forceinline__ i32x8_t cat8(const bf16x8 lo, const bf16x8 hi) { return __builtin_shufflevector(__builtin_bit_cast(i32x4_t, lo), __builtin_bit_cast(i32x4_t, hi), 0, 1, 2, 3, 4, 5, 6, 7); }
template <class Epi, class Sched, bool ALIGN_EPI, bool FP8 = false>
__device__ __forceinline__ void gemm_phase(LAS unsigned char* lds, const int K, const Sched& S, const Epi& E, const int KLEN = 0, const int ascale = 0x7F7F7F7F, const int wscale = 0x7F7F7F7F) {
    const int tid = opaque_tid(), wid = __builtin_amdgcn_readfirstlane(tid >> 6), lane = tid & 63, wr = wid >> 2, wc = wid & 3, fr = lane & 15, fq = lane >> 4;
    const int nt = (KLEN ? KLEN : K) / BK;
    LAS float* rtab = (LAS float*)(lds + 131072 + 1024);
    unsigned voffA[2], voffB[2];
#pragma unroll
    for (int i = 0; i < 2; ++i) { int R, C; stage_rc(tid * 16 + i * 8192, R, C); const int Rb = (R & ~31) + perm32(R & 31);
        voffA[i] = (unsigned)(R * K + C) * 2u; voffB[i] = (unsigned)(Rb * K + C) * 2u; }
    const size_t kstep = (size_t)(BK * 2);
    const size_t hstep = (size_t)HALF * K * 2;
    const unsigned ldsw = (unsigned)wid * 1024u;
    const int aoff = lds_byte(wr * 64 + fr, fq * 8), boff = lds_byte(wc * 32 + fr, fq * 8);
#define PG8_SA(b, h) (((b) * 2 + (h)) * HTB)
#define PG8_SB(b, h) ((4 + (b) * 2 + (h)) * HTB)
#define PG8_STAGE(bufoff, gbase, voff) do { _Pragma("unroll") for (int _i = 0; _i < 2; ++_i) \
        __builtin_amdgcn_global_load_lds((const unsigned*)((const char*)(gbase) + (voff)[_i]), (LAS unsigned*)(lds + (bufoff) + ldsw + _i * 8192), 16, 0, 0); } while (0)
#define PG8_LDA(dst, b, h) do { _Pragma("unroll") for (int m = 0; m < 4; ++m) { if constexpr (FP8) dst##8[m] = cat8(*(const LAS bf16x8*)(lds + PG8_SA(b, h) + aoff + m * 2048), *(const LAS bf16x8*)(lds + PG8_SA(b, h) + aoff + m * 2048 + 1024)); \
        else { _Pragma("unroll") for (int k = 0; k < 2; ++k) dst[m][k] = *(const LAS bf16x8*)(lds + PG8_SA(b, h) + aoff + m * 2048 + k * 1024); } } } while (0)
#define PG8_LDB(dst, b, h) do { _Pragma("unroll") for (int n = 0; n < 2; ++n) { if constexpr (FP8) dst##8[n] = cat8(*(const LAS bf16x8*)(lds + PG8_SB(b, h) + boff + n * 2048), *(const LAS bf16x8*)(lds + PG8_SB(b, h) + boff + n * 2048 + 1024)); \
        else { _Pragma("unroll") for (int k = 0; k < 2; ++k) dst[n][k] = *(const LAS bf16x8*)(lds + PG8_SB(b, h) + boff + n * 2048 + k * 1024); } } } while (0)
#define PG8_MMA(ai, bj, At, Bt) do { __builtin_amdgcn_s_setprio(1); _Pragma("unroll") for (int m = 0; m < 4; ++m) _Pragma("unroll") for (int n = 0; n < 2; ++n) { \
        if constexpr (FP8) asm volatile("s_nop 1\n\tv_mfma_scale_f32_16x16x128_f8f6f4 %0, %1, %2, %0, %3, %4 op_sel_hi:[0,0,0]" : "+v"(acc[ai][bj][m][n]) : "v"(Bt##8[n]), "v"(At##8[m]), "v"(scw_), "v"(sc1_)); \
        else { _Pragma("unroll") for (int k = 0; k < 2; ++k) acc[ai][bj][m][n] = __builtin_amdgcn_mfma_f32_16x16x32_bf16(Bt[n][k], At[m][k], acc[ai][bj][m][n], 0, 0, 0); } } __builtin_amdgcn_s_setprio(0); } while (0)
#define PG8_WAIT_V(n) asm volatile("s_waitcnt vmcnt(" #n ")" ::: "memory")
#define PG8_WAIT_L(n) asm volatile("s_waitcnt lgkmcnt(" #n ")" ::: "memory")
#define PG8_BAR __builtin_amdgcn_s_barrier()
#define PG8_SCHED __builtin_amdgcn_sched_barrier(0)
    Unit cur, nxt; int ui = 0;
    if (!S.next(0, cur)) return;
    f32x4 acc[2][2][4][2];
    if constexpr (Epi::HAS_INIT) E.init(acc, cur, wr, wc, fr, fq);
    else {
#pragma unroll
    for (int a = 0; a < 2; ++a)
#pragma unroll
        for (int b = 0; b < 2; ++b)
#pragma unroll
            for (int m = 0; m < 4; ++m)
#pragma unroll
                for (int n = 0; n < 2; ++n) acc[a][b][m][n] = (f32x4){0.f, 0.f, 0.f, 0.f};
    }
    int sc1_ = ascale, scw_ = wscale; asm volatile("" : "+v"(sc1_), "+v"(scw_));
    bf16x8 At[4][2], B0[2][2], B1[2][2]; i32x8_t At8[4], B08[2], B18[2]; (void)At; (void)B0; (void)B1; (void)At8; (void)B08; (void)B18;
    const char* cA = cur.A; const char* cB = cur.B;
    PG8_STAGE(PG8_SB(0, 0), cB, voffB); PG8_STAGE(PG8_SB(0, 1), cB + hstep, voffB); PG8_STAGE(PG8_SA(0, 0), cA, voffA); PG8_STAGE(PG8_SA(0, 1), cA + hstep, voffA);
    if (wr == 1) PG8_BAR;
    PG8_WAIT_V(2); PG8_BAR;
    PG8_STAGE(PG8_SB(1, 0), cB + kstep, voffB); PG8_STAGE(PG8_SA(1, 0), cA + kstep, voffA); PG8_STAGE(PG8_SB(1, 1), cB + hstep + kstep, voffB);
    PG8_WAIT_V(6); PG8_BAR;
    for (;;) {
        const bool has_next = S.next(ui + 1, nxt);
        const char* nA = has_next ? nxt.A : cA; const char* nB = has_next ? nxt.B : cB;
        int t = 0;
#pragma nounroll
        for (int sg = 0; sg < (Epi::HAS_MID ? 3 : 1); ++sg) {
        int tend = nt; if constexpr (Epi::HAS_MID) tend = sg == 0 ? Epi::MID0 : (sg == 1 ? Epi::MID1 : nt);
#pragma nounroll
        for (; t < tend; t += 2) {
            const bool last = (t == nt - 2);
            const char* a1 = cA + (size_t)(t + 1) * kstep;
            const char* a2 = last ? nA : cA + (size_t)(t + 2) * kstep; const char* b2 = last ? nB : cB + (size_t)(t + 2) * kstep;
            const char* a3 = a2 + kstep; const char* b3 = b2 + kstep;
            PG8_LDB(B0, 0, 0); PG8_LDB(B1, 0, 1); PG8_SCHED; PG8_LDA(At, 0, 0); PG8_STAGE(PG8_SA(1, 1), a1 + hstep, voffA);
            PG8_WAIT_V(8); PG8_WAIT_L(0); PG8_BAR; PG8_MMA(0, 0, At, B0); PG8_MMA(0, 1, At, B1); PG8_BAR; PG8_SCHED;
            PG8_LDA(At, 0, 1); PG8_STAGE(PG8_SB(0, 0), b2, voffB); PG8_STAGE(PG8_SB(0, 1), b2 + hstep, voffB); PG8_STAGE(PG8_SA(0, 0), a2, voffA);
            PG8_WAIT_V(8); PG8_WAIT_L(0); PG8_BAR; PG8_MMA(1, 0, At, B0); PG8_MMA(1, 1, At, B1); PG8_BAR; PG8_SCHED;
            PG8_LDB(B0, 1, 0); PG8_LDB(B1, 1, 1); PG8_SCHED; PG8_LDA(At, 1, 0); PG8_STAGE(PG8_SA(0, 1), a2 + hstep, voffA);
            PG8_WAIT_V(8); PG8_WAIT_L(0); PG8_BAR; PG8_MMA(0, 0, At, B0); PG8_MMA(0, 1, At, B1); PG8_BAR; PG8_SCHED;
            PG8_LDA(At, 1, 1); PG8_STAGE(PG8_SB(1, 0), b3, voffB); PG8_STAGE(PG8_SB(1, 1), b3 + hstep, voffB); PG8_STAGE(PG8_SA(1, 0), a3, voffA);
            PG8_WAIT_V(8); PG8_WAIT_L(0); PG8_BAR; PG8_MMA(1, 0, At, B0); PG8_MMA(1, 1, At, B1); PG8_BAR; PG8_SCHED;
        }
        if constexpr (Epi::HAS_MID) { if (sg < 2) E.mid(acc, cur, wr, wc, fr, fq, t); }
        }
        if constexpr (FP8) { asm volatile("s_nop 15\n\ts_nop 7" ::: "memory"); PG8_SCHED; }
        if constexpr (ALIGN_EPI) { if (wr == 0) PG8_BAR; }
        if constexpr (Epi::NEEDS_RS) { static_assert(ALIGN_EPI, "r-table needs aligned halves"); if (!E.prefilled()) { E.rs_table(cur, rtab); PG8_WAIT_L(0); PG8_BAR; asm volatile("" ::: "memory"); } }
        E(acc, cur, wr, wc, fr, fq, rtab);
        if (!has_next) break;
        if constexpr (Epi::HAS_INIT) E.init(acc, nxt, wr, wc, fr, fq);
        else {
#pragma unroll
        for (int a = 0; a < 2; ++a)
#pragma unroll
            for (int b = 0; b < 2; ++b)
#pragma unroll
                for (int m = 0; m < 4; ++m)
#pragma unroll
                    for (int n = 0; n < 2; ++n) acc[a][b][m][n] = (f32x4){0.f, 0.f, 0.f, 0.f};
        }
        cur = nxt; cA = nA; cB = nB; ++ui;
        if constexpr (ALIGN_EPI) { if (wr == 1) PG8_BAR; }
    }
    PG8_WAIT_V(0);
    if constexpr (!ALIGN_EPI) { if (wr == 0) PG8_BAR; }
    PG8_BAR;
#undef PG8_SA
#undef PG8_SB
#undef PG8_STAGE
#undef PG8_LDA
#undef PG8_LDB
#undef PG8_MMA
#undef PG8_WAIT_V
#undef PG8_WAIT_L
#undef PG8_BAR
#undef PG8_SCHED
}

template <int NP> __device__ __forceinline__ void rs_fill(const float* part, int row_first, float inv_n, LAS float* rtab) {
    const int tid = opaque_tid(), rl = tid >> 1, half = tid & 1; const float* p = part + (size_t)(row_first + rl) * NP + half * (NP / 2); float s;
    if constexpr (NP == 16) { const f32x4 a = *(const f32x4*)p, b = *(const f32x4*)(p + 4); s = ((a.x + a.y) + (a.z + a.w)) + ((b.x + b.y) + (b.z + b.w)); }
    else if constexpr (NP == 12) { const f32x2 a = *(const f32x2*)p, b = *(const f32x2*)(p + 2), c = *(const f32x2*)(p + 4); s = (a.x + a.y) + (b.x + b.y) + (c.x + c.y); }
    else { const f32x4 a = *(const f32x4*)p; s = (a.x + a.y) + (a.z + a.w); }
    s = add_xor<1>(s);
    if (half == 0) rtab[rl] = __builtin_amdgcn_rsqf(s * inv_n + EPS);
}
#define ST16(p, v) (*(u32x4*)(p) = (v))
__device__ __forceinline__ u32x4 pack8(const f32x4 a, const f32x4 b) { u32x4 w; w.x = pk2(a.x, a.y); w.y = pk2(a.z, a.w); w.z = pk2(b.x, b.y); w.w = pk2(b.z, b.w); return w; }
__device__ __forceinline__ float sum8sq(const f32x4 a, const f32x4 b) { return ((a.x * a.x + a.y * a.y) + (a.z * a.z + a.w * a.w)) + ((b.x * b.x + b.y * b.y) + (b.z * b.z + b.w * b.w)); }
__device__ __forceinline__ void rope4(f32x4& x1, f32x4& x2, const f32x4 t0, const f32x4 t1) {
    const f32x4 c = {t0.x, t0.z, t1.x, t1.z}, s = {t0.y, t0.w, t1.y, t1.w};
    const f32x4 y1 = x1 * c - x2 * s, y2 = x2 * c + x1 * s; x1 = y1; x2 = y2;
}

#define RS_(ai, m) rt[(ai) * HALF + (m) * 16]
struct EpiP1 {
    bf16_t *FQ, *FK, *FV, *RQ, *KG, *RV, *RG, *GATES, *CQ, *CKV, *KR; float *LOGF, *SSQC, *SSQK;
    const float* SSQ16; const f32x2* T64; const f32x2* T32; const float* fbias; unsigned* KMSQ;
    int pre = 0;
    static constexpr bool NEEDS_RS = true, HAS_MID = false, HAS_INIT = false;
    __device__ __forceinline__ bool prefilled() const { return pre != 0; }
    __device__ __forceinline__ void rs_table(const Unit& u, LAS float* rtab) const { rs_fill<16>(SSQ16, u.pm * BM, 1.f / 1024.f, rtab); }
    __device__ __forceinline__ void operator()(const f32x4 (&acc)[2][2][4][2], const Unit& u, int wr, int wc, int fr, int fq, const LAS float* rtab) const {
        const int pn = u.pn, row0 = u.pm * BM + wr * 64 + fr, ct0 = wc * 32 + fq * 8; const LAS float* rt = rtab + (pre ? 256 + (u.pm & 7) * 256 : 0) + wr * 64 + fr;
        if (pn < 6 || (pn >= 10 && pn < 14)) {
            bf16_t* dst; int ld, cb; float sc = 1.f;
            if (pn < 2) { dst = FQ; ld = 512; cb = pn * 256; sc = C2F; } else if (pn < 4) { dst = FK; ld = 512; cb = (pn - 2) * 256; } else if (pn < 6) { dst = FV; ld = 512; cb = (pn - 4) * 256; } else { dst = RV; ld = 1024; cb = (pn - 10) * 256; }
            float mx[2] = {0.f, 0.f};
#pragma unroll
            for (int ai = 0; ai < 2; ++ai)
#pragma unroll
                for (int m = 0; m < 4; ++m) { const int row = row0 + ai * HALF + m * 16; const float s = RS_(ai, m) * sc; bf16_t* rp = dst + (size_t)row * ld + cb + ct0;
#pragma unroll
                    for (int bj = 0; bj < 2; ++bj) { const f32x4 a = acc[ai][bj][m][0] * s, b = acc[ai][bj][m][1] * s; ST16(rp + bj * HALF, pack8(a, b));
                        if (pn == 2 || pn == 3) { float q = sum8sq(a, b); q = add_xor<16>(q); q = add_xor<32>(q); mx[bj] = fmaxf(mx[bj], q); } } }
            if (pn == 2 || pn == 3) {
#pragma unroll
                for (int bj = 0; bj < 2; ++bj) { float q = mx[bj];
                    q = fmaxf(q, __int_as_float(__builtin_amdgcn_ds_swizzle(__float_as_int(q), (1 << 10) | 0x1F))); q = fmaxf(q, __int_as_float(__builtin_amdgcn_ds_swizzle(__float_as_int(q), (2 << 10) | 0x1F)));
                    q = fmaxf(q, __int_as_float(__builtin_amdgcn_ds_swizzle(__float_as_int(q), (4 << 10) | 0x1F))); q = fmaxf(q, __int_as_float(__builtin_amdgcn_ds_swizzle(__float_as_int(q), (8 << 10) | 0x1F)));
                    const int colb = (pn - 2) * 256 + bj * HALF + wc * 32;
                    if (fr == 0 && fq == 0) atomicMax(KMSQ + (((u.pm * BM) >> 13) * 8 + (colb >> 6)) * 2 + ((colb >> 5) & 1), __float_as_uint(q)); } }
        } else if (pn >= 14 && pn < 30) {
            const bool gl = pn >= 18; const int cb = (pn - 14) * 256;
            bf16_t* gfb = GATES + ((size_t)(((pn - 18) >> 2) * 64 + u.pm) * 4 + ((pn - 18) & 3)) * (8 * 16 * 64 * 8) + (size_t)((wr * 4 + wc) * 16) * 512 + (fq * 16 + fr) * 8;
#pragma unroll
            for (int ai = 0; ai < 2; ++ai)
#pragma unroll
                for (int m = 0; m < 4; ++m) { const int row = row0 + ai * HALF + m * 16; const float s = RS_(ai, m); bf16_t* rp = gl ? gfb + (ai * 8 + m * 2) * 512 - 0 : RG + (size_t)row * 1024 + cb + ct0; const int bstep = gl ? 512 : HALF;
#pragma unroll
                    for (int bj = 0; bj < 2; ++bj) { f32x4 v[2];
#pragma unroll
                        for (int n = 0; n < 2; ++n) { const f32x4 x = acc[ai][bj][m][n] * s; f32x4 sg; sg.x = sigmoidf_(x.x); sg.y = sigmoidf_(x.y); sg.z = sigmoidf_(x.z); sg.w = sigmoidf_(x.w); v[n] = gl ? sg : x * sg; }
                        ST16(rp + bj * bstep, pack8(v[0], v[1])); } }
        } else if (pn >= 6 && pn < 10) {
            const bool isk = pn >= 8; bf16_t* dst = isk ? KG : RQ; const int cb = (pn - (isk ? 8 : 6)) * 256; const int i0 = 16 * (wc & 1) + 4 * fq;
#pragma unroll
            for (int ai = 0; ai < 2; ++ai) {
                f32x4 tq0[4], tq1[4];
#pragma unroll
                for (int m = 0; m < 4; ++m) { const int pos = (row0 + ai * HALF + m * 16) & (SEQ - 1); const f32x4* tp = (const f32x4*)(T64 + (size_t)pos * 32 + i0); tq0[m] = tp[0]; tq1[m] = tp[1]; }
                asm volatile("" ::: "memory");
#pragma unroll
                for (int m = 0; m < 4; ++m) { const int row = row0 + ai * HALF + m * 16, pos = row & (SEQ - 1); const float s = RS_(ai, m); bf16_t* rp = dst + (size_t)row * 512 + cb + ct0;
                    const f32x4 t0 = tq0[m], t1 = tq1[m];
#pragma unroll
                    for (int bj = 0; bj < 2; ++bj) { f32x4 x1 = acc[ai][bj][m][0] * s, x2 = acc[ai][bj][m][1] * s; rope4(x1, x2, t0, t1);
                        if (isk) { const int head = (cb + bj * HALF + wc * 32) >> 6; const float ks = 0.125f * fexp2(-(float)(pos & 127) * lg2gamma(head)); x1 = x1 * ks; x2 = x2 * ks; }
                        ST16(rp + bj * HALF, pack8(x1, x2)); } }
                asm volatile("" ::: "memory"); }
        } else {
#pragma unroll
            for (int bj = 0; bj < 2; ++bj) {
                int kind, col, grp;
                if (pn == 30) { kind = 0; col = bj * HALF + ct0; grp = 4 * bj + wc; }
                else if (pn == 31) { if (bj == 0) { kind = 0; col = 256 + ct0; grp = 8 + wc; } else { kind = 1; col = ct0; grp = wc; } }
                else { if (bj == 0) { kind = 1; col = HALF + ct0; grp = 4 + wc; } else { kind = 2; col = 0; grp = 0; } }
                if (kind < 2) {
                    bf16_t* dst = kind == 0 ? CQ : CKV; const int ld = kind == 0 ? 384 : 256; float* sq = kind == 0 ? SSQC : SSQK; const int np = kind == 0 ? 12 : 8;
#pragma unroll
                    for (int ai = 0; ai < 2; ++ai)
#pragma unroll
                        for (int m = 0; m < 4; ++m) { const int row = row0 + ai * HALF + m * 16; const float s = RS_(ai, m); const f32x4 a = acc[ai][bj][m][0] * s, b = acc[ai][bj][m][1] * s;
                            ST16(dst + (size_t)row * ld + col, pack8(a, b));
                            float q = sum8sq(a, b); q = add_xor<16>(q); q = add_xor<32>(q);
                            if (fq == 0) sq[(size_t)row * np + grp] = q; }
                } else if (wc == 0) {
#pragma unroll
                    for (int ai = 0; ai < 2; ++ai) {
                        f32x4 tq0[4], tq1[4];
#pragma unroll
                        for (int m = 0; m < 4; ++m) { const int pos = (row0 + ai * HALF + m * 16) & (SEQ - 1); const f32x4* tp = (const f32x4*)(T32 + (size_t)pos * 16 + 4 * fq); tq0[m] = tp[0]; tq1[m] = tp[1]; }
                        asm volatile("" ::: "memory");
#pragma unroll
                        for (int m = 0; m < 4; ++m) { const int row = row0 + ai * HALF + m * 16; const float s = RS_(ai, m);
                            f32x4 x1 = acc[ai][bj][m][0] * s, x2 = acc[ai][bj][m][1] * s; rope4(x1, x2, tq0[m], tq1[m]);
                            ST16(KR + (size_t)row * 32 + 8 * fq, pack8(x1, x2)); }
                        asm volatile("" ::: "memory"); }
                } else if (wc == 1 && fq == 0) {
                    const f32x4 b0 = *(const f32x4*)(fbias), b1 = *(const f32x4*)(fbias + 4);
#pragma unroll
                    for (int ai = 0; ai < 2; ++ai)
#pragma unroll
                        for (int m = 0; m < 4; ++m) { const int row = row0 + ai * HALF + m * 16; const float s = RS_(ai, m);
                            const f32x4 a = acc[ai][bj][m][0] * s + b0, b = acc[ai][bj][m][1] * s + b1; f32x4 la, lb;
                            la.x = fminf(a.x, 0.f) - __logf(1.f + __expf(-fabsf(a.x))); la.y = fminf(a.y, 0.f) - __logf(1.f + __expf(-fabsf(a.y))); la.z = fminf(a.z, 0.f) - __logf(1.f + __expf(-fabsf(a.z))); la.w = fminf(a.w, 0.f) - __logf(1.f + __expf(-fabsf(a.w)));
                            lb.x = fminf(b.x, 0.f) - __logf(1.f + __expf(-fabsf(b.x))); lb.y = fminf(b.y, 0.f) - __logf(1.f + __expf(-fabsf(b.y))); lb.z = fminf(b.z, 0.f) - __logf(1.f + __expf(-fabsf(b.z))); lb.w = fminf(b.w, 0.f) - __logf(1.f + __expf(-fabsf(b.w)));
                            *(f32x4*)(LOGF + (size_t)row * 8) = la; *(f32x4*)(LOGF + (size_t)row * 8 + 4) = lb; }
                }
            }
        }
    }
};

__device__ __forceinline__ unsigned pk4_gate(const f32x4 g) {
    const unsigned a = (unsigned)fmaxf(g.x * 255.f + 0.5f, 1.f), b = (unsigned)fmaxf(g.y * 255.f + 0.5f, 1.f), c = (unsigned)fmaxf(g.z * 255.f + 0.5f, 1.f), d = (unsigned)fmaxf(g.w * 255.f + 0.5f, 1.f);
    return a | (b << 8) | (c << 16) | (d << 24); }
struct EpiGL8 {
    unsigned char* GATES;
    static constexpr bool NEEDS_RS = true, HAS_MID = false, HAS_INIT = false;
    __device__ __forceinline__ bool prefilled() const { return true; }
    __device__ __forceinline__ void rs_table(const Unit&, LAS float*) const {}
    __device__ __forceinline__ void operator()(const f32x4 (&acc)[2][2][4][2], const Unit& u, int wr, int wc, int fr, int fq, const LAS float* rtab) const {
        const LAS float* rt = rtab + 256 + (u.pm & 7) * 256 + wr * 64 + fr;
        unsigned char* gfb = GATES + ((size_t)((u.pn >> 2) * 64 + u.pm) * 4 + (u.pn & 3)) * (8 * 16 * 64 * 8) + (size_t)((wr * 4 + wc) * 16) * 512 + (fq * 16 + fr) * 8;
#pragma unroll
        for (int ai = 0; ai < 2; ++ai)
#pragma unroll
            for (int m = 0; m < 4; ++m) { const float s = RS_(ai, m) * (-LOG2E / 32.f);
#pragma unroll
                for (int bj = 0; bj < 2; ++bj) { f32x4 v[2];
#pragma unroll
                    for (int n = 0; n < 2; ++n) { const f32x4 t = acc[ai][bj][m][n] * s; v[n].x = __builtin_amdgcn_rcpf(1.f + fexp2(t.x)); v[n].y = __builtin_amdgcn_rcpf(1.f + fexp2(t.y)); v[n].z = __builtin_amdgcn_rcpf(1.f + fexp2(t.z)); v[n].w = __builtin_amdgcn_rcpf(1.f + fexp2(t.w)); }
                    *(u32x2*)(gfb + (ai * 8 + m * 2 + bj) * 512) = (u32x2){pk4_gate(v[0]), pk4_gate(v[1])}; } }
    }
};
struct EpiMQ {
    bf16_t* MQ; const float* SSQC; const f32x2* T32;
    static constexpr bool NEEDS_RS = true, HAS_MID = false, HAS_INIT = false;
    __device__ __forceinline__ bool prefilled() const { return false; }
    __device__ __forceinline__ void rs_table(const Unit& u, LAS float* rtab) const { rs_fill<12>(SSQC, u.pm * BM, 1.f / 384.f, rtab); }
    __device__ __forceinline__ void operator()(const f32x4 (&acc)[2][2][4][2], const Unit& u, int wr, int wc, int fr, int fq, const LAS float* rtab) const {
        const int row0 = u.pm * BM + wr * 64 + fr, ct0 = wc * 32 + fq * 8; const LAS float* rt = rtab + wr * 64 + fr;
#pragma unroll
        for (int ai = 0; ai < 2; ++ai) {
            f32x4 tq0[4], tq1[4];
#pragma unroll
            for (int m = 0; m < 4; ++m) { const int pos = (row0 + ai * HALF + m * 16) & (SEQ - 1); const f32x4* tp = (const f32x4*)(T32 + (size_t)pos * 16 + 4 * fq); tq0[m] = tp[0]; tq1[m] = tp[1]; }
            asm volatile("" ::: "memory");
#pragma unroll
            for (int m = 0; m < 4; ++m) { const int row = row0 + ai * HALF + m * 16; const float s = RS_(ai, m); bf16_t* rp = MQ + (size_t)row * 768 + u.pn * 256 + ct0;
                const f32x4 t0 = tq0[m], t1 = tq1[m];
#pragma unroll
                for (int bj = 0; bj < 2; ++bj) { const int G = 8 * u.pn + 4 * bj + wc; f32x4 x1 = acc[ai][bj][m][0] * s, x2 = acc[ai][bj][m][1] * s;
                    if (G % 3 == 2) rope4(x1, x2, t0, t1);
                    ST16(rp + bj * HALF, pack8(x1 * C2M, x2 * C2M)); } }
            asm volatile("" ::: "memory"); }
    }
};
struct EpiKV {
    bf16_t *KN, *MV; const float* SSQK;
    static constexpr bool NEEDS_RS = true, HAS_MID = false, HAS_INIT = false;
    __device__ __forceinline__ bool prefilled() const { return false; }
    __device__ __forceinline__ void rs_table(const Unit& u, LAS float* rtab) const { rs_fill<8>(SSQK, u.pm * BM, 1.f / 256.f, rtab); }
    __device__ __forceinline__ void operator()(const f32x4 (&acc)[2][2][4][2], const Unit& u, int wr, int wc, int fr, int fq, const LAS float* rtab) const {
        const int row0 = u.pm * BM + wr * 64 + fr, ct0 = wc * 32 + fq * 8; const LAS float* rt = rtab + wr * 64 + fr;
        bf16_t* dst = u.pn < 2 ? KN : MV; const int cb = (u.pn & 1) * 256;
#pragma unroll
        for (int ai = 0; ai < 2; ++ai)
#pragma unroll
            for (int m = 0; m < 4; ++m) { const int row = row0 + ai * HALF + m * 16; const float s = RS_(ai, m); bf16_t* rp = dst + (size_t)row * 512 + cb + ct0;
#pragma unroll
                for (int bj = 0; bj < 2; ++bj) ST16(rp + bj * HALF, pack8(acc[ai][bj][m][0] * s, acc[ai][bj][m][1] * s)); }
    }
};
struct EpiMerge {
    const unsigned char* GATES; bf16_t* MERGED;
    static constexpr bool NEEDS_RS = false, HAS_MID = true, HAS_INIT = false; static constexpr int MID0 = 8, MID1 = 24;
    static __device__ __forceinline__ void unpack_gate(const u32x2 g, f32x4& g0, f32x4& g1) {
        g0 = (f32x4){(float)(g.x & 255u), (float)((g.x >> 8) & 255u), (float)((g.x >> 16) & 255u), (float)(g.x >> 24)};
        g1 = (f32x4){(float)(g.y & 255u), (float)((g.y >> 8) & 255u), (float)((g.y >> 16) & 255u), (float)(g.y >> 24)}; }
    __device__ __forceinline__ void mid(f32x4 (&acc)[2][2][4][2], const Unit& u, int wr, int wc, int fr, int fq, int t) const {
        int row0 = ((wr * 4 + wc) * 16) * 512 + (fq * 16 + fr) * 8; asm volatile("" : "+v"(row0));
        const int br = t == MID0 ? 0 : 1;
        const unsigned char* gfb = GATES + ((size_t)(br * 64 + u.pm) * 4 + u.pn) * (8 * 16 * 64 * 8) + (size_t)row0;
#pragma unroll
        for (int ai = 0; ai < 2; ++ai) {
            u32x2 pq[8], nq[8];
#pragma unroll
            for (int sl = 0; sl < 8; ++sl) { const unsigned char* gp = gfb + (ai * 8 + sl) * 512; pq[sl] = *(const u32x2*)gp; nq[sl] = *(const u32x2*)(gp + (size_t)64 * 4 * (8 * 16 * 64 * 8)); }
            asm volatile("" ::: "memory");
#pragma unroll
            for (int m = 0; m < 4; ++m) {
#pragma unroll
                for (int bj = 0; bj < 2; ++bj) {
                    f32x4 p0, p1, n0, n1; unpack_gate(pq[m * 2 + bj], p0, p1); unpack_gate(nq[m * 2 + bj], n0, n1);
                    n0.x = __builtin_amdgcn_rcpf(n0.x); n0.y = __builtin_amdgcn_rcpf(n0.y); n0.z = __builtin_amdgcn_rcpf(n0.z); n0.w = __builtin_amdgcn_rcpf(n0.w);
                    n1.x = __builtin_amdgcn_rcpf(n1.x); n1.y = __builtin_amdgcn_rcpf(n1.y); n1.z = __builtin_amdgcn_rcpf(n1.z); n1.w = __builtin_amdgcn_rcpf(n1.w);
                    acc[ai][bj][m][0] = acc[ai][bj][m][0] * (p0 * n0); acc[ai][bj][m][1] = acc[ai][bj][m][1] * (p1 * n1); }
                }
            asm volatile("" ::: "memory"); }
    }
    __device__ __forceinline__ void operator()(const f32x4 (&acc)[2][2][4][2], const Unit& u, int wr, int wc, int fr, int fq, const LAS float* rtab) const {
        const int row0 = u.pm * BM + wr * 64 + fr, c0 = u.pn * BM + wc * 32 + fq * 8;
        const unsigned char* gfb = GATES + ((size_t)(2 * 64 + u.pm) * 4 + u.pn) * (8 * 16 * 64 * 8) + (size_t)((wr * 4 + wc) * 16) * 512 + (fq * 16 + fr) * 8;
        u32x2 gq[16];
#pragma unroll
        for (int sl = 0; sl < 16; ++sl) gq[sl] = *(const u32x2*)(gfb + sl * 512);
        asm volatile("" ::: "memory");
#pragma unroll
        for (int ai = 0; ai < 2; ++ai)
#pragma unroll
            for (int m = 0; m < 4; ++m) { const int row = row0 + ai * HALF + m * 16;
#pragma unroll
                for (int bj = 0; bj < 2; ++bj) { const int col = c0 + bj * HALF; f32x4 g0, g1; unpack_gate(gq[ai * 8 + m * 2 + bj], g0, g1);
                    *(u32x4*)(MERGED + (size_t)row * 1024 + col) = pack8(acc[ai][bj][m][0] * (g0 * (1.f / 255.f)), acc[ai][bj][m][1] * (g1 * (1.f / 255.f))); }
                }
    }
};
struct EpiResid {
    const float* xin; float* xo; bf16_t* XB; float* SSQ16; unsigned char* XB8 = nullptr;
    const bf16_t* xin16 = nullptr;
    static constexpr bool NEEDS_RS = false, HAS_MID = false, HAS_INIT = true;
    __device__ __forceinline__ void init(f32x4 (&acc)[2][2][4][2], const Unit& u, int wr, int wc, int fr, int fq) const {
        const int row0 = u.pm * BM + wr * 64 + fr, c0 = u.pn * BM + wc * 32 + fq * 8;
#pragma unroll
        for (int ai = 0; ai < 2; ++ai)
#pragma unroll
            for (int m = 0; m < 4; ++m)
#pragma unroll
                for (int bj = 0; bj < 2; ++bj) { const size_t off = (size_t)(row0 + ai * HALF + m * 16) * 1024 + c0 + bj * HALF;
                    if (xin16) { const u32x4 w = *(const u32x4*)(xin16 + off);
                        acc[ai][bj][m][0] = (f32x4){__uint_as_float(w.x << 16), __uint_as_float(w.x & 0xffff0000u), __uint_as_float(w.y << 16), __uint_as_float(w.y & 0xffff0000u)};
                        acc[ai][bj][m][1] = (f32x4){__uint_as_float(w.z << 16), __uint_as_float(w.z & 0xffff0000u), __uint_as_float(w.w << 16), __uint_as_float(w.w & 0xffff0000u)}; }
                    else { const float* p = xin + off; acc[ai][bj][m][0] = *(const f32x4*)p; acc[ai][bj][m][1] = *(const f32x4*)(p + 4); } }
    }
    __device__ __forceinline__ void operator()(const f32x4 (&acc)[2][2][4][2], const Unit& u, int wr, int wc, int fr, int fq, const LAS float* rtab) const {
        const int row0 = u.pm * BM + wr * 64 + fr, c0 = u.pn * BM + wc * 32 + fq * 8;
#pragma unroll
        for (int ai = 0; ai < 2; ++ai)
#pragma unroll
            for (int m = 0; m < 4; ++m) { const int row = row0 + ai * HALF + m * 16; float q = 0.f;
#pragma unroll
                for (int bj = 0; bj < 2; ++bj) { const size_t off = (size_t)row * 1024 + c0 + bj * HALF; const f32x4 a = acc[ai][bj][m][0], b = acc[ai][bj][m][1];
                    if (xo) { *(f32x4*)(xo + off) = a; *(f32x4*)(xo + off + 4) = b; } if (XB) *(u32x4*)(XB + off) = pack8(a, b); q += sum8sq(a, b);
                    if (XB8) *(u32x2*)(XB8 + off) = (u32x2){pk4_fp8(a.x, a.y, a.z, a.w), pk4_fp8(b.x, b.y, b.z, b.w)}; }
                q = add_xor<16>(q); q = add_xor<32>(q);
                if (fq == 0) SSQ16[(size_t)row * 16 + 4 * u.pn + wc] = q; }
    }
};
constexpr float ACT8_SC = 8.f;
template <bool MOE, bool OUT8 = false> struct EpiSwiglu {
    bf16_t* ACT; const float* RS; int arow0;
    int pre = 0; float wsc = 1.f;
    static constexpr bool NEEDS_RS = true, HAS_MID = false, HAS_INIT = false;
    __device__ __forceinline__ bool prefilled() const { return pre != 0; }
    __device__ __forceinline__ void rs_table(const Unit& u, LAS float* rtab) const {
        if constexpr (MOE) { const int tid = opaque_tid(); if ((tid & 1) == 0) rtab[tid >> 1] = RS[u.pm * BM + (tid >> 1)]; } else rs_fill<16>(RS, u.pm * BM, 1.f / 1024.f, rtab); }
    __device__ __forceinline__ void operator()(const f32x4 (&acc)[2][2][4][2], const Unit& u, int wr, int wc, int fr, int fq, const LAS float* rtab) const {
        const int row0 = u.pm * BM + wr * 64 + fr, c0 = u.pn * HALF + wc * 32 + fq * 8;
        const LAS float* rt = rtab + (pre ? 256 + ((pre == 2 ? u.k : u.pm) & 7) * 256 : 0) + wr * 64 + fr;
#pragma unroll
        for (int ai = 0; ai < 2; ++ai)
#pragma unroll
            for (int m = 0; m < 4; ++m) { const int row = row0 + ai * HALF + m * 16 - (MOE ? arow0 * BM : 0); const float s = RS_(ai, m) * wsc; f32x4 v[2];
#pragma unroll
                for (int n = 0; n < 2; ++n) { const f32x4 g = acc[ai][0][m][n] * s, up = acc[ai][1][m][n] * s; f32x4 sg; sg.x = sigmoidf_(g.x); sg.y = sigmoidf_(g.y); sg.z = sigmoidf_(g.z); sg.w = sigmoidf_(g.w); v[n] = g * sg * up; }
                if constexpr (OUT8) { v[0] *= ACT8_SC; v[1] *= ACT8_SC; *(u32x2*)((unsigned char*)ACT + (size_t)row * DFF + c0) = (u32x2){pk4_fp8(v[0].x, v[0].y, v[0].z, v[0].w), pk4_fp8(v[1].x, v[1].y, v[1].z, v[1].w)}; }
                else ST16(ACT + (size_t)row * DFF + c0, pack8(v[0], v[1])); }
    }
};
constexpr float Y8_SC = 16.f;
struct EpiY {
    bf16_t* Y; float osc = 1.f;
    static constexpr bool NEEDS_RS = false, HAS_MID = false, HAS_INIT = false;
    __device__ __forceinline__ void operator()(const f32x4 (&acc)[2][2][4][2], const Unit& u, int wr, int wc, int fr, int fq, const LAS float* rtab) const {
        const int row0 = u.pm * BM + wr * 64 + fr, c0 = u.pn * BM + wc * 32 + fq * 8;
#pragma unroll
        for (int ai = 0; ai < 2; ++ai)
#pragma unroll
            for (int m = 0; m < 4; ++m) { unsigned char* rp = (unsigned char*)Y + (size_t)(row0 + ai * HALF + m * 16) * 1024 + c0; const float sc = osc * Y8_SC;
#pragma unroll
                for (int bj = 0; bj < 2; ++bj) { const f32x4 a = acc[ai][bj][m][0] * sc, b = acc[ai][bj][m][1] * sc; *(u32x2*)(rp + bj * HALF) = (u32x2){pk4_fp8(a.x, a.y, a.z, a.w), pk4_fp8(b.x, b.y, b.z, b.w)}; } }
    }
};
struct EpiYPart {
    bf16_t* YP; int row_base; float osc = 1.f;
    static constexpr bool NEEDS_RS = false, HAS_MID = false, HAS_INIT = false;
    __device__ __forceinline__ void operator()(const f32x4 (&acc)[2][2][4][2], const Unit& u, int wr, int wc, int fr, int fq, const LAS float* rtab) const {
        const int row0 = u.pm * BM + wr * 64 + fr - row_base, c0 = (u.pn & 3) * BM + wc * 32 + fq * 8; bf16_t* base = YP + (size_t)(u.pn >> 2) * 2048 * 1024;
#pragma unroll
        for (int ai = 0; ai < 2; ++ai)
#pragma unroll
            for (int m = 0; m < 4; ++m) { bf16_t* rp = base + (size_t)(row0 + ai * HALF + m * 16) * 1024 + c0;
#pragma unroll
                for (int bj = 0; bj < 2; ++bj) *(u32x4*)(rp + bj * HALF) = pack8(acc[ai][bj][m][0] * osc, acc[ai][bj][m][1] * osc); }
    }
};
}

namespace att {
__device__ __forceinline__ int crow(int r, int hi) { return (r & 3) + 8 * (r >> 2) + 4 * hi; }
__device__ __forceinline__ void glds16(const void* gsrc, unsigned lds_dst) { unsigned keep;
    asm volatile("s_mov_b32 %0, m0\n\ts_mov_b32 m0, %2\n\ts_nop 0\n\tglobal_load_lds_dwordx4 %1, off\n\ts_mov_b32 m0, %0" : "=&s"(keep) : "v"(gsrc), "s"(lds_dst) : "memory"); }
#define ATT_RFL(x) ((unsigned)__builtin_amdgcn_readfirstlane((int)(x)))
#define ATT_WAIT_BAR(N) asm volatile("s_waitcnt vmcnt(" #N ") lgkmcnt(0)\n\ts_barrier" ::: "memory")
#define ATT_SBAR() __builtin_amdgcn_sched_barrier(0)
#define ATT_MFMA(a, b, c) __builtin_amdgcn_mfma_f32_32x32x16_bf16(a, b, c, 0, 0, 0)
typedef LAS const char* lds_cptr;
typedef short v4i16_t __attribute__((ext_vector_type(4)));
__device__ __forceinline__ bf16x8 ldsv(lds_cptr p) { return *(const LAS bf16x8*)p; }
#define ATT_TRI(lo_, hi_, base, off0, off1) do { asm volatile("ds_read_b64_tr_b16 %0, %1 offset:%c2" : "=&v"(lo_) : "v"(base), "i"(off0) : "memory"); \
    asm volatile("ds_read_b64_tr_b16 %0, %1 offset:%c2" : "=&v"(hi_) : "v"(base), "i"(off1) : "memory"); } while (0)
#define ATT_TRW() do { asm volatile("s_waitcnt lgkmcnt(0)" ::: "memory"); ATT_SBAR(); } while (0)
#define ATT_FR(lo_, hi_) ((bf16x8){lo_[0], lo_[1], lo_[2], lo_[3], hi_[0], hi_[1], hi_[2], hi_[3]})

__device__ __forceinline__ float rowmax32(const f32x16& p0, const f32x16& p1) {
    float a = fmaxf(fmaxf(p0[0], p0[1]), p1[0]), b = fmaxf(fmaxf(p0[2], p0[3]), p1[1]); a = fmaxf(fmaxf(a, p1[2]), p1[3]);
#pragma unroll
    for (int r = 4; r < 16; r += 4) { a = fmaxf(fmaxf(a, p0[r]), p0[r + 1]); b = fmaxf(fmaxf(b, p0[r + 2]), p0[r + 3]); a = fmaxf(fmaxf(a, p1[r]), p1[r + 1]); b = fmaxf(fmaxf(b, p1[r + 2]), p1[r + 3]); }
    const float m = fmaxf(a, b); auto rr = __builtin_amdgcn_permlane32_swap(__float_as_uint(m), __float_as_uint(m), false, false);
    return fmaxf(__uint_as_float(rr[0]), __uint_as_float(rr[1]));
}

template <int NS, bool BIAS, int NCH>
__device__ __forceinline__ void attn_unit2(int qb, const bf16_t* Qh, int qp, const bf16_t* KAh, int kap, const bf16_t* KBh, int kbp, const bf16_t* Vh, int vp, bf16_t* Oh, int op, const float* cumf, float kmax, LAS char* shm) {
    constexpr int NQ = BIAS ? NS - 1 : NS, NM = 2 * NS;
    constexpr int KSL = NCH * 1024, LDS_K = 0, LDS_V = 4 * KSL, LDS_WS = LDS_V + 3 * 8192, LDS_QX = LDS_WS + 8 * 256, LDS_OST = LDS_QX + 64;
    static_assert(LDS_OST + 8 * 4096 <= 131072 && (NM == 10 || NM == 12), "attention LDS / k-steps");
    const int tid = opaque_tid(), lane = tid & 63, r32 = lane & 31, hi = lane >> 5; const int wid = __builtin_amdgcn_readfirstlane(tid >> 6);
    const int q0 = qb * 256, NT = (q0 + 256) / 64;
    const bf16_t* Qw = Qh + (long)(q0 + wid * 32) * qp;
    const unsigned lds0 = (unsigned)(uintptr_t)shm;
    LAS float* wsf = (LAS float*)(shm + LDS_WS) + wid * 64;
    const bool hasB = wid < NCH - 8;
    const bf16_t* ksrcA = KAh + (long)lane * kap + wid * 8;
    const bf16_t* ksrcB = KBh + (long)lane * kbp + (BIAS ? 0 : wid * 8);
    const bf16_t* vsrc = Vh + (long)(16 * (wid & 3) + (lane >> 2)) * vp + (wid >> 2) * 32 + (lane & 3) * 8;
    const unsigned kdstA = lds0 + LDS_K + wid * 1024, kdstB = lds0 + LDS_K + (8 + wid) * 1024, vdst = lds0 + LDS_V + wid * 1024;
#define A2_TILE(s) ((s) < 4 ? NT - 4 + (s) : NT - 1 - (s))
#define A2_DMA_K(t, sb) do { glds16(ksrcA + (long)A2_TILE(t) * 64 * kap, ATT_RFL(kdstA + (sb))); if (hasB) glds16(ksrcB + (long)A2_TILE(t) * 64 * kbp, ATT_RFL(kdstB + (sb))); } while (0)
#define A2_DMA_V(t, sb) glds16(vsrc + (long)A2_TILE(t) * 64 * vp, ATT_RFL(vdst + (sb)))
#define A2_WB(a, b) do { if (hasB) { ATT_WAIT_BAR(b); } else { ATT_WAIT_BAR(a); } } while (0)
#define A2_KS(t) (((t) & 3) * KSL)
    const lds_cptr vp0 = (lds_cptr)shm + LDS_V + ((lane >> 4) & 1) * 32 + (lane & 3) * 8 + (4 * hi + ((lane & 15) >> 2)) * 64;
    const lds_cptr kp0 = (lds_cptr)shm + LDS_K + hi * 1024 + r32 * 16, kpb = (lds_cptr)shm + LDS_K + 8192 + r32 * 16;
    A2_DMA_K(0, 0); A2_DMA_V(0, 0); A2_DMA_K(1, KSL);
    bf16x8 qr[NS];
#pragma unroll
    for (int d0 = 0; d0 < NQ; ++d0) qr[d0] = *(const bf16x8*)(Qw + (long)r32 * qp + d0 * 16 + hi * 8);
    if constexpr (BIAS) { const short o1 = hi ? (short)0 : (short)0x3F80; qr[NS - 1] = (bf16x8){o1, o1, o1, 0, 0, 0, 0, 0}; }
    float mhat = 0.f, l_reg = 0.f; f32x16 o[2];
#pragma unroll
    for (int r = 0; r < 16; ++r) { o[0][r] = 0.f; o[1][r] = 0.f; }
    f32x16 negm;
#pragma unroll
    for (int r = 0; r < 16; ++r) negm[r] = 0.f;
    asm volatile("" : "+v"(negm));
    const int qrel = wid * 32 + r32; bool resc = false;
    f32x16 pA0, pA1, pB0, pB1; bf16x8 kf[4]; s16x4 vlo[8], vhi[8]; u32x4 pw0, pw1, pw2, pw3;
    int vs_prev = 0, vs_cur = 0, vs_next = 8192;
#define A2_ROT() do { vs_prev = vs_cur; vs_cur = vs_next; vs_next = (vs_next == 16384) ? 0 : vs_next + 8192; } while (0)
#define A2_KADDR(kq, kqb, j) ((BIAS && ((j) >> 1) == NS - 1) ? ((kqb) + ((j) & 1) * 512) : ((kq) + ((j) >> 1) * 2048 + ((j) & 1) * 512))
#define A2_CMASK(P0, P1, t) do { const int jb_ = (t) - (NT - 4); if (jb_ >= 0) { const int kb_ = 64 * jb_ + 4 * hi; \
        _Pragma("unroll") for (int r = 0; r < 16; ++r) { const int kv_ = kb_ + (r & 3) + 8 * (r >> 2); if (kv_ > qrel) P0[r] = -INFINITY; if (kv_ + 32 > qrel) P1[r] = -INFINITY; } } } while (0)
#define A2_RESC() do { if (resc) { asm volatile("s_waitcnt lgkmcnt(0)" ::: "memory"); \
        _Pragma("unroll") for (int d_ = 0; d_ < 2; ++d_) _Pragma("unroll") for (int r = 0; r < 16; ++r) o[d_][r] *= wsf[crow(r, hi)]; } } while (0)
    A2_DMA_K(2, 2 * KSL);
    if constexpr (BIAS) {
        float qs = 0.f;
#pragma unroll
        for (int d0 = 0; d0 < NQ; ++d0)
#pragma unroll
            for (int j = 0; j < 8; ++j) { const float v = bf2f((unsigned short)qr[d0][j]); qs += v * v; }
        { auto rr = __builtin_amdgcn_permlane32_swap(__float_as_uint(qs), __float_as_uint(qs), false, false); qs = __uint_as_float(rr[0]) + __uint_as_float(rr[1]); }
        qs = fmaxf(qs, __int_as_float(__builtin_amdgcn_ds_swizzle(__float_as_int(qs), (1 << 10) | 0x1F))); qs = fmaxf(qs, __int_as_float(__builtin_amdgcn_ds_swizzle(__float_as_int(qs), (2 << 10) | 0x1F)));
        qs = fmaxf(qs, __int_as_float(__builtin_amdgcn_ds_swizzle(__float_as_int(qs), (4 << 10) | 0x1F))); qs = fmaxf(qs, __int_as_float(__builtin_amdgcn_ds_swizzle(__float_as_int(qs), (8 << 10) | 0x1F)));
        qs = fmaxf(qs, __int_as_float(__builtin_amdgcn_ds_swizzle(__float_as_int(qs), (16 << 10) | 0x1F)));
        if (lane == 0) ((LAS float*)(shm + LDS_QX))[wid] = qs;
    }
    A2_WB(3, 5);
    int NSTEP = NT;
    if constexpr (BIAS) { if (NT > 4) {
        const LAS float* qx = (const LAS float*)(shm + LDS_QX); float qm = fmaxf(fmaxf(fmaxf(qx[0], qx[1]), fmaxf(qx[2], qx[3])), fmaxf(fmaxf(qx[4], qx[5]), fmaxf(qx[6], qx[7])));
        const float lim = cumf[q0] - 32.f - 2.f * __builtin_sqrtf(qm) * kmax * 1.0001f;
        const int T0 = lane, T1 = lane + 64; const bool c0 = (T0 < NT - 4) && (cumf[64 * T0 + 63] <= lim), c1 = (T1 < NT - 4) && (cumf[64 * T1 + 63] <= lim);
        const int nskip = (__popcll(__ballot(c0)) + __popcll(__ballot(c1))) & ~1; NSTEP = __builtin_amdgcn_readfirstlane(NT - nskip); } }
    { const lds_cptr kq_ = kp0, kqb_ = kpb;
#pragma unroll
      for (int j = 0; j < NM; ++j) { const bf16x8 f = ldsv(A2_KADDR(kq_, kqb_, j)); if (j & 1) pA1 = ATT_MFMA(f, qr[j >> 1], j < 2 ? negm : pA1); else pA0 = ATT_MFMA(f, qr[j >> 1], j < 2 ? negm : pA0); } }
    A2_CMASK(pA0, pA1, A2_TILE(0));
    { const float rm = rowmax32(pA0, pA1); mhat += rm;
#pragma unroll
      for (int r = 0; r < 16; ++r) { pA0[r] -= rm; pA1[r] -= rm; }
#pragma unroll
      for (int r = 0; r < 16; ++r) negm[r] = -mhat;
      asm volatile("" : "+v"(negm));
#pragma unroll
      for (int r = 0; r < 16; ++r) { pA0[r] = fexp2(pA0[r]); pA1[r] = fexp2(pA1[r]); } }
    ATT_WAIT_BAR(0);
    A2_DMA_K(3, 3 * KSL); A2_DMA_V(1, 8192);
    A2_ROT();
    { const lds_cptr kq_ = kp0 + A2_KS(1), kqb_ = kpb + A2_KS(1); kf[0] = ldsv(A2_KADDR(kq_, kqb_, 0)); kf[1] = ldsv(A2_KADDR(kq_, kqb_, 1)); kf[2] = ldsv(A2_KADDR(kq_, kqb_, 2)); }
#define A2_PKW(P, B) pk2(P[B], P[B + 1])
#define A2_PAF(k) __builtin_bit_cast(bf16x8, pw##k)
#define A2_VFR(i) ((bf16x8){vlo[i][0], vlo[i][1], vlo[i][2], vlo[i][3], vhi[i][0], vhi[i][1], vhi[i][2], vhi[i][3]})
#define A2_PIN(x) asm volatile("" : "+v"(x))
#define A2_VTR(p) __builtin_bit_cast(s16x4, __builtin_amdgcn_ds_read_tr16_b64_v4i16((LAS v4i16_t*)(p)))
#define A2_VRD(i) do { vlo[i] = A2_VTR(vp_ + (((i) >> 2) * 4096 + ((i) & 3) * 1024)); vhi[i] = A2_VTR(vp_ + (((i) >> 2) * 4096 + ((i) & 3) * 1024 + 512)); } while (0)
#define A2_KJ(j) do { if ((j) < NM) kf[(j) % 4] = ldsv(A2_KADDR(kq_, kqb_, (j))); } while (0)
#define A2_GAPA(MF, a0, a1, a2, a3, W0, W1, PW) do { MF; sacc += a0; sacc += a1; sacc += a2; sacc += a3; A2_PIN(sacc); W0; W1; A2_PIN(PW); ATT_SBAR(); } while (0)
#define A2_GAPB(MF, X, B) do { MF; X[B] = fexp2(X[B]); X[B + 1] = fexp2(X[B + 1]); X[B + 2] = fexp2(X[B + 2]); X[B + 3] = fexp2(X[B + 3]); A2_PIN(X); ATT_SBAR(); } while (0)
#define A2_MX3(a, b, c) __builtin_fmaxf(__builtin_fmaxf((a), (b)), (c))
#define A2_STEP(C0, C1, P0, P1, t, GK, GV, GL) do { ATT_SBAR(); \
    const lds_cptr vp_ = vp0 + vs_prev; const lds_cptr kq_ = kp0 + A2_KS(t), kqb_ = kpb + A2_KS(t); \
    A2_VRD(0); A2_KJ(3); ATT_SBAR(); float sacc = (P0[0] + P0[1]); \
    A2_GAPA(C0 = ATT_MFMA(kf[0], qr[0], negm), P0[2], P0[3], P0[4], P0[5],     pw0[0] = A2_PKW(P0, 0), pw0[1] = A2_PKW(P0, 2), pw0); \
    A2_VRD(4); A2_KJ(4); ATT_SBAR(); A2_GAPA(C1 = ATT_MFMA(kf[1], qr[0], negm), P0[6], P0[7], P0[8], P0[9],     pw0[2] = A2_PKW(P0, 4), pw0[3] = A2_PKW(P0, 6), pw0); \
    A2_VRD(1); A2_KJ(5); ATT_SBAR(); A2_GAPA(C0 = ATT_MFMA(kf[2], qr[1], C0),   P0[10], P0[11], P0[12], P0[13], pw1[0] = A2_PKW(P0, 8), pw1[1] = A2_PKW(P0, 10), pw1); \
    A2_VRD(5); A2_KJ(6); ATT_SBAR(); A2_GAPA(C1 = ATT_MFMA(kf[3], qr[1], C1),   P0[14], P0[15], P1[0], P1[1],   pw1[2] = A2_PKW(P0, 12), pw1[3] = A2_PKW(P0, 14), pw1); \
    A2_VRD(2); A2_KJ(7); ATT_SBAR(); A2_GAPA(C0 = ATT_MFMA(kf[0], qr[2], C0),   P1[2], P1[3], P1[4], P1[5],     pw2[0] = A2_PKW(P1, 0), pw2[1] = A2_PKW(P1, 2), pw2); \
    A2_VRD(6); A2_KJ(8); ATT_SBAR(); A2_GAPA(C1 = ATT_MFMA(kf[1], qr[2], C1),   P1[6], P1[7], P1[8], P1[9],     pw2[2] = A2_PKW(P1, 4), pw2[3] = A2_PKW(P1, 6), pw2); \
    A2_VRD(3); A2_KJ(9); ATT_SBAR(); A2_GAPA(C0 = ATT_MFMA(kf[2], qr[3], C0),   P1[10], P1[11], P1[12], P1[13], pw3[0] = A2_PKW(P1, 8), pw3[1] = A2_PKW(P1, 10), pw3); \
    A2_VRD(7); A2_KJ(10); ATT_SBAR(); A2_GAPA(C1 = ATT_MFMA(kf[3], qr[3], C1),  P1[14], P1[15], 0.f, 0.f,       pw3[2] = A2_PKW(P1, 12), pw3[3] = A2_PKW(P1, 14), pw3); \
    A2_KJ(11); ATT_SBAR(); C0 = ATT_MFMA(kf[0], qr[4], C0); ATT_SBAR(); \
    C1 = ATT_MFMA(kf[1], qr[4], C1); ATT_SBAR(); \
    if constexpr (NM > 10) { C0 = ATT_MFMA(kf[2], qr[NS - 1], C0); ATT_SBAR(); C1 = ATT_MFMA(kf[3], qr[NS - 1], C1); ATT_SBAR(); } \
    l_reg += sacc; \
    if (GK) { A2_DMA_K((t) + 3, A2_KS((t) + 3)); } if (GV) { A2_DMA_V((t) + 1, vs_next); } \
    A2_CMASK(C0, C1, A2_TILE(t)); \
    { float a = A2_MX3(C0[0], C0[1], C1[0]), b = A2_MX3(C0[2], C0[3], C1[1]); a = A2_MX3(a, C1[2], C1[3]); \
      _Pragma("unroll") for (int r = 4; r < 16; r += 4) { a = A2_MX3(a, C0[r], C0[r + 1]); b = A2_MX3(b, C0[r + 2], C0[r + 3]); a = A2_MX3(a, C1[r], C1[r + 1]); b = A2_MX3(b, C1[r + 2], C1[r + 3]); } \
      float rm = __builtin_fmaxf(a, b); { auto rr = __builtin_amdgcn_permlane32_swap(__float_as_uint(rm), __float_as_uint(rm), false, false); rm = __builtin_fmaxf(__uint_as_float(rr[0]), __uint_as_float(rr[1])); } \
      resc = false; \
      if (__builtin_expect(__any(rm > 8.f), 0)) { const float dl = __builtin_fmaxf(rm, 0.f); mhat += dl; \
        _Pragma("unroll") for (int r = 0; r < 16; ++r) { C0[r] -= dl; C1[r] -= dl; } \
        _Pragma("unroll") for (int r = 0; r < 16; ++r) negm[r] = -mhat; asm volatile("" : "+v"(negm)); \
        const float f = fexp2(-dl); l_reg *= f; if (hi == 0) wsf[r32] = f; resc = true; } } \
    ATT_SBAR(); \
    A2_GAPB(o[0] = ATT_MFMA(A2_PAF(0), A2_VFR(0), o[0]), C0, 0); \
    A2_GAPB(o[1] = ATT_MFMA(A2_PAF(0), A2_VFR(4), o[1]), C0, 4); \
    A2_GAPB(o[0] = ATT_MFMA(A2_PAF(1), A2_VFR(1), o[0]), C0, 8); \
    if (GL) { const lds_cptr kn_ = kp0 + A2_KS((t) + 1), knb_ = kpb + A2_KS((t) + 1); kf[0] = ldsv(A2_KADDR(kn_, knb_, 0)); kf[1] = ldsv(A2_KADDR(kn_, knb_, 1)); kf[2] = ldsv(A2_KADDR(kn_, knb_, 2)); ATT_SBAR(); } \
    A2_GAPB(o[1] = ATT_MFMA(A2_PAF(1), A2_VFR(5), o[1]), C0, 12); \
    A2_GAPB(o[0] = ATT_MFMA(A2_PAF(2), A2_VFR(2), o[0]), C1, 0); \
    A2_GAPB(o[1] = ATT_MFMA(A2_PAF(2), A2_VFR(6), o[1]), C1, 4); \
    A2_GAPB(o[0] = ATT_MFMA(A2_PAF(3), A2_VFR(3), o[0]), C1, 8); \
    A2_GAPB(o[1] = ATT_MFMA(A2_PAF(3), A2_VFR(7), o[1]), C1, 12); \
    } while (0)
    int t = 1;
    for (; t + 5 < NSTEP; t += 2) {
        A2_STEP(pB0, pB1, pA0, pA1, t, true, true, true);     A2_WB(2, 3); A2_RESC(); A2_ROT();
        A2_STEP(pA0, pA1, pB0, pB1, t + 1, true, true, true); A2_WB(2, 3); A2_RESC(); A2_ROT();
    }
#define A2_ENDW(tt) do { if ((tt) + 3 < NSTEP) { A2_WB(2, 3); } else if ((tt) + 2 < NSTEP) { ATT_WAIT_BAR(1); } else { ATT_WAIT_BAR(0); } } while (0)
    for (; t + 1 < NSTEP; t += 2) {
        A2_STEP(pB0, pB1, pA0, pA1, t, (t + 3 < NSTEP), (t + 1 < NSTEP), (t + 1 < NSTEP));         A2_ENDW(t);     A2_RESC(); A2_ROT();
        A2_STEP(pA0, pA1, pB0, pB1, t + 1, (t + 4 < NSTEP), (t + 2 < NSTEP), (t + 2 < NSTEP));     A2_ENDW(t + 1); A2_RESC(); A2_ROT();
    }
    A2_STEP(pB0, pB1, pA0, pA1, NSTEP - 1, false, false, false); A2_RESC();
    { float sacc = pB0[0] + pB0[1];
#pragma unroll
      for (int r = 2; r < 16; ++r) sacc += pB0[r];
#pragma unroll
      for (int r = 0; r < 16; ++r) sacc += pB1[r];
      l_reg += sacc;
      pw0 = (u32x4){A2_PKW(pB0, 0), A2_PKW(pB0, 2), A2_PKW(pB0, 4), A2_PKW(pB0, 6)}; pw1 = (u32x4){A2_PKW(pB0, 8), A2_PKW(pB0, 10), A2_PKW(pB0, 12), A2_PKW(pB0, 14)};
      pw2 = (u32x4){A2_PKW(pB1, 0), A2_PKW(pB1, 2), A2_PKW(pB1, 4), A2_PKW(pB1, 6)}; pw3 = (u32x4){A2_PKW(pB1, 8), A2_PKW(pB1, 10), A2_PKW(pB1, 12), A2_PKW(pB1, 14)};
      const lds_cptr vp_ = vp0 + vs_cur;
#pragma unroll
      for (int i = 0; i < 8; ++i) A2_VRD(i);
      o[0] = ATT_MFMA(A2_PAF(0), A2_VFR(0), o[0]); o[1] = ATT_MFMA(A2_PAF(0), A2_VFR(4), o[1]); o[0] = ATT_MFMA(A2_PAF(1), A2_VFR(1), o[0]); o[1] = ATT_MFMA(A2_PAF(1), A2_VFR(5), o[1]);
      o[0] = ATT_MFMA(A2_PAF(2), A2_VFR(2), o[0]); o[1] = ATT_MFMA(A2_PAF(2), A2_VFR(6), o[1]); o[0] = ATT_MFMA(A2_PAF(3), A2_VFR(3), o[0]); o[1] = ATT_MFMA(A2_PAF(3), A2_VFR(7), o[1]); }
    { auto rr = __builtin_amdgcn_permlane32_swap(__float_as_uint(l_reg), __float_as_uint(l_reg), false, false); l_reg = __uint_as_float(rr[0]) + __uint_as_float(rr[1]); }
    if (hi == 0) wsf[32 + r32] = l_reg;
    asm volatile("s_waitcnt lgkmcnt(0)" ::: "memory");
    float rli[16];
#pragma unroll
    for (int r = 0; r < 16; ++r) rli[r] = __builtin_amdgcn_rcpf(wsf[32 + crow(r, hi)]);
    bf16_t* Ow = Oh + (long)(q0 + wid * 32) * op;
    { LAS bf16_t* stg = (LAS bf16_t*)(shm + LDS_OST) + wid * 2048;
#pragma unroll
        for (int r = 0; r < 16; ++r) { const int orow = crow(r, hi);
#pragma unroll
            for (int d0 = 0; d0 < 2; ++d0) stg[orow * 64 + d0 * 32 + r32] = f2bf(o[d0][r] * rli[r]); }
        asm volatile("s_waitcnt lgkmcnt(0)" ::: "memory");
#pragma unroll
        for (int i = 0; i < 4; ++i) { const int row = i * 8 + (lane >> 3), ch = lane & 7; const u32x4 v = *(const LAS u32x4*)(stg + row * 64 + ch * 8); *(u32x4*)(Ow + (long)row * op + ch * 8) = v; } }
    asm volatile("s_waitcnt lgkmcnt(0)\n\ts_barrier" ::: "memory");
#undef A2_TILE
#undef A2_DMA_K
#undef A2_DMA_V
#undef A2_WB
#undef A2_KS
#undef A2_ROT
#undef A2_KADDR
#undef A2_CMASK
#undef A2_RESC
#undef A2_PKW
#undef A2_PAF
#undef A2_VFR
#undef A2_PIN
#undef A2_VTR
#undef A2_VRD
#undef A2_KJ
#undef A2_GAPA
#undef A2_GAPB
#undef A2_MX3
#undef A2_STEP
#undef A2_ENDW
}

__device__ __forceinline__ void tstate_run(int u0, int stride, int n, const bf16_t* KG, const bf16_t* RV, float* T, LAS char* shm) {
    const int tid = opaque_tid(), lane = tid & 63, r32 = lane & 31, hi = lane >> 5; const int wid = __builtin_amdgcn_readfirstlane(tid >> 6);
    const unsigned lds0 = (unsigned)(uintptr_t)shm;
    const int dblk = wid >> 2, db = wid & 3;
#define TS_DMA(u, buf) do { const int bh_ = (u) >> 6, c_ = (u) & 63; const long row0_ = (long)(bh_ >> 3) * SEQ + (long)c_ * 128; const int h_ = bh_ & 7; \
    _Pragma("unroll") for (int i = 0; i < 2; ++i) { const int kp = wid * 2 + i, c8 = kp >> 1, rh = kp & 1; glds16(KG + (row0_ + 64 * rh + lane) * 512 + h_ * 64 + 8 * c8, ATT_RFL(lds0 + (buf) * 49152 + c8 * 2048 + rh * 1024)); } \
    _Pragma("unroll") for (int i = 0; i < 4; ++i) { const int vp = wid * 4 + i, db_ = vp >> 3, j = vp & 7; glds16(RV + (row0_ + 16 * j + (lane >> 2)) * 1024 + h_ * 128 + 32 * db_ + (lane & 3) * 8, ATT_RFL(lds0 + (buf) * 49152 + 16384 + db_ * 8192 + j * 1024)); } } while (0)
    if (n <= 0) return;
    TS_DMA(u0, 0);
    for (int k = 0; k < n; ++k) {
        const int u = u0 + k * stride, buf = k & 1;
        if (k + 1 < n) { TS_DMA(u + stride, buf ^ 1); ATT_WAIT_BAR(6); } else ATT_WAIT_BAR(0);
        const int ab = (int)lds0 + buf * 49152 + (4 * dblk + 2 * ((lane >> 4) & 1) + ((lane & 3) >> 1)) * 2048 + (8 * hi + ((lane & 15) >> 2)) * 16 + (lane & 1) * 8;
        const int vb = (int)lds0 + buf * 49152 + 16384 + db * 8192 + (8 * hi + ((lane & 15) >> 2)) * 64 + ((lane >> 4) & 1) * 32 + (lane & 3) * 8;
        f32x16 acc;
#pragma unroll
        for (int r = 0; r < 16; ++r) acc[r] = 0.f;
#pragma unroll
        for (int ks = 0; ks < 8; ks += 2) { s16x4 al0, ah0, bl0, bh0, al1, ah1, bl1, bh1;
            ATT_TRI(al0, ah0, ab, ks * 256, ks * 256 + 64); ATT_TRI(bl0, bh0, vb, ks * 1024, ks * 1024 + 256); ATT_TRI(al1, ah1, ab, ks * 256 + 256, ks * 256 + 320); ATT_TRI(bl1, bh1, vb, ks * 1024 + 1024, ks * 1024 + 1280);
            ATT_TRW(); acc = ATT_MFMA(ATT_FR(al0, ah0), ATT_FR(bl0, bh0), acc); acc = ATT_MFMA(ATT_FR(al1, ah1), ATT_FR(bl1, bh1), acc); }
        float* Tp = T + ((size_t)u * 64 + 32 * dblk) * 128 + 32 * db + r32;
#pragma unroll
        for (int r = 0; r < 16; ++r) Tp[(size_t)crow(r, hi) * 128] = acc[r];
        asm volatile("s_waitcnt lgkmcnt(0)\n\ts_barrier" ::: "memory");
    }
#undef TS_DMA
}

__device__ __forceinline__ void ret_unit(int bh, int cp, const bf16_t* RQ, const bf16_t* KG, const bf16_t* RV, const bf16_t* RP, const bf16_t* RG, const float* gnw, bf16_t* OR, LAS char* shm) {
    const int tid = opaque_tid(), lane = tid & 63, r32 = lane & 31, hi = lane >> 5; const int wid = __builtin_amdgcn_readfirstlane(tid >> 6);
    const int hw = wid >> 2, wq = wid & 3, b = bh >> 3, h = bh & 7, c = 2 * cp + hw; const long row0 = (long)b * SEQ + (long)c * 128;
    const unsigned lds0 = (unsigned)(uintptr_t)shm + hw * 65536u;
    bf16x8 qr[4];
#pragma unroll
    for (int d0 = 0; d0 < 4; ++d0) qr[d0] = *(const bf16x8*)(RQ + (row0 + 32 * wq + r32) * 512 + h * 64 + 16 * d0 + 8 * hi);
#pragma unroll
    for (int i = 0; i < 4; ++i) { const int kp = wq * 4 + i, c8 = kp >> 1, rh = kp & 1; glds16(KG + (row0 + 64 * rh + lane) * 512 + h * 64 + 8 * c8, ATT_RFL(lds0 + c8 * 2048 + rh * 1024)); }
#pragma unroll
    for (int i = 0; i < 8; ++i) { const int vp = wq * 8 + i, db = vp >> 3, j = vp & 7; glds16(RV + (row0 + 16 * j + (lane >> 2)) * 1024 + h * 128 + 32 * db + (lane & 3) * 8, ATT_RFL(lds0 + 16384 + db * 8192 + j * 1024)); }
#pragma unroll
    for (int i = 0; i < 4; ++i) { const int rp = wq * 4 + i, db = rp >> 2, j = rp & 3; glds16(RP + ((size_t)(bh * 64 + c) * 64 + 16 * j + (lane >> 2)) * 128 + 32 * db + (lane & 3) * 8, ATT_RFL(lds0 + 49152 + db * 4096 + j * 1024)); }
    float gw[4];
#pragma unroll
    for (int db = 0; db < 4; ++db) gw[db] = gnw[h * 128 + 32 * db + r32];
    u32x4 gq[8];
#pragma unroll
    for (int i = 0; i < 8; ++i) { const int row = i * 4 + (lane >> 4), ch = lane & 15; gq[i] = *(const u32x4*)(RG + (size_t)(row0 + 32 * wq + row) * 1024 + h * 128 + ch * 8); }
    ATT_WAIT_BAR(0);
    f32x16 o[4];
#pragma unroll
    for (int d = 0; d < 4; ++d)
#pragma unroll
        for (int r = 0; r < 16; ++r) o[d][r] = 0.f;
    const lds_cptr kbase = (lds_cptr)shm + hw * 65536 + hi * 2048 + r32 * 16;
    const int vb0 = (int)lds0 + 16384 + ((lane >> 4) & 1) * 32 + (lane & 3) * 8 + (4 * hi + ((lane & 15) >> 2)) * 64;
    for (int kt = 0; kt <= wq; ++kt) {
        f32x16 p;
#pragma unroll
        for (int r = 0; r < 16; ++r) p[r] = 0.f;
#pragma unroll
        for (int d0 = 0; d0 < 4; ++d0) p = ATT_MFMA(ldsv(kbase + d0 * 4096 + kt * 512), qr[d0], p);
        if (kt == wq) {
#pragma unroll
            for (int r = 0; r < 16; ++r) if (crow(r, hi) > r32) p[r] = 0.f; }
        const u32x4 pw0 = {pk2(p[0], p[1]), pk2(p[2], p[3]), pk2(p[4], p[5]), pk2(p[6], p[7])}, pw1 = {pk2(p[8], p[9]), pk2(p[10], p[11]), pk2(p[12], p[13]), pk2(p[14], p[15])};
        const int vb = vb0 + kt * 2048;
        { s16x4 l0[4], h0[4], l1[4], h1[4];
#pragma unroll
          for (int db = 0; db < 4; ++db) { ATT_TRI(l0[db], h0[db], vb, db * 8192, db * 8192 + 512); ATT_TRI(l1[db], h1[db], vb, db * 8192 + 1024, db * 8192 + 1536); }
          ATT_TRW();
#pragma unroll
          for (int db = 0; db < 4; ++db) { o[db] = ATT_MFMA(__builtin_bit_cast(bf16x8, pw0), ATT_FR(l0[db], h0[db]), o[db]); o[db] = ATT_MFMA(__builtin_bit_cast(bf16x8, pw1), ATT_FR(l1[db], h1[db]), o[db]); } }
    }
    { const int rb = (int)lds0 + 49152 + ((lane >> 4) & 1) * 32 + (lane & 3) * 8 + (8 * hi + ((lane & 15) >> 2)) * 64;
#pragma unroll
        for (int dp = 0; dp < 4; dp += 2) { s16x4 l0[2], h0[2], l1[2], h1[2], l2[2], h2[2], l3[2], h3[2];
#pragma unroll
            for (int e = 0; e < 2; ++e) { const int db = dp + e; ATT_TRI(l0[e], h0[e], rb, db * 4096, db * 4096 + 256); ATT_TRI(l1[e], h1[e], rb, db * 4096 + 1024, db * 4096 + 1280); ATT_TRI(l2[e], h2[e], rb, db * 4096 + 2048, db * 4096 + 2304); ATT_TRI(l3[e], h3[e], rb, db * 4096 + 3072, db * 4096 + 3328); }
            ATT_TRW();
#pragma unroll
            for (int e = 0; e < 2; ++e) { const int db = dp + e; o[db] = ATT_MFMA(qr[0], ATT_FR(l0[e], h0[e]), o[db]); o[db] = ATT_MFMA(qr[1], ATT_FR(l1[e], h1[e]), o[db]); o[db] = ATT_MFMA(qr[2], ATT_FR(l2[e], h2[e]), o[db]); o[db] = ATT_MFMA(qr[3], ATT_FR(l3[e], h3[e]), o[db]); } } }
    asm volatile("s_waitcnt lgkmcnt(0)\n\ts_barrier" ::: "memory");
    const float lg = lg2gamma(h);
    float s1[16], s2[16];
#pragma unroll
    for (int r = 0; r < 16; ++r) { const int n = 32 * wq + crow(r, hi); const float g = fexp2((float)n * lg);
        o[0][r] *= g; o[1][r] *= g; o[2][r] *= g; o[3][r] *= g; s1[r] = (o[0][r] + o[1][r]) + (o[2][r] + o[3][r]); }
#pragma unroll
    for (int r = 0; r < 16; ++r) s1[r] = add_xor<1>(s1[r]);
#pragma unroll
    for (int r = 0; r < 16; ++r) s1[r] = add_xor<2>(s1[r]);
#pragma unroll
    for (int r = 0; r < 16; ++r) s1[r] = add_xor<4>(s1[r]);
#pragma unroll
    for (int r = 0; r < 16; ++r) s1[r] = add_xor<8>(s1[r]);
#pragma unroll
    for (int r = 0; r < 16; ++r) s1[r] = add_xor<16>(s1[r]);
#pragma unroll
    for (int r = 0; r < 16; ++r) { const float mu = s1[r] * (1.f / 128.f); o[0][r] -= mu; o[1][r] -= mu; o[2][r] -= mu; o[3][r] -= mu; s2[r] = (o[0][r] * o[0][r] + o[1][r] * o[1][r]) + (o[2][r] * o[2][r] + o[3][r] * o[3][r]); }
#pragma unroll
    for (int r = 0; r < 16; ++r) s2[r] = add_xor<1>(s2[r]);
#pragma unroll
    for (int r = 0; r < 16; ++r) s2[r] = add_xor<2>(s2[r]);
#pragma unroll
    for (int r = 0; r < 16; ++r) s2[r] = add_xor<4>(s2[r]);
#pragma unroll
    for (int r = 0; r < 16; ++r) s2[r] = add_xor<8>(s2[r]);
#pragma unroll
    for (int r = 0; r < 16; ++r) s2[r] = add_xor<16>(s2[r]);
    { LAS bf16_t* stg = (LAS bf16_t*)shm + wid * 4096;
#pragma unroll
      for (int r = 0; r < 16; ++r) { const float rstd = __builtin_amdgcn_rsqf(s2[r] * (1.f / 128.f) + EPS); const int orow = crow(r, hi);
#pragma unroll
          for (int db = 0; db < 4; ++db) stg[orow * 128 + db * 32 + r32] = f2bf(o[db][r] * rstd * gw[db]); }
      asm volatile("s_waitcnt lgkmcnt(0)" ::: "memory");
#pragma unroll
      for (int i = 0; i < 8; ++i) { const int row = i * 4 + (lane >> 4), ch = lane & 15; const u32x4 v = *(const LAS u32x4*)(stg + row * 128 + ch * 8);
          const size_t grow = (size_t)(row0 + 32 * wq + row); const u32x4 g = gq[i];
          u32x4 w;
          w.x = pk2(__uint_as_float(v.x << 16) * __uint_as_float(g.x << 16), __uint_as_float(v.x & 0xffff0000u) * __uint_as_float(g.x & 0xffff0000u));
          w.y = pk2(__uint_as_float(v.y << 16) * __uint_as_float(g.y << 16), __uint_as_float(v.y & 0xffff0000u) * __uint_as_float(g.y & 0xffff0000u));
          w.z = pk2(__uint_as_float(v.z << 16) * __uint_as_float(g.z << 16), __uint_as_float(v.z & 0xffff0000u) * __uint_as_float(g.z & 0xffff0000u));
          w.w = pk2(__uint_as_float(v.w << 16) * __uint_as_float(g.w << 16), __uint_as_float(v.w & 0xffff0000u) * __uint_as_float(g.w & 0xffff0000u));
          *(u32x4*)(OR + grow * 2048 + 512 + h * 128 + ch * 8) = w; } }
    asm volatile("s_waitcnt lgkmcnt(0)\n\ts_barrier" ::: "memory");
}
}

constexpr size_t MiB = 1u << 20;
constexpr size_t WS_CTL = 0, CTL_ZERO_BYTES = 64 * 1024;
constexpr size_t WS_SSQ16 = 1 * MiB;
constexpr size_t WS_TAB64 = 2 * MiB, WS_TAB32 = 4 * MiB;
constexpr size_t WS_SSQC = 5 * MiB, WS_SSQK = 6 * MiB, WS_LOGF = 6 * MiB + 512 * 1024;
constexpr size_t WS_SEL = 7 * MiB, WS_SLOT = 7 * MiB + 256 * 1024, WS_CNT = 7 * MiB + 384 * 1024, WS_RSL = 7 * MiB + 512 * 1024;
constexpr size_t WS_CUMB = 8 * MiB, WS_KR = 10 * MiB, WS_CUMF = 11 * MiB  ;
constexpr int CW_KMSQ = 8448;
constexpr int CW_QCTR = 8192;
constexpr size_t WS_WIN = 12 * MiB, WIN_STRIDE = (size_t)NP1 * 1024 * 2;
constexpr size_t WS_WUQ = 45 * MiB, WS_WUKV = 47 * MiB, WS_WBCAT = 48 * MiB  , WS_WOUT = 56 * MiB, WS_WGU = 60 * MiB, WS_WDN = 74 * MiB;
constexpr size_t WS_XB = 81 * MiB;
constexpr size_t WS_FQ = 113 * MiB, WS_FK = 129 * MiB, WS_FV = 145 * MiB, WS_RQ = 161 * MiB, WS_KG = 177 * MiB, WS_RV = 193 * MiB, WS_RG = 225 * MiB, WS_GATES = 257 * MiB;
constexpr size_t WS_ACT = 225 * MiB;
constexpr size_t WS_CQ = 353 * MiB, WS_CKV = 365 * MiB;
constexpr size_t WS_MQ = 373 * MiB, WS_KN = 397 * MiB, WS_MV = 413 * MiB, WS_T = 429 * MiB, WS_OCAT = 429 * MiB, WS_X1B = 461 * MiB, WS_RP = 493 * MiB;
constexpr size_t WS_ACTM1 = (size_t)371 * MiB;
constexpr size_t WS_ACTM = 81 * MiB  , WS_YP = 150 * MiB  , WS_HS = 180 * MiB, WS_Y = 248 * MiB;
constexpr size_t WS_XB8 = 509 * MiB  , WS_WGL8 = 525 * MiB  , WS_END = 531 * MiB;

constexpr int RING_BYTES = 131072, MISC_OFF = RING_BYTES, LDS_BYTES = 147456;

#define RLX_AGENT __ATOMIC_RELAXED, __HIP_MEMORY_SCOPE_AGENT
#define XB_TMO      128
#define XB_XCNT(j)  (256  + 64 * (j))
#define XB_XSUB(j)  (1280 + 64 * (j))
#define XB_XGEN(j)  (2304 + 64 * (j))
#define XB_TOP      3328
#define XB_TOPGEN   3392
#define XCD_BAR_WORDS 3456
#define XB_SPIN_CAP (1u << 18)
__device__ __forceinline__ unsigned xb_ld(unsigned* p)              { return __hip_atomic_load(p, __ATOMIC_RELAXED, __HIP_MEMORY_SCOPE_AGENT); }
__device__ __forceinline__ unsigned xb_add(unsigned* p, unsigned v) { return __hip_atomic_fetch_add(p, v, __ATOMIC_RELAXED, __HIP_MEMORY_SCOPE_AGENT); }
__device__ __forceinline__ unsigned xb_xcc_id() { return (unsigned)__builtin_amdgcn_s_getreg((3 << 11) | 20) & 0xFu; }
#define XB_SPIN(cond, bar) do { unsigned _sp = 0; while (cond) { __builtin_amdgcn_s_sleep(1); \
    if ((++_sp & 255u) == 0u) { if (xb_ld(&(bar)[XB_TMO])) break; if (_sp > XB_SPIN_CAP) { atomicAdd(&(bar)[XB_TMO], 1u); break; } } } } while (0)
struct XcdBarrier { unsigned* bar; unsigned x; volatile LAS unsigned* st; };
__device__ __forceinline__ XcdBarrier xcd_barrier_post(unsigned* bar, volatile LAS unsigned* st) {
    XcdBarrier b; b.bar = bar; b.x = xb_xcc_id(); b.st = st;
    if (threadIdx.x == 0) (void)xb_add(&bar[XB_XCNT(b.x)], 1u);
    return b;
}
__device__ __forceinline__ void xcd_barrier_complete(unsigned* bar, unsigned x, unsigned& nloc, unsigned& nx) {
    const unsigned G = gridDim.x * gridDim.y * gridDim.z;
    unsigned sum, cnt, mine, sp = 0u;
    for (;;) {
        sum = 0u; cnt = 0u; mine = 0u;
#pragma unroll
        for (unsigned j = 0; j < 16; ++j) { const unsigned c = xb_ld(&bar[XB_XCNT(j)]); sum += c; cnt += (c > 0u) ? 1u : 0u; mine = (j == x) ? c : mine; }
        if (sum == G) break;
        __builtin_amdgcn_s_sleep(1);
        if ((++sp & 255u) == 0u) { if (xb_ld(&bar[XB_TMO])) break; if (sp > XB_SPIN_CAP) { atomicAdd(&bar[XB_TMO], 1u); break; } }
    }
    nloc = mine > 0u ? mine : 1u; nx = cnt > 0u ? cnt : 1u;
}
__device__ __forceinline__ void xcd_barrier(const XcdBarrier& b) {
    asm volatile("s_waitcnt vmcnt(0)" ::: "memory");
    __syncthreads();
    if (threadIdx.x == 0) {
        unsigned* bar = b.bar;
        __builtin_amdgcn_s_waitcnt(0);
        unsigned nloc = b.st[0], nx = b.st[1];
        if (nloc == 0u) { xcd_barrier_complete(bar, b.x, nloc, nx); b.st[0] = nloc; b.st[1] = nx; }
        const unsigned old = xb_add(&bar[XB_XSUB(b.x)], 1u);
        const unsigned gen = old / nloc;
        if (old + 1u == (gen + 1u) * nloc) {
            __builtin_amdgcn_fence(__ATOMIC_RELEASE, "agent");
            asm volatile("s_waitcnt vmcnt(0)" ::: "memory");
            const unsigned og = xb_add(&bar[XB_TOP], 1u);
            const unsigned tg = og / nx;
            if (og + 1u == (tg + 1u) * nx) xb_add(&bar[XB_TOPGEN], 1u);
            else XB_SPIN(xb_ld(&bar[XB_TOPGEN]) == tg, bar);
            __builtin_amdgcn_fence(__ATOMIC_ACQUIRE, "agent");
            xb_add(&bar[XB_XGEN(b.x)], 1u);
            asm volatile("s_waitcnt vmcnt(0)" ::: "memory");
        } else {
            XB_SPIN(xb_ld(&bar[XB_XGEN(b.x)]) == gen, bar);
            __builtin_amdgcn_fence(__ATOMIC_ACQUIRE, "agent");
            asm volatile("s_waitcnt vmcnt(0)" ::: "memory");
        }
    }
    __syncthreads();
}

#define LDS_WAIT() asm volatile("s_waitcnt lgkmcnt(0)" ::: "memory")
__device__ __forceinline__ float wave_sum(float v) { v = add_xor<1>(v); v = add_xor<2>(v); v = add_xor<4>(v); v = add_xor<8>(v); v = add_xor<16>(v); return add_xor<32>(v); }
__device__ __forceinline__ int rp64(int j) { const int head = j >> 6, d = j & 63, i = d & 31, x2 = d >> 5; return 64 * head + 8 * (i >> 2) + 4 * x2 + (i & 3); }
__device__ __forceinline__ int rp32(int d) { const int i = d & 15, x2 = d >> 4; return 8 * (i >> 2) + 4 * x2 + (i & 3); }
template <int KIND> __device__ __forceinline__ int map_col(int j) {
    if (KIND == 0) return j;
    if (KIND == 1) {
        if (j < 1536) return j;
        if (j < 1544) return 8352 + (j - 1536);
        if (j < 2056) return 1536 + rp64(j - 1544);
        if (j < 2568) return 2048 + rp64(j - 2056);
        if (j < 3592) return 2560 + (j - 2568);
        if (j < 4616) return 3584 + (j - 3592);
        if (j < 5000) return 7680 + (j - 4616);
        if (j < 5256) return 8064 + (j - 5000);
        if (j < 5288) return 8320 + rp32(j - 5256);
        return 4608 + (j - 5288);
    }
    if (KIND == 2) { const int head = j / 96, d = j - 96 * head; return d < 64 ? 96 * head + d : 96 * head + 64 + rp32(d - 64); }
    if (KIND == 3) return 256 * (j >> 7) + (j & 127);
    return 256 * (j >> 7) + 128 + (j & 127);
}
template <int KIND> __device__ __forceinline__ void tr_item(const float* W, int ldw, int ncols, int K, const float* ksc, bf16_t* WT, int ldk, int koff, int row_off, LAS unsigned* scr, int item, int lane) {
    const int nblk = (ncols + 63) >> 6, kb = item / nblk, nb = item - kb * nblk, k0 = 64 * kb, n0 = 64 * nb, col = n0 + lane; const bool ok = col < ncols;
    const float* src = W + (size_t)k0 * ldw + (ok ? col : 0);
    float v[64];
#pragma unroll
    for (int i = 0; i < 64; ++i) v[i] = src[(size_t)i * ldw];
    if (ksc) {
#pragma unroll
        for (int i = 0; i < 64; ++i) v[i] *= ksc[k0 + i]; }
#pragma unroll
    for (int i = 0; i < 32; ++i) scr[lane * 34 + i] = pk2(v[2 * i], v[2 * i + 1]);
    LDS_WAIT(); asm volatile("" ::: "memory");
    const int c = lane & 7;
#pragma unroll
    for (int j = 0; j < 8; ++j) { const int n = (lane >> 3) + 8 * j; const u32x2 a = *(const LAS u32x2*)(scr + n * 34 + c * 4), b = *(const LAS u32x2*)(scr + n * 34 + c * 4 + 2);
        if (n0 + n < ncols) *(u32x4*)(WT + (size_t)(row_off + map_col<KIND>(n0 + n)) * ldk + koff + k0 + 8 * c) = (u32x4){a.x, a.y, b.x, b.y}; }
    LDS_WAIT(); asm volatile("" ::: "memory");
}
template <int KIND> __device__ __forceinline__ void tr8_item(const float* W, int ldw, int ncols, int K, const float* ksc, unsigned char* WT8, LAS unsigned* scr, int item, int lane) {
    const int nblk = (ncols + 63) >> 6, kb = item / nblk, nb = item - kb * nblk, k0 = 64 * kb, n0 = 64 * nb, col = n0 + lane; const bool ok = col < ncols;
    const float* src = W + (size_t)k0 * ldw + (ok ? col : 0);
    float v[64];
#pragma unroll
    for (int i = 0; i < 64; ++i) v[i] = src[(size_t)i * ldw];
#pragma unroll
    for (int i = 0; i < 64; ++i) v[i] *= ksc ? ksc[k0 + i] * 32.f : 32.f;
#pragma unroll
    for (int i = 0; i < 16; ++i) scr[lane * 18 + i] = pk4_fp8(v[4 * i], v[4 * i + 1], v[4 * i + 2], v[4 * i + 3]);
    LDS_WAIT(); asm volatile("" ::: "memory");
    const int c = lane & 3;
#pragma unroll
    for (int j = 0; j < 4; ++j) { const int n = (lane >> 2) + 16 * j; const u32x2 a = *(const LAS u32x2*)(scr + n * 18 + c * 4), b = *(const LAS u32x2*)(scr + n * 18 + c * 4 + 2);
        if (n0 + n < ncols) *(u32x4*)(WT8 + (size_t)map_col<KIND>(n0 + n) * K + k0 + 16 * c) = (u32x4){a.x, a.y, b.x, b.y}; }
    LDS_WAIT(); asm volatile("" ::: "memory");
}
struct MoeCvtItem { const char* src; const float* ksc; unsigned char* dst; int ldw, K, k0, n0, job; };
__device__ __forceinline__ MoeCvtItem moe_cvt_item(const float* wg, const float* wu, const float* wd, const float* gain, unsigned char* ws, int g, int lane) {
    MoeCvtItem it; const int e = g / 2688, r = g - e * 2688, job = r / 896, i = r - job * 896; it.job = job;
    if (job < 2) { const int kb = i / 56, nb = i - kb * 56; it.k0 = 64 * kb; it.n0 = 64 * nb; it.ldw = DFF; it.K = 1024; it.ksc = gain; it.dst = ws + pg8::moe_gu_base(e);
        it.src = (const char*)((job == 0 ? wg : wu) + (size_t)e * 1024 * DFF + (size_t)it.k0 * DFF + it.n0); }
    else { const int kb = i >> 4, nb = i & 15; it.k0 = 64 * kb; it.n0 = 64 * nb; it.ldw = 1024; it.K = DFF; it.ksc = nullptr; it.dst = ws + pg8::moe_dn_base(e);
        it.src = (const char*)(wd + (size_t)e * DFF * 1024 + (size_t)it.k0 * 1024 + it.n0); }
    return it;
}
__device__ __forceinline__ void moe_cvt_load(float (&v)[64], const MoeCvtItem& it, int lane) {
    const unsigned step = (unsigned)it.ldw * 4u; const __amdgpu_buffer_rsrc_t rs = __builtin_amdgcn_make_buffer_rsrc((void*)it.src, (short)0, (int)(64u * step), 0x00020000); const int vo = lane * 4;
#pragma unroll
    for (int i = 0; i < 64; ++i) v[i] = __uint_as_float(__builtin_amdgcn_raw_buffer_load_b32(rs, vo, (int)(i * step), 2  ));
}
__device__ __forceinline__ void moe_cvt_finish(float (&v)[64], const MoeCvtItem& it, LAS unsigned* scr, int lane) {
    if (it.ksc) {
#pragma unroll
        for (int i = 0; i < 64; ++i) v[i] *= it.ksc[it.k0 + i] * 32.f;
    } else {
#pragma unroll
        for (int i = 0; i < 64; ++i) v[i] *= 32.f;
    }
#pragma unroll
    for (int i = 0; i < 16; ++i) scr[lane * 18 + i] = pk4_fp8(v[4 * i], v[4 * i + 1], v[4 * i + 2], v[4 * i + 3]);
    LDS_WAIT(); asm volatile("" ::: "memory");
    const int c = lane & 3;
#pragma unroll
    for (int j = 0; j < 4; ++j) { const int n = it.n0 + (lane >> 2) + 16 * j; const u32x2 a = *(const LAS u32x2*)(scr + ((lane >> 2) + 16 * j) * 18 + c * 4), b = *(const LAS u32x2*)(scr + ((lane >> 2) + 16 * j) * 18 + c * 4 + 2);
        const int row = it.job == 2 ? n : 256 * (n >> 7) + 128 * it.job + (n & 127);
        *(u32x4*)(it.dst + (size_t)row * it.K + it.k0 + 16 * c) = (u32x4){a.x, a.y, b.x, b.y}; }
    LDS_WAIT(); asm volatile("" ::: "memory");
}
__device__ __forceinline__ void moe_cvt_run(const float* wg, const float* wu, const float* wd, const float* gain, unsigned char* ws, LAS unsigned* scr, int w, int nw, int nitems, int lane) {
    float va[64], vb[64]; int g = w; MoeCvtItem ia, ib;
    if (g < nitems) { ia = moe_cvt_item(wg, wu, wd, gain, ws, g, lane); moe_cvt_load(va, ia, lane); }
    while (g < nitems) {
        const bool hb = g + nw < nitems;
        if (hb) { ib = moe_cvt_item(wg, wu, wd, gain, ws, g + nw, lane); moe_cvt_load(vb, ib, lane); }
        moe_cvt_finish(va, ia, scr, lane);
        g += nw; if (!hb) break;
        const bool ha = g + nw < nitems;
        if (ha) { ia = moe_cvt_item(wg, wu, wd, gain, ws, g + nw, lane); moe_cvt_load(va, ia, lane); }
        moe_cvt_finish(vb, ib, scr, lane);
        g += nw; if (!ha) break;
    }
}
#define TR8_JOB(KIND, W, ldw, ncols, K, ksc, WT8) do { const int nit_ = ((K) / 64) * (((ncols) + 63) / 64); int st_ = gw - rot; if (st_ < 0) st_ += NGW; \
    for (int it_ = st_; it_ < nit_; it_ += NGW) tr8_item<KIND>(W, ldw, ncols, K, ksc, WT8, (LAS unsigned*)scr, it_, lane); rot = (rot + nit_) % NGW; } while (0)
#define TR_JOB(KIND, W, ldw, ncols, K, ksc, WT, row_off) TR_JOB2(KIND, W, ldw, ncols, K, ksc, WT, K, 0, row_off)
#define TR_JOB2(KIND, W, ldw, ncols, K, ksc, WT, ldk, koff, row_off) do { const int nit_ = ((K) / 64) * (((ncols) + 63) / 64); int st_ = gw - rot; if (st_ < 0) st_ += NGW; \
    for (int it_ = st_; it_ < nit_; it_ += NGW) tr_item<KIND>(W, ldw, ncols, K, ksc, WT, ldk, koff, row_off, (LAS unsigned*)scr, it_, lane); rot = (rot + nit_) % NGW; } while (0)
#define CVT_LAYER(l_) do { bf16_t* WIN_ = (bf16_t*)(ws + WS_WIN + (l_) * WIN_STRIDE); \
        TR_JOB(1, args.in[2] + (size_t)(l_) * 1024 * DIN, DIN, 5288, 1024, args.in[1] + (l_) * 1024, WIN_, 0);     \
        for (int i = gw * 64 + lane; i < (NP1 - DIN) * 1024 / 8; i += NGW * 64) *(u32x4*)(WIN_ + (size_t)DIN * 1024 + (size_t)i * 8) = (u32x4){0u, 0u, 0u, 0u};     \
        TR8_JOB(0, args.in[2] + (size_t)(l_) * 1024 * DIN + 5288, DIN, 3072, 1024, args.in[1] + (l_) * 1024, ws + WS_WGL8 + (size_t)(l_) * 3 * MiB); \
        TR_JOB(2, args.in[7] + (size_t)(l_) * 384 * 768, 768, 768, 384, args.in[5] + (l_) * 384, (bf16_t*)(ws + WS_WUQ + (l_) * MiB), 0); \
        TR_JOB(0, args.in[8] + (size_t)(l_) * 256 * 512, 512, 512, 256, args.in[6] + (l_) * 256, (bf16_t*)(ws + WS_WUKV + (l_) * (MiB / 2)), 0); \
        TR_JOB(0, args.in[9] + (size_t)(l_) * 256 * 512, 512, 512, 256, args.in[6] + (l_) * 256, (bf16_t*)(ws + WS_WUKV + (l_) * (MiB / 2)), 512); \
        TR_JOB2(0, args.in[10] + (size_t)(l_) * 512 * 1024, 1024, 1024, 512, (const float*)nullptr, (bf16_t*)(ws + WS_WBCAT + (l_) * 4 * MiB), 2048, 0, 0); \
        TR_JOB2(0, args.in[11] + (size_t)(l_) * 1024 * 1024, 1024, 1024, 1024, (const float*)nullptr, (bf16_t*)(ws + WS_WBCAT + (l_) * 4 * MiB), 2048, 512, 0); \
        TR_JOB2(0, args.in[12] + (size_t)(l_) * 512 * 1024, 1024, 1024, 512, (const float*)nullptr, (bf16_t*)(ws + WS_WBCAT + (l_) * 4 * MiB), 2048, 1536, 0); \
        TR_JOB(0, args.in[13] + (size_t)(l_) * 1024 * 1024, 1024, 1024, 1024, (const float*)nullptr, (bf16_t*)(ws + WS_WOUT + (l_) * 2 * MiB), 0); } while (0)
#define CVT_DENSE() do { \
        TR_JOB(3, args.in[15], DFF, DFF, 1024, args.in[14], (bf16_t*)(ws + WS_WGU), 0); \
        TR_JOB(4, args.in[16], DFF, DFF, 1024, args.in[14], (bf16_t*)(ws + WS_WGU), 0); \
        if (FP8_DENSE_DN) TR8_JOB(0, args.in[17], 1024, 1024, DFF, (const float*)nullptr, ws + WS_WDN); \
        else TR_JOB(0, args.in[17], 1024, 1024, DFF, (const float*)nullptr, (bf16_t*)(ws + WS_WDN), 0); } while (0)
#define CVT_MOE(e0_, e1_, gu_) do { for (int e = (e0_); e < (e1_); ++e) { \
        if (gu_) { TR8_JOB(3, args.in[19] + (size_t)e * 1024 * DFF, DFF, DFF, 1024, args.in[14] + 1024, ws + pg8::moe_gu_base(e)); \
                   TR8_JOB(4, args.in[20] + (size_t)e * 1024 * DFF, DFF, DFF, 1024, args.in[14] + 1024, ws + pg8::moe_gu_base(e)); } \
        TR8_JOB(0, args.in[21] + (size_t)e * DFF * 1024, 1024, 1024, DFF, (const float*)nullptr, ws + pg8::moe_dn_base(e)); } } while (0)
#define CVT_IS_BLOCK() (((bx >> 3) & 3) == 0)
#define CVT_RANK() ((bx >> 5) * 8 + (bx & 7))

struct Args { const float* in[23]; float* out; unsigned char* ws; int ph_lo, ph_hi; };
constexpr int NPH = 32;
__host__ __device__ constexpr int PH(int l, int j) { return 1 + 16 * l + j; }

__device__ __forceinline__ void moe_table(const int* CNT, volatile LAS unsigned* MISC, int tid, int lane, int wave, int tb) {
    { int s = 0, bl = 0;
#pragma unroll
        for (int j = 0; j < 4; ++j) { const int bb = lane + 64 * j; const int c = CNT[bb * 8 + wave]; s += c; bl += (bb < tb) ? c : 0; }
        s = (int)wave_sum((float)s); bl = (int)wave_sum((float)bl);
        if (lane == 0) { MISC[16 + wave] = (unsigned)s; MISC[24 + wave] = (unsigned)bl; } }
    __syncthreads();
    if (tid == 0) { volatile LAS unsigned char* te = (volatile LAS unsigned char*)(MISC + 64); int t = 0;
        for (int e = 0; e < 8; ++e) { const int nt_ = ((int)MISC[16 + e] + 255) >> 8; for (int i = 0; i < nt_ && t < MAXT; ++i) te[t++] = (unsigned char)e; }
        MISC[32] = (unsigned)t; }
    __syncthreads();
}

__device__ __forceinline__ f32x4 bf4_to_f32(const u32x2 a) { return (f32x4){__uint_as_float(a.x << 16), __uint_as_float(a.x & 0xffff0000u), __uint_as_float(a.y << 16), __uint_as_float(a.y & 0xffff0000u)}; }
constexpr size_t WS_X1C = (size_t)282 << 20;
#define IN(k) (lo <= (k) && (k) < hi)
#define SEAM() do { if (!MK_PER_PHASE) xcd_barrier(bar); } while (0)

#define RS_PREFILL() do { const int t_ = opaque_tid(); LAS float* rt8_ = (LAS float*)(lds + 131072 + 1024) + 256; f32x4 q_[4][4]; \
    _Pragma("unroll") for (int k_ = 0; k_ < 4; ++k_) { const float* p_ = SSQ16 + ((size_t)(bx & 7) * 2048 + t_ + 512 * k_) * 16;     \
        q_[k_][0] = *(const f32x4*)p_; q_[k_][1] = *(const f32x4*)(p_ + 4); q_[k_][2] = *(const f32x4*)(p_ + 8); q_[k_][3] = *(const f32x4*)(p_ + 12); } \
    _Pragma("unroll") for (int k_ = 0; k_ < 4; ++k_) { const f32x4 a_ = q_[k_][0], b_ = q_[k_][1], c_ = q_[k_][2], d_ = q_[k_][3]; \
        rt8_[t_ + 512 * k_] = __builtin_amdgcn_rsqf((((a_.x + a_.y) + (a_.z + a_.w)) + ((b_.x + b_.y) + (b_.z + b_.w)) + ((c_.x + c_.y) + (c_.z + c_.w)) + ((d_.x + d_.y) + (d_.z + d_.w))) * (1.f / 1024.f) + EPS); } \
    __syncthreads(); } while (0)
#define PHASE_IDS() const int tid = opaque_tid(), lane = tid & 63, wave = __builtin_amdgcn_readfirstlane(tid >> 6), gw = bx * 8 + wave; LAS float* scr = (LAS float*)(lds + wave * 16384); (void)lane; (void)gw; (void)scr
template <int l> __device__ __forceinline__ void layer_body(const Args& args, LAS unsigned char* lds, volatile LAS unsigned* MISC, const XcdBarrier& bar, const int lo, const int hi) {
    const int G = gridDim.x, bx = blockIdx.x, vcu = (bx & 7) * (G >> 3) + (bx >> 3), NGW = G * 8; (void)NGW; (void)vcu;
    unsigned char* ws = args.ws;
    float* XRES = args.out;
    float* SSQ16 = (float*)(ws + WS_SSQ16); const f32x2* T64 = (const f32x2*)(ws + WS_TAB64); const f32x2* T32 = (const f32x2*)(ws + WS_TAB32);
    float* SSQC = (float*)(ws + WS_SSQC); float* SSQK = (float*)(ws + WS_SSQK); float* LOGF = (float*)(ws + WS_LOGF);
    bf16_t* CUMB = (bf16_t*)(ws + WS_CUMB); bf16_t* KR = (bf16_t*)(ws + WS_KR); float* CUMF = (float*)(ws + WS_CUMF);
    bf16_t* XB = (bf16_t*)(ws + WS_XB); bf16_t* MERGED = (bf16_t*)(ws + WS_FQ);
    bf16_t *FQ = (bf16_t*)(ws + WS_FQ), *FK = (bf16_t*)(ws + WS_FK), *FV = (bf16_t*)(ws + WS_FV), *RQ = (bf16_t*)(ws + WS_RQ), *KG = (bf16_t*)(ws + WS_KG), *RV = (bf16_t*)(ws + WS_RV);
    bf16_t *RG = (bf16_t*)(ws + WS_RG), *GATES = (bf16_t*)(ws + WS_GATES), *CQ = (bf16_t*)(ws + WS_CQ), *CKV = (bf16_t*)(ws + WS_CKV);
    bf16_t *MQ = (bf16_t*)(ws + WS_MQ), *KN = (bf16_t*)(ws + WS_KN), *MV = (bf16_t*)(ws + WS_MV), *OCAT = (bf16_t*)(ws + WS_OCAT), *RP = (bf16_t*)(ws + WS_RP), *X1B = (bf16_t*)(ws + WS_X1B);
    float* Tst = (float*)(ws + WS_T); bf16_t* ACT = (bf16_t*)(ws + WS_ACT);

        const int pb = PH(l, 0);
        const bf16_t* WIN = (const bf16_t*)(ws + WS_WIN + l * WIN_STRIDE);
        const float* xin = l == 0 ? args.in[0] : (const float*)XRES;
        if (IN(pb + 0)) {
            pg8::GridOrder S; S.init(64, 20, G, bx, XB, WIN, 1024); S.pn_skip = 17; S.pn_add = 13;
            pg8::EpiP1 E{FQ, FK, FV, RQ, KG, RV, RG, GATES, CQ, CKV, KR, LOGF, SSQC, SSQK, SSQ16, T64, T32, args.in[3] + l * 8, (unsigned*)(ws + WS_CTL) + CW_KMSQ + 64 * l};
            RS_PREFILL(); E.pre = 1;
            pg8::gemm_phase<pg8::EpiP1, pg8::GridOrder, true>(lds, 1024, S, E);
            { pg8::GridOrder S8; S8.init(64, 12, G, bx, ws + WS_XB8, ws + WS_WGL8 + (size_t)l * 3 * MiB, 512); pg8::EpiGL8 E8{(unsigned char*)GATES};
              pg8::gemm_phase<pg8::EpiGL8, pg8::GridOrder, true, true>(lds, 512, S8, E8); }
            SEAM();
        }
        if (IN(pb + 1)) { PHASE_IDS();
            if (bx < 16) {
                const int b = bx >> 3, h = bx & 7, t0 = tid * 16; float v[16]; float run = 0.f;
#pragma unroll
                for (int j = 0; j < 16; ++j) { run += LOGF[((size_t)b * SEQ + t0 + j) * 8 + h]; v[j] = run; }
                float inc = run;
#pragma unroll
                for (int o = 1; o < 64; o <<= 1) { const float n = __int_as_float(__builtin_amdgcn_ds_bpermute((lane - o) << 2, __float_as_int(inc))); if (lane >= o) inc += n; }
                LAS float* wt = (LAS float*)lds;
                if (lane == 63) wt[wave] = inc;
                __syncthreads();
                float base = inc - run;
                for (int w = 0; w < wave; ++w) base += wt[w];
#pragma unroll
                for (int j = 0; j < 16; ++j) { const float bk = -(base + v[j]) * LOG2E; const unsigned short h0 = f2bf(bk); const float r1 = bk - bf2f(h0); const unsigned short h1 = f2bf(r1); const unsigned short h2 = f2bf(r1 - bf2f(h1));
                    *(u32x4*)(CUMB + ((size_t)bx * SEQ + t0 + j) * 8) = (u32x4){(unsigned)h0 | ((unsigned)h1 << 16), (unsigned)h2, 0u, 0u}; CUMF[(size_t)bx * SEQ + t0 + j] = bf2f(h0) + bf2f(h1) + bf2f(h2); }
                __syncthreads();
            }
            if (bx >= 192) { pg8::GridOrder S; S.init(64, 1, 64, bx - 192, XB, WIN, 1024); S.pn_off = 17;
              pg8::EpiP1 E{FQ, FK, FV, RQ, KG, RV, RG, GATES, CQ, CKV, KR, LOGF, SSQC, SSQK, SSQ16, T64, T32, args.in[3] + l * 8, (unsigned*)(ws + WS_CTL) + CW_KMSQ + 64 * l};
              pg8::gemm_phase<pg8::EpiP1, pg8::GridOrder, true>(lds, 1024, S, E); }
            else { pg8::GridOrder S; S.init(64, 3, 192, bx, CQ, ws + WS_WUQ + l * MiB, 384); pg8::EpiMQ E{MQ, SSQC, T32};
              pg8::gemm_phase<pg8::EpiMQ, pg8::GridOrder, true>(lds, 384, S, E); }
            { pg8::GridOrder S; S.init(64, 4, G, bx, CKV, ws + WS_WUKV + l * (MiB / 2), 256); pg8::EpiKV E{KN, MV, SSQK};
              pg8::gemm_phase<pg8::EpiKV, pg8::GridOrder, true>(lds, 256, S, E); }
            if (bx >= 192) att::tstate_run(2 * (bx - 192), 1, 2, KG, RV, Tst, (LAS char*)lds);
            else if (bx >= 16) att::tstate_run(128 + bx - 16, 176, (1024 - (128 + bx - 16) + 175) / 176, KG, RV, Tst, (LAS char*)lds);
            SEAM();
        }
        if (IN(pb + 2)) { PHASE_IDS();
            for (int e = bx * 512 + tid; e < 16 * 8192; e += G * 512) { const int bh = e >> 13, el = e & 8191; const float lg = lg2gamma(bh & 7), g1 = fexp2(lg), g127 = fexp2(127.f * lg), g128 = fexp2(128.f * lg);
                float R = 0.f; const size_t base = (size_t)bh * 64 * 8192 + el; float Tc[64];
#pragma unroll
                for (int c = 0; c < 64; ++c) Tc[c] = Tst[base + (size_t)c * 8192];
                asm volatile("" ::: "memory");
#pragma unroll
                for (int c = 0; c < 64; ++c) { RP[base + (size_t)c * 8192] = f2bf(g1 * R); R = g128 * R + g127 * Tc[c]; } }
            SEAM();
        }
        if (IN(pb + 3)) {
            unsigned* qctr = (unsigned*)(ws + WS_CTL) + CW_QCTR + 64 * l;
            const unsigned* kmsq = (const unsigned*)(ws + WS_CTL) + CW_KMSQ + 64 * l;
            if (CVT_IS_BLOCK() && (l == 0 ? CVT_L1_IN_P4 : CVT_MOE_IN_P4)) { PHASE_IDS(); (void)tid;
                { const int cw_ = CVT_RANK() * 8 + wave; const int gw = cw_, NGW = 512; int rot = 0;
                  if constexpr (l == 0) { CVT_LAYER(1); CVT_DENSE(); } else moe_cvt_run(args.in[19], args.in[20], args.in[21], args.in[14] + 1024, ws, (LAS unsigned*)scr, cw_, NGW, 8 * 2688 - 896, lane); }
                __syncthreads(); }
            const int tid0 = opaque_tid();
            unsigned nxt_ = 0u; if (tid0 == 0) nxt_ = __hip_atomic_fetch_add(qctr, 1u, __ATOMIC_RELAXED, __HIP_MEMORY_SCOPE_AGENT);
            for (;;) {
                if (tid0 == 0) MISC[40] = nxt_;
                __syncthreads();
                const int idx = (int)MISC[40];
                __syncthreads();
                if (idx >= 1536) break;
                if (tid0 == 0) nxt_ = __hip_atomic_fetch_add(qctr, 1u, __ATOMIC_RELAXED, __HIP_MEMORY_SCOPE_AGENT);
                if (idx < 1024) { const int qb = 31 - (idx >> 5), w = idx & 31, bh = w & 15, b = bh >> 3, h = bh & 7; const size_t rb = (size_t)b * SEQ;
                    if (w < 16) att::attn_unit2<5, true, 9>(qb, FQ + rb * 512 + h * 64, 512, FK + rb * 512 + h * 64, 512, CUMB + (size_t)bh * SEQ * 8, 8, FV + rb * 512 + h * 64, 512, OCAT + rb * 2048 + h * 64, 2048, CUMF + (size_t)bh * SEQ, 1.01f * __builtin_sqrtf(__uint_as_float(kmsq[bh * 2]) + __uint_as_float(kmsq[bh * 2 + 1])), (LAS char*)lds);
                    else att::attn_unit2<6, false, 12>(qb, MQ + rb * 768 + h * 96, 768, KN + rb * 512 + h * 64, 512, KR + rb * 32, 32, MV + rb * 512 + h * 64, 512, OCAT + rb * 2048 + 1536 + h * 64, 2048, (const float*)nullptr, 0.f, (LAS char*)lds);
                } else { const int u = idx - 1024; att::ret_unit(u >> 5, u & 31, RQ, KG, RV, RP, RG, args.in[4] + l * 1024, OCAT, (LAS char*)lds); }
            }
            SEAM();
        }
        if (IN(pb + 4)) {
            pg8::GridOrder S; S.init(64, 4, G, bx, OCAT, ws + WS_WBCAT + l * 4 * MiB, 2048); pg8::EpiMerge E{(const unsigned char*)GATES, MERGED};
            pg8::gemm_phase<pg8::EpiMerge, pg8::GridOrder, true>(lds, 2048, S, E);
            SEAM();
        }
        if (IN(pb + 5)) {
            pg8::GridOrder S; S.init(64, 4, G, bx, MERGED, ws + WS_WOUT + l * 2 * MiB, 1024); pg8::EpiResid E{xin, (float*)nullptr, l == 0 ? X1B : (bf16_t*)(ws + WS_X1C), SSQ16, l == 0 ? (unsigned char*)nullptr : ws + WS_XB8, XB};
            pg8::gemm_phase<pg8::EpiResid, pg8::GridOrder, true>(lds, 1024, S, E);
            SEAM();
        }
        if (l == 0) {
            if (IN(pb + 6)) {
#if FP8_DENSE_GU
                pg8::GridOrder S; S.init(64, 28, G, bx, ws + WS_XB8, ws + WS_WGU, 512); pg8::EpiSwiglu<false> E{ACT, SSQ16, 0};
                RS_PREFILL(); E.pre = 1; E.wsc = 1.f / 32.f;
                pg8::gemm_phase<pg8::EpiSwiglu<false>, pg8::GridOrder, true, true>(lds, 512, S, E);
#else
                pg8::GridOrder S; S.init(64, 28, G, bx, X1B, ws + WS_WGU, 1024); pg8::EpiSwiglu<false, FP8_DENSE_DN != 0> E{ACT, SSQ16, 0};
                RS_PREFILL(); E.pre = 1;
                pg8::gemm_phase<pg8::EpiSwiglu<false, FP8_DENSE_DN != 0>, pg8::GridOrder, true>(lds, 1024, S, E);
#endif
                SEAM();
            }
            if (IN(pb + 7)) {
                pg8::GridOrder S; S.init(64, 4, G, bx, ACT, ws + WS_WDN, FP8_DENSE_DN ? DFF / 2 : DFF); pg8::EpiResid E{(const float*)nullptr, (float*)nullptr, XB, SSQ16, ws + WS_XB8, X1B};
                if (FP8_DENSE_DN) pg8::gemm_phase<pg8::EpiResid, pg8::GridOrder, true, true>(lds, DFF / 2, S, E, 0, 0x7C7C7C7C, 0x7A7A7A7A);
                else pg8::gemm_phase<pg8::EpiResid, pg8::GridOrder, true>(lds, DFF, S, E);
                SEAM();
            }
        } else {
            int* CNT = (int*)(ws + WS_CNT); f32x4* SEL = (f32x4*)(ws + WS_SEL); int* SLOT = (int*)(ws + WS_SLOT); float* RSL = (float*)(ws + WS_RSL);
            bf16_t* HS = (bf16_t*)(ws + WS_HS); bf16_t* Y = (bf16_t*)(ws + WS_Y); bf16_t* ACTM = (bf16_t*)(ws + WS_ACTM);
            if (IN(pb + 6)) { PHASE_IDS();
                LAS float* wrl = (LAS float*)lds;
                { float wq_[16], gq_[16];
#pragma unroll
                  for (int p = 0; p < 16; ++p) { const int i = tid + 512 * p; wq_[p] = args.in[18][i]; gq_[p] = args.in[14][1024 + (i >> 3)]; }
#pragma unroll
                  for (int p = 0; p < 16; ++p) { const int i = tid + 512 * p; wrl[(i & 7) * 1024 + (i >> 3)] = wq_[p] * gq_[p]; } }
                __syncthreads();
                volatile LAS unsigned char* selb = (volatile LAS unsigned char*)(lds + 65536);
                for (int tb = bx; tb < 256; tb += G) {
                    f32x4 xq_[4];
#pragma unroll
                    for (int j = 0; j < 4; ++j) xq_[j] = bf4_to_f32(((const u32x2*)((const bf16_t*)(ws + WS_X1C) + (size_t)(tb * 64 + wave * 8) * 1024) + lane)[64 * j]);
                    for (int tk = 0; tk < 8; ++tk) { const int tl = wave * 8 + tk, t = tb * 64 + tl;
                        f32x4 xc_[4], xn_[4];
#pragma unroll
                        for (int j = 0; j < 4; ++j) xc_[j] = xq_[j];
                        if (tk < 7) {
#pragma unroll
                            for (int j = 0; j < 4; ++j) xn_[j] = bf4_to_f32(((const u32x2*)((const bf16_t*)(ws + WS_X1C) + (size_t)(t + 1) * 1024) + lane)[64 * j]); }
                        float ssq = 0.f; float a[8];
#pragma unroll
                        for (int e = 0; e < 8; ++e) a[e] = 0.f;
#pragma unroll
                        for (int j = 0; j < 4; ++j) { const f32x4 v = xc_[j]; ssq += (v.x * v.x + v.y * v.y) + (v.z * v.z + v.w * v.w); const int k = 4 * (64 * j + lane);
#pragma unroll
                            for (int e = 0; e < 8; ++e) { const f32x4 w = *(const LAS f32x4*)(wrl + e * 1024 + k); a[e] += (v.x * w.x + v.y * w.y) + (v.z * w.z + v.w * w.w); } }
                        ssq = wave_sum(ssq);
#pragma unroll
                        for (int e = 0; e < 8; ++e) a[e] = wave_sum(a[e]);
                        const float r = __builtin_amdgcn_rsqf(ssq * (1.f / 1024.f) + EPS);
                        int i0 = 0; float v0 = a[0];
#pragma unroll
                        for (int e = 1; e < 8; ++e) if (a[e] > v0) { v0 = a[e]; i0 = e; }
                        int i1 = -1; float v1 = -INFINITY;
#pragma unroll
                        for (int e = 0; e < 8; ++e) if (e != i0 && a[e] > v1) { v1 = a[e]; i1 = e; }
                        const float e1 = __expf((v1 - v0) * r), w0 = 1.f / (1.f + e1), w1 = e1 * w0;
                        if (lane == 0) { SEL[t] = (f32x4){__uint_as_float((unsigned)i0 | ((unsigned)i1 << 8)), w0, w1, r}; selb[tl * 2] = (unsigned char)i0; selb[tl * 2 + 1] = (unsigned char)i1; }
                        if (tk < 7) {
#pragma unroll
                            for (int j = 0; j < 4; ++j) xq_[j] = xn_[j]; } }
                    __syncthreads();
                    if (tid < 8) { int c = 0; for (int i = 0; i < 128; ++i) c += (selb[i] == tid) ? 1 : 0; CNT[tb * 8 + tid] = c; }
                    __syncthreads();
                }
                { int rot = 0; if (CVT_MOE_IN_P4) CVT_MOE(7, 8, false); else CVT_MOE(0, 8, true); }
                SEAM();
            }
            if (IN(pb + 7)) { PHASE_IDS();
                volatile LAS int* lslot = (volatile LAS int*)lds;
                for (int tb = bx; tb < 256; tb += G) {
                    moe_table(CNT, MISC, tid, lane, wave, tb);
                    if (wave == 0) { const int t = tb * 64 + lane; const f32x4 se = SEL[t]; const unsigned ee = __float_as_uint(se.x); const int e0 = ee & 255, e1 = (ee >> 8) & 255; int s0 = 0, s1 = 0, off = 0;
                        for (int e = 0; e < 8; ++e) { const unsigned long long mk = __ballot(e0 == e || e1 == e); const int rank = __popcll(mk & ((1ull << lane) - 1ull)); const int sl = off + (int)MISC[24 + e] + rank;
                            if (e0 == e) s0 = sl; if (e1 == e) s1 = sl; off += (((int)MISC[16 + e] + 255) >> 8) << 8; }
                        SLOT[t * 2] = s0; SLOT[t * 2 + 1] = s1; RSL[s0] = se.w; RSL[s1] = se.w; lslot[lane * 2] = s0; lslot[lane * 2 + 1] = s1; }
                    __syncthreads();
#if FP8_MOE_GU
                    { u32x4 rowv[8];
#pragma unroll
                      for (int i = 0; i < 8; ++i) rowv[i] = ((const u32x4*)(ws + WS_XB8 + (size_t)(tb * 64 + wave * 8 + i) * 1024))[lane];
                      asm volatile("" ::: "memory");
#pragma unroll
                      for (int i = 0; i < 16; ++i) { const int sl = lslot[wave * 16 + i]; ((u32x4*)((unsigned char*)HS + (size_t)sl * 1024))[lane] = rowv[i >> 1]; } }
#else
                    for (int p = wave * 16; p < wave * 16 + 16; ++p) { const int t = tb * 64 + (p >> 1), sl = lslot[p]; const u32x4* src = (const u32x4*)(X1B + (size_t)t * 1024); u32x4* dst = (u32x4*)(HS + (size_t)sl * 1024);
                        dst[lane] = src[lane]; dst[lane + 64] = src[lane + 64]; }
#endif
                    __syncthreads();
                }
                SEAM();
            }
            if (IN(pb + 8)) { PHASE_IDS();
              for (int ci = 0; ci < 2; ++ci) {
                { bf16_t* ACTM = ci == 0 ? (bf16_t*)(ws + WS_ACTM) : (bf16_t*)(ws + WS_ACTM1);
                    const int Tt = (int)MISC[32], t0 = 64 * ci, t1 = ci == 0 ? (Tt < 64 ? Tt : 64) : Tt;
                    if (t0 < t1) { pg8::MoeOrder S{t0, t1 - t0, 28, G, bx, 0, (const char*)HS, (const char*)ws, (size_t)256 * 1024, (size_t)0, (const LAS unsigned char*)(lds + MISC_OFF + 256)};
                        pg8::EpiSwiglu<true, FP8_MOE_DN != 0> E{ACTM, RSL, t0}; if (FP8_MOE_GU) E.wsc = 1.f / 32.f;
                        if (ci == 0 && t1 == 64) {
                            LAS float* rt8_ = (LAS float*)(lds + 131072 + 1024) + 256; { const float a_ = RSL[(bx & 7) * 2048 + tid], b_ = RSL[(bx & 7) * 2048 + tid + 512], c_ = RSL[(bx & 7) * 2048 + tid + 1024], d_ = RSL[(bx & 7) * 2048 + tid + 1536];
                              rt8_[tid] = a_; rt8_[tid + 512] = b_; rt8_[tid + 1024] = c_; rt8_[tid + 1536] = d_; } __syncthreads(); E.pre = 1; }
                        else if ((t1 - t0) * 28 <= 8 * G) {
                            LAS float* rt8_ = (LAS float*)(lds + 131072 + 1024) + 256; float vq[4];
#pragma unroll
                            for (int p = 0; p < 4; ++p) { const int idx = tid + 512 * p; pg8::Unit uu; vq[p] = S.next(idx >> 8, uu) ? RSL[uu.pm * 256 + (idx & 255)] : 0.f; }
#pragma unroll
                            for (int p = 0; p < 4; ++p) rt8_[tid + 512 * p] = vq[p];
                            __syncthreads(); E.pre = 2; }
                        pg8::gemm_phase<pg8::EpiSwiglu<true, FP8_MOE_DN != 0>, pg8::MoeOrder, true, FP8_MOE_GU != 0>(lds, FP8_MOE_GU ? 512 : 1024, S, E); }
                }
              }
              SEAM();
            }
            if (IN(pb + 9)) { PHASE_IDS();
              for (int ci = 0; ci < 2; ++ci) {
                { bf16_t* ACTM = ci == 0 ? (bf16_t*)(ws + WS_ACTM) : (bf16_t*)(ws + WS_ACTM1);
                    const int Tt = (int)MISC[32], t0 = 64 * ci, t1 = ci == 0 ? (Tt < 64 ? Tt : 64) : Tt;
                    const int t1w = t1 < 128 ? t1 : 128;
                    constexpr int DB = FP8_MOE_DN ? 1 : 2; constexpr float OSC = FP8_MOE_DN ? 1.f / (32.f * pg8::ACT8_SC) : 1.f;
                    if (t0 < t1w) { pg8::MoeOrder S{t0, t1w - t0, 4, G, bx, t0, (const char*)ACTM, (const char*)ws, (size_t)256 * DFF * DB, (size_t)0, (const LAS unsigned char*)(lds + MISC_OFF + 256), 0, 1};
                        pg8::EpiY E{Y, OSC}; pg8::gemm_phase<pg8::EpiY, pg8::MoeOrder, true, FP8_MOE_DN != 0>(lds, DFF * DB / 2, S, E); }
                    if (ci == 1 && t1 > 128) { pg8::MoeOrder S{128, t1 - 128, 4 * YPARTS, G, bx, t0, (const char*)ACTM, (const char*)ws, (size_t)256 * DFF * DB, (size_t)0, (const LAS unsigned char*)(lds + MISC_OFF + 256), YPART_BYTES, 1};
                        pg8::EpiYPart E{(bf16_t*)(ws + WS_YP), 128 * 256, OSC}; pg8::gemm_phase<pg8::EpiYPart, pg8::MoeOrder, true, FP8_MOE_DN != 0>(lds, DFF * DB / 2, S, E, YPART_BYTES / 2); }
                }
              }
              SEAM();
            }
            if (IN(pb + 14)) { PHASE_IDS();
                const f32x4* fw = (const f32x4*)args.in[22] + lane;
                for (int m = gw; m < M; m += NGW) { const f32x4 se = SEL[m]; const int s0 = SLOT[m * 2], s1 = SLOT[m * 2 + 1];
                    f32x4* xr = (f32x4*)(XRES + (size_t)m * 1024) + lane; const bf16_t* YP = (const bf16_t*)(ws + WS_YP);
                    f32x4 v[4]; float ss = 0.f;
#pragma unroll
                    for (int j = 0; j < 4; ++j) v[j] = bf4_to_f32(((const u32x2*)((const bf16_t*)(ws + WS_X1C) + (size_t)m * 1024) + lane)[64 * j]);
#pragma unroll
                    for (int k = 0; k < 2; ++k) { const int sl = k == 0 ? s0 : s1; const float wk = k == 0 ? se.y : se.z;
                        const bool part = sl >= 128 * 256;
                        if (!part) { const unsigned* y8 = (const unsigned*)((const unsigned char*)Y + (size_t)sl * 1024) + lane; const float wq = wk * (1.f / pg8::Y8_SC);
#pragma unroll
                            for (int j = 0; j < 4; ++j) { const unsigned w = y8[64 * j]; const auto lo = __builtin_amdgcn_cvt_pk_f32_fp8((int)w, false), hi = __builtin_amdgcn_cvt_pk_f32_fp8((int)w, true);
                                v[j] += (f32x4){lo[0], lo[1], hi[0], hi[1]} * wq; } }
                        else { const u32x2* yb_ = (const u32x2*)(YP + (size_t)(sl - 128 * 256) * 1024) + lane;
                        for (int p = 0; p < YPARTS; ++p) { const u32x2* yp = yb_ + (size_t)p * 2048 * 1024 / 4;
#pragma unroll
                            for (int j = 0; j < 4; ++j) { const u32x2 a = yp[64 * j];
                                const f32x4 ya = {__uint_as_float(a.x << 16), __uint_as_float(a.x & 0xffff0000u), __uint_as_float(a.y << 16), __uint_as_float(a.y & 0xffff0000u)}; v[j] += ya * wk; } } } }
#pragma unroll
                    for (int j = 0; j < 4; ++j) ss += (v[j].x * v[j].x + v[j].y * v[j].y) + (v[j].z * v[j].z + v[j].w * v[j].w);
                    const float r = __builtin_amdgcn_rsqf(wave_sum(ss) * (1.f / 1024.f) + EPS);
#pragma unroll
                    for (int j = 0; j < 4; ++j) xr[64 * j] = v[j] * r * fw[64 * j]; }
            }
        }
}

__global__ void __launch_bounds__(512, 2) hybrid_fwd(Args args) {
    extern __shared__ __attribute__((aligned(16))) unsigned char lds_raw[];
    LAS unsigned char* lds = (LAS unsigned char*)lds_raw;
    volatile LAS unsigned* MISC = (volatile LAS unsigned*)(lds + MISC_OFF);
    const int G = gridDim.x, bx = blockIdx.x, vcu = (bx & 7) * (G >> 3) + (bx >> 3), NGW = G * 8;
    unsigned char* ws = args.ws;
    for (int u = threadIdx.x; u < (LDS_BYTES - MISC_OFF) / 4; u += 512) MISC[u] = 0u;
    __syncthreads();
    XcdBarrier bar; bar.bar = (unsigned*)(ws + WS_CTL); bar.x = 0; bar.st = nullptr;
    if (!MK_PER_PHASE) bar = xcd_barrier_post((unsigned*)(ws + WS_CTL), MISC + 8);
    const int lo = args.ph_lo, hi = args.ph_hi;
    float* XRES = args.out;
    float* SSQ16 = (float*)(ws + WS_SSQ16); const f32x2* T64 = (const f32x2*)(ws + WS_TAB64); const f32x2* T32 = (const f32x2*)(ws + WS_TAB32);
    float* SSQC = (float*)(ws + WS_SSQC); float* SSQK = (float*)(ws + WS_SSQK); float* LOGF = (float*)(ws + WS_LOGF);
    bf16_t* CUMB = (bf16_t*)(ws + WS_CUMB); bf16_t* KR = (bf16_t*)(ws + WS_KR); float* CUMF = (float*)(ws + WS_CUMF);
    bf16_t* XB = (bf16_t*)(ws + WS_XB); bf16_t* MERGED = (bf16_t*)(ws + WS_FQ);
    bf16_t *FQ = (bf16_t*)(ws + WS_FQ), *FK = (bf16_t*)(ws + WS_FK), *FV = (bf16_t*)(ws + WS_FV), *RQ = (bf16_t*)(ws + WS_RQ), *KG = (bf16_t*)(ws + WS_KG), *RV = (bf16_t*)(ws + WS_RV);
    bf16_t *RG = (bf16_t*)(ws + WS_RG), *GATES = (bf16_t*)(ws + WS_GATES), *CQ = (bf16_t*)(ws + WS_CQ), *CKV = (bf16_t*)(ws + WS_CKV);
    bf16_t *MQ = (bf16_t*)(ws + WS_MQ), *KN = (bf16_t*)(ws + WS_KN), *MV = (bf16_t*)(ws + WS_MV), *OCAT = (bf16_t*)(ws + WS_OCAT), *RP = (bf16_t*)(ws + WS_RP), *X1B = (bf16_t*)(ws + WS_X1B);
    float* Tst = (float*)(ws + WS_T); bf16_t* ACT = (bf16_t*)(ws + WS_ACT);

    if (IN(0)) { PHASE_IDS();
        int rot = 0;
        if (!CVT_L1_IN_P4) { CVT_LAYER(1); CVT_DENSE(); }
        CVT_LAYER(0);
        for (int idx = bx * 512 + tid; idx < SEQ * 32; idx += G * 512) { const int pos = idx >> 5, i = idx & 31; const double inv = exp2(-(double)(2 * i) / 64.0 * 13.287712379549449), ang = (double)pos * inv;
            ((f32x2*)(ws + WS_TAB64))[idx] = (f32x2){(float)cos(ang), (float)sin(ang)}; }
        for (int idx = bx * 512 + tid; idx < SEQ * 16; idx += G * 512) { const int pos = idx >> 4, i = idx & 15; const double inv = exp2(-(double)(2 * i) / 32.0 * 13.287712379549449), ang = (double)pos * inv;
            ((f32x2*)(ws + WS_TAB32))[idx] = (f32x2){(float)cos(ang), (float)sin(ang)}; }
        for (int m = gw; m < M; m += NGW) { const f32x4* xr = (const f32x4*)(args.in[0] + (size_t)m * 1024) + lane; u32x2* o8 = (u32x2*)(XB + (size_t)m * 1024) + lane; float s = 0.f;
#pragma unroll
            for (int j = 0; j < 4; ++j) { const f32x4 v = xr[64 * j]; s += (v.x * v.x + v.y * v.y) + (v.z * v.z + v.w * v.w); o8[64 * j] = (u32x2){pk2(v.x, v.y), pk2(v.z, v.w)};
                ((unsigned*)(ws + WS_XB8 + (size_t)m * 1024))[64 * j + lane] = pk4_fp8(v.x, v.y, v.z, v.w); }
            s = wave_sum(s); if (lane < 16) SSQ16[(size_t)m * 16 + lane] = lane == 0 ? s : 0.f; }
        SEAM();
    }

    layer_body<0>(args, lds, MISC, bar, lo, hi);
    layer_body<1>(args, lds, MISC, bar, lo, hi);
}
#undef IN
#undef SEAM

extern "C" void kernel_launch(void* const* d_in, const int* in_sizes, int n_in, void* d_out, int out_size, void* d_ws, size_t ws_size, hipStream_t stream) {
    static int ready = 0;
    if (ready == 0) {
        ready = -1;
        if (n_in != 23 || in_sizes[0] != M * DM || out_size != M * DM || ws_size < WS_END) { fprintf(stderr, "kernel_launch: unexpected shapes (n_in %d, in0 %d, out %d, ws %zu < %zu); nothing launched\n", n_in, n_in > 0 ? in_sizes[0] : -1, out_size, ws_size, (size_t)WS_END); return; }
        if (hipFuncSetAttribute((const void*)hybrid_fwd, hipFuncAttributeMaxDynamicSharedMemorySize, LDS_BYTES) != hipSuccess) { fprintf(stderr, "kernel_launch: hipFuncSetAttribute failed\n"); return; }
        int per_cu = 0; if (hipOccupancyMaxActiveBlocksPerMultiprocessor(&per_cu, (const void*)hybrid_fwd, 512, LDS_BYTES) != hipSuccess || per_cu < 1) fprintf(stderr, "kernel_launch: occupancy query says %d\n", per_cu);
        (void)hipGetLastError();
        ready = 1;
    }
    if (ready < 0) return;
    (void)hipMemsetAsync((char*)d_ws + WS_CTL, 0, CTL_ZERO_BYTES, stream);
    Args a{};
    for (int i = 0; i < 23; ++i) a.in[i] = (const float*)d_in[i];
    a.out = (float*)d_out; a.ws = (unsigned char*)d_ws;
#if MK_PER_PHASE
    for (int p = 0; p < NPH; ++p) {
        const bool exists = p == 0 || (p >= PH(0, 0) && p <= PH(0, 7)) || (p >= PH(1, 0) && p <= PH(1, 14));
        if (!exists) continue;
        a.ph_lo = p; a.ph_hi = p + 1;
        hipLaunchKernelGGL(hybrid_fwd, dim3(256), dim3(512), LDS_BYTES, stream, a);
    }
#else
    a.ph_lo = 0; a.ph_hi = NPH;
    hipLaunchKernelGGL(hybrid_fwd, dim3(256), dim3(512), LDS_BYTES, stream, a);
#endif
}
```
